# Optimizing an MI355X kernel written in HIP

```python
import jax, jax.numpy as jnp
from jax import lax
import numpy as np

D_MODEL = 1024
BATCH = 4
SEQ = 4096
DEPTH = 1

ATTN_HEAD_DIM = 64
ATTN_HEADS = D_MODEL // ATTN_HEAD_DIM
ATTN_KV_HEADS = ATTN_HEADS // 4
ATTN_GROUP = ATTN_HEADS // ATTN_KV_HEADS
WINDOW = 128

MLSTM_HEADS = 8
MLSTM_V_DIM = D_MODEL // MLSTM_HEADS
MLSTM_QK_DIM = MLSTM_V_DIM // 2
MLSTM_CHUNK = 64
CONV_WIDTH = 4
GATE_SOFTCAP = 15.0

D_FF = ((8 * D_MODEL // 3 + 127) // 128) * 128
FFN_RESIDUAL_WEIGHT = 0.5
NORM_EPS = 1e-6

SZ_AQ = ATTN_HEADS * ATTN_HEAD_DIM
SZ_AK = ATTN_KV_HEADS * ATTN_HEAD_DIM
SZ_AV = ATTN_KV_HEADS * ATTN_HEAD_DIM
SZ_MQ = MLSTM_HEADS * MLSTM_QK_DIM
SZ_MK = MLSTM_HEADS * MLSTM_QK_DIM
SZ_MV = MLSTM_HEADS * MLSTM_V_DIM
SZ_MO = MLSTM_HEADS * MLSTM_V_DIM
SZ_MI = MLSTM_HEADS
SZ_MF = MLSTM_HEADS
SZ_GATES = 2 * D_MODEL
SPLIT_POINTS = (
    SZ_AQ,
    SZ_AQ + SZ_AK,
    SZ_AQ + SZ_AK + SZ_AV,
    SZ_AQ + SZ_AK + SZ_AV + SZ_MQ,
    SZ_AQ + SZ_AK + SZ_AV + SZ_MQ + SZ_MK,
    SZ_AQ + SZ_AK + SZ_AV + SZ_MQ + SZ_MK + SZ_MV,
    SZ_AQ + SZ_AK + SZ_AV + SZ_MQ + SZ_MK + SZ_MV + SZ_MO,
    SZ_AQ + SZ_AK + SZ_AV + SZ_MQ + SZ_MK + SZ_MV + SZ_MO + SZ_MI,
    SZ_AQ + SZ_AK + SZ_AV + SZ_MQ + SZ_MK + SZ_MV + SZ_MO + SZ_MI + SZ_MF,
)
F_OFFSET = SPLIT_POINTS[7]
IN_WIDTH = SPLIT_POINTS[8] + SZ_GATES

kernel_name = "hybrid_swa_mlstm_macaron_block"


def rms_norm(x, g):
    xf = x.astype(jnp.float32)
    y = xf * lax.rsqrt(jnp.mean(xf * xf, axis=-1, keepdims=True) + NORM_EPS)
    return (y * g.astype(jnp.float32)).astype(x.dtype)


def swiglu(x, w_gate, w_up, w_down):
    return (jax.nn.silu(x @ w_gate) * (x @ w_up)) @ w_down


def causal_depthwise_conv(x, w):
    s = x.shape[1]
    xp = jnp.pad(x, ((0, 0), (CONV_WIDTH - 1, 0), (0, 0)))
    out = xp[:, 0:s] * w[0]
    for j in range(1, CONV_WIDTH):
        out = out + xp[:, j:j + s] * w[j]
    return out


def sliding_window_attention(q, k, v, sinks):
    b, s = q.shape[0], q.shape[1]
    nb = s // WINDOW
    qb = q.reshape(b, nb, WINDOW, ATTN_KV_HEADS, ATTN_GROUP, ATTN_HEAD_DIM)

    def band(t):
        tp = jnp.pad(t, ((0, 0), (WINDOW, 0), (0, 0), (0, 0)))
        tp = tp.reshape(b, nb + 1, WINDOW, ATTN_KV_HEADS, ATTN_HEAD_DIM)
        return jnp.concatenate([tp[:, :-1], tp[:, 1:]], axis=2)

    kb, vb = band(k), band(v)
    scale = ATTN_HEAD_DIM ** -0.5
    scores = jnp.einsum('bnqhgd,bnkhd->bhgnqk', qb, kb).astype(jnp.float32) * scale
    qi = jnp.arange(WINDOW)[:, None]
    kj = jnp.arange(2 * WINDOW)[None, :]
    in_window = (kj > qi) & (kj <= qi + WINDOW)
    is_pad = (jnp.arange(nb)[:, None, None] == 0) & (kj < WINDOW)[None]
    valid = in_window[None] & ~is_pad
    scores = jnp.where(valid, scores, -jnp.inf)
    sink = jnp.broadcast_to(
        sinks.astype(jnp.float32).reshape(ATTN_KV_HEADS, ATTN_GROUP)[None, :, :, None, None, None],
        scores.shape[:-1] + (1,))
    probs = jax.nn.softmax(jnp.concatenate([scores, sink], axis=-1), axis=-1)[..., :-1]
    out = jnp.einsum('bhgnqk,bnkhd->bnqhgd', probs.astype(v.dtype), vb)
    return out.reshape(b, s, ATTN_HEADS * ATTN_HEAD_DIM)


def mlstm_chunkwise(q, k, v, i_pre, f_pre):
    b, s = q.shape[0], q.shape[1]
    nc = s // MLSTM_CHUNK
    f32 = jnp.float32

    def to_chunks(t):
        return t.astype(f32).reshape(b, nc, MLSTM_CHUNK, MLSTM_HEADS, t.shape[-1]).transpose(1, 0, 3, 2, 4)

    def gate_chunks(t):
        return t.astype(f32).reshape(b, nc, MLSTM_CHUNK, MLSTM_HEADS).transpose(1, 0, 3, 2)

    qc, kc, vc = to_chunks(q), to_chunks(k), to_chunks(v)
    ic = gate_chunks(i_pre)
    lfc = jax.nn.log_sigmoid(gate_chunks(f_pre))
    causal = jnp.tril(jnp.ones((MLSTM_CHUNK, MLSTM_CHUNK), dtype=bool))

    def step(carry, inp):
        c_prev, n_prev, m_prev = carry
        q_, k_, v_, i_, lf_ = inp
        cum = jnp.cumsum(lf_, axis=-1)
        logw = cum[..., :, None] - cum[..., None, :] + i_[..., None, :]
        logw = jnp.where(causal, logw, -jnp.inf)
        log_inter = cum + m_prev[..., None]
        m_t = jnp.maximum(log_inter, jnp.max(logw, axis=-1))
        w_intra = jnp.exp(logw - m_t[..., None])
        w_inter = jnp.exp(log_inter - m_t)
        sc = jnp.einsum('bhtd,bhsd->bhts', q_, k_) * w_intra
        num = jnp.einsum('bhts,bhsv->bhtv', sc, v_) + w_inter[..., None] * jnp.einsum('bhtd,bhdv->bhtv', q_, c_prev)
        den = jnp.sum(sc, axis=-1) + w_inter * jnp.einsum('bhtd,bhd->bht', q_, n_prev)
        h = num / jnp.maximum(jnp.abs(den), jnp.exp(-m_t))[..., None]
        total = cum[..., -1]
        log_k = total[..., None] - cum + i_
        m_new = jnp.maximum(total + m_prev, jnp.max(log_k, axis=-1))
        wk = jnp.exp(log_k - m_new[..., None])
        decay = jnp.exp(total + m_prev - m_new)
        c_new = decay[..., None, None] * c_prev + jnp.einsum('bhs,bhsd,bhsv->bhdv', wk, k_, v_)
        n_new = decay[..., None] * n_prev + jnp.einsum('bhs,bhsd->bhd', wk, k_)
        return (c_new, n_new, m_new), h

    init = (jnp.zeros((b, MLSTM_HEADS, MLSTM_QK_DIM, MLSTM_V_DIM), f32),
            jnp.zeros((b, MLSTM_HEADS, MLSTM_QK_DIM), f32),
            jnp.zeros((b, MLSTM_HEADS), f32))
    _, hs = lax.scan(step, init, (qc, kc, vc, ic, lfc))
    return hs.transpose(1, 0, 3, 2, 4).reshape(b, s, MLSTM_HEADS, MLSTM_V_DIM)


def softcap(t):
    return GATE_SOFTCAP * jnp.tanh(t / GATE_SOFTCAP)


def setup_inputs(seed: int = 0) -> dict:
    key = jax.random.key(seed)
    ks = jax.random.split(key, 24)
    f32 = jnp.float32

    def dense(k, fan_in, fan_out):
        return jax.random.normal(k, (DEPTH, fan_in, fan_out), f32) * fan_in ** -0.5

    def gain(k, shape):
        return 1.0 + 0.05 * jax.random.normal(k, shape, f32)

    b_in = 0.02 * jax.random.normal(ks[7], (DEPTH, IN_WIDTH), f32)
    f_bias = jnp.linspace(3.0, 6.0, MLSTM_HEADS, dtype=f32)
    b_in = b_in.at[:, F_OFFSET:F_OFFSET + SZ_MF].add(f_bias)
    return {
        "x": jax.random.normal(ks[0], (BATCH, SEQ, D_MODEL), f32),
        "ffn1_norm": gain(ks[1], (DEPTH, D_MODEL)),
        "ffn1_w_gate": dense(ks[2], D_MODEL, D_FF),
        "ffn1_w_up": dense(ks[3], D_MODEL, D_FF),
        "ffn1_w_down": dense(ks[4], D_FF, D_MODEL),
        "mix_norm": gain(ks[5], (DEPTH, D_MODEL)),
        "w_in": dense(ks[6], D_MODEL, IN_WIDTH),
        "b_in": b_in,
        "attn_sinks": 0.5 * jax.random.normal(ks[8], (DEPTH, ATTN_HEADS), f32),
        "mlstm_conv": jax.random.normal(ks[9], (DEPTH, CONV_WIDTH, SZ_MQ + SZ_MK), f32) * CONV_WIDTH ** -0.5,
        "mlstm_head_norm": gain(ks[10], (DEPTH, MLSTM_HEADS, MLSTM_V_DIM)),
        "w_proj_attn": dense(ks[11], SZ_AQ, D_MODEL),
        "w_proj_mlstm": dense(ks[12], SZ_MV, D_MODEL),
        "w_out": dense(ks[13], D_MODEL, D_MODEL),
        "ffn2_norm": gain(ks[14], (DEPTH, D_MODEL)),
        "ffn2_w_gate": dense(ks[15], D_MODEL, D_FF),
        "ffn2_w_up": dense(ks[16], D_MODEL, D_FF),
        "ffn2_w_down": dense(ks[17], D_FF, D_MODEL),
        "final_norm": gain(ks[18], (D_MODEL,)),
    }


def reference(x, ffn1_norm, ffn1_w_gate, ffn1_w_up, ffn1_w_down, mix_norm, w_in, b_in,
              attn_sinks, mlstm_conv, mlstm_head_norm, w_proj_attn, w_proj_mlstm, w_out,
              ffn2_norm, ffn2_w_gate, ffn2_w_up, ffn2_w_down, final_norm):
    b, s, _ = x.shape
    for l in range(DEPTH):
        h = rms_norm(x, ffn1_norm[l])
        x = x + FFN_RESIDUAL_WEIGHT * swiglu(h, ffn1_w_gate[l], ffn1_w_up[l], ffn1_w_down[l])

        h = rms_norm(x, mix_norm[l])
        z = h @ w_in[l] + b_in[l]
        a_q, a_k, a_v, m_q, m_k, m_v, m_o, m_i, m_f, g_pre = jnp.split(z, SPLIT_POINTS, axis=-1)

        y_attn = sliding_window_attention(
            a_q.reshape(b, s, ATTN_HEADS, ATTN_HEAD_DIM),
            a_k.reshape(b, s, ATTN_KV_HEADS, ATTN_HEAD_DIM),
            a_v.reshape(b, s, ATTN_KV_HEADS, ATTN_HEAD_DIM),
            attn_sinks[l]) @ w_proj_attn[l]

        qk = jax.nn.silu(causal_depthwise_conv(jnp.concatenate([m_q, m_k], axis=-1), mlstm_conv[l]))
        mq = qk[..., :SZ_MQ].reshape(b, s, MLSTM_HEADS, MLSTM_QK_DIM)
        mk = qk[..., SZ_MQ:].reshape(b, s, MLSTM_HEADS, MLSTM_QK_DIM) * MLSTM_QK_DIM ** -0.5
        mv = m_v.reshape(b, s, MLSTM_HEADS, MLSTM_V_DIM)
        hm = mlstm_chunkwise(mq, mk, mv,
                             softcap(m_i.astype(jnp.float32)), softcap(m_f.astype(jnp.float32)))
        hm = rms_norm(hm, mlstm_head_norm[l]).reshape(b, s, SZ_MV)
        hm = (jax.nn.sigmoid(m_o.astype(jnp.float32)) * hm).astype(x.dtype)
        y_mlstm = hm @ w_proj_mlstm[l]

        gates = jax.nn.sigmoid(g_pre.astype(jnp.float32)).astype(x.dtype).reshape(b, s, 2, D_MODEL)
        merged = gates[:, :, 0] * y_attn + gates[:, :, 1] * y_mlstm
        x = x + merged @ w_out[l]

        h = rms_norm(x, ffn2_norm[l])
        x = x + FFN_RESIDUAL_WEIGHT * swiglu(h, ffn2_w_gate[l], ffn2_w_up[l], ffn2_w_down[l])
    return rms_norm(x, final_norm)
```

```cpp
#include <hip/hip_runtime.h>
#include <cstdio>
#include <cstdint>

namespace {
constexpr int D = 1024, B = 4, S = 4096, FF = 2816, INW = 6672;
constexpr int AH = 16, AKV = 4, HD = 64, WIN = 128;
constexpr int MH = 8, MV = 128, MQK = 64, CH = 64;
constexpr float EPS = 1e-6f, CAP = 15.0f;
constexpr int O_AQ = 0, O_AK = 1024, O_AV = 1280, O_MQ = 1536, O_MK = 2048, O_MV = 2560, O_MO = 3584, O_MI = 4608, O_MF = 4616, O_G = 4624;

__device__ __forceinline__ float wave_sum(float v) {
#pragma unroll
    for (int o = 1; o < 64; o <<= 1) v += __shfl_xor(v, o);
    return v;
}
__device__ __forceinline__ float sigmoidf_(float x) { return 1.0f / (1.0f + expf(-x)); }
__device__ __forceinline__ float siluf_(float x) { return x / (1.0f + expf(-x)); }

__global__ void rmsnorm_k(const float* x, const float* __restrict__ g, float* out, int rows) {
    const int row = blockIdx.x * 4 + (threadIdx.x >> 6), lane = threadIdx.x & 63;
    if (row >= rows) return;
    const float* xr = x + (size_t)row * D;
    float v[16]; float s = 0.f;
#pragma unroll
    for (int j = 0; j < 16; ++j) { v[j] = xr[lane + 64 * j]; s += v[j] * v[j]; }
    s = wave_sum(s);
    const float r = rsqrtf(s * (1.0f / D) + EPS);
#pragma unroll
    for (int j = 0; j < 16; ++j) out[(size_t)row * D + lane + 64 * j] = v[j] * r * g[lane + 64 * j];
}

template <int MODE>
__global__ void gemm_k(const float* __restrict__ A, int lda, const float* __restrict__ W, const float* __restrict__ W2, int ldw,
                       const float* __restrict__ bias, const float* R, float alpha, float* C, int ldc, int M, int N, int K) {
    __shared__ float As[16][64 + 1];
    __shared__ float Ws[16][64 + 1];
    __shared__ float Ws2[MODE == 1 ? 16 : 1][64 + 1];
    const int tid = threadIdx.x, tx = tid & 15, ty = tid >> 4;
    const int m0 = blockIdx.y * 64, n0 = blockIdx.x * 64;
    float acc[4][4], acc2[4][4];
#pragma unroll
    for (int i = 0; i < 4; ++i)
#pragma unroll
        for (int j = 0; j < 4; ++j) { acc[i][j] = 0.f; acc2[i][j] = 0.f; }
    for (int k0 = 0; k0 < K; k0 += 16) {
#pragma unroll
        for (int i = 0; i < 4; ++i) { const int e = tid + 256 * i, m = e >> 4, k = e & 15; As[k][m] = A[(size_t)(m0 + m) * lda + k0 + k]; }
#pragma unroll
        for (int i = 0; i < 4; ++i) { const int e = tid + 256 * i, k = e >> 6, n = e & 63; const int nn = n0 + n;
            Ws[k][n] = nn < N ? W[(size_t)(k0 + k) * ldw + nn] : 0.f;
            if (MODE == 1) Ws2[k][n] = nn < N ? W2[(size_t)(k0 + k) * ldw + nn] : 0.f; }
        __syncthreads();
#pragma unroll
        for (int k = 0; k < 16; ++k) {
            float a[4], w[4], w2[4];
#pragma unroll
            for (int i = 0; i < 4; ++i) a[i] = As[k][ty * 4 + i];
#pragma unroll
            for (int j = 0; j < 4; ++j) { w[j] = Ws[k][tx * 4 + j]; if (MODE == 1) w2[j] = Ws2[k][tx * 4 + j]; }
#pragma unroll
            for (int i = 0; i < 4; ++i)
#pragma unroll
                for (int j = 0; j < 4; ++j) { acc[i][j] = fmaf(a[i], w[j], acc[i][j]); if (MODE == 1) acc2[i][j] = fmaf(a[i], w2[j], acc2[i][j]); }
        }
        __syncthreads();
    }
#pragma unroll
    for (int i = 0; i < 4; ++i)
#pragma unroll
        for (int j = 0; j < 4; ++j) {
            const int m = m0 + ty * 4 + i, n = n0 + tx * 4 + j;
            if (n < N) {
                float v = acc[i][j];
                if (MODE == 0) { if (bias) v += bias[n]; }
                else if (MODE == 1) v = siluf_(v) * acc2[i][j];
                else v = R[(size_t)m * ldc + n] + alpha * v;
                C[(size_t)m * ldc + n] = v;
            }
        }
}

__global__ void attn_k(const float* __restrict__ z, const float* __restrict__ sinks, float* __restrict__ out) {
    const int w = blockIdx.x * 4 + (threadIdx.x >> 6), lane = threadIdx.x & 63;
    const int t = w / AH, hq = w % AH, hk = hq / (AH / AKV);
    const float q = z[(size_t)t * INW + O_AQ + hq * HD + lane];
    float m = sinks[hq], l = 1.0f, acc = 0.f;
    const int j0 = t - (WIN - 1) < 0 ? 0 : t - (WIN - 1);
    for (int j = j0; j <= t; ++j) {
        const float kv = z[(size_t)j * INW + O_AK + hk * HD + lane];
        const float s = wave_sum(q * kv) * 0.125f;
        const float mn = fmaxf(m, s), f = expf(m - mn), p = expf(s - mn);
        l = l * f + p; acc = acc * f + p * z[(size_t)j * INW + O_AV + hk * HD + lane]; m = mn;
    }
    out[(size_t)t * D + hq * HD + lane] = acc / l;
}

__global__ void conv_k(const float* __restrict__ z, const float* __restrict__ cw, float* __restrict__ qk) {
    const int idx = blockIdx.x * 256 + threadIdx.x; const int t = idx >> 10, c = idx & 1023;
    float a = 0.f;
#pragma unroll
    for (int j = 0; j < 4; ++j) { const int tt = t - 3 + j; if (tt >= 0) a += z[(size_t)tt * INW + O_MQ + c] * cw[j * 1024 + c]; }
    a = siluf_(a); if (c >= 512) a *= 0.125f;
    qk[(size_t)t * 1024 + c] = a;
}

__global__ void __launch_bounds__(256) mlstm_k(const float* __restrict__ z, const float* __restrict__ qk, const float* __restrict__ hnorm, float* __restrict__ hm) {
    extern __shared__ float sm[];
    float* Cs = sm;
    float* qs = Cs + 64 * 128;
    float* ks = qs + 64 * 65;
    float* vs = ks + 64 * 65;
    float* Ss = vs + 64 * 128;
    float* ns = Ss + 64 * 65;
    float* ig = ns + 64;
    float* cum = ig + 64;
    float* mt = cum + 64;
    float* wint = mt + 64;
    float* wk = wint + 64;
    float* hs = wk + 64;
    float* sc = hs + 64 * 128;
    float* den = sc + 8;
    const int h = blockIdx.x, tid = threadIdx.x;
    for (int i = tid; i < 64 * 128; i += 256) Cs[i] = 0.f;
    if (tid < 64) ns[tid] = 0.f;
    if (tid == 0) sc[0] = 0.f;
    __syncthreads();
    for (int c = 0; c < S / CH; ++c) {
        const int t0 = c * CH;
        for (int i = tid; i < 64 * 64; i += 256) { const int t = i >> 6, d = i & 63; qs[t * 65 + d] = qk[(size_t)(t0 + t) * 1024 + h * 64 + d]; ks[t * 65 + d] = qk[(size_t)(t0 + t) * 1024 + 512 + h * 64 + d]; }
        for (int i = tid; i < 64 * 128; i += 256) { const int t = i >> 7, v = i & 127; vs[i] = z[(size_t)(t0 + t) * INW + O_MV + h * 128 + v]; }
        if (tid < 64) {
            const float ip = z[(size_t)(t0 + tid) * INW + O_MI + h], fp = z[(size_t)(t0 + tid) * INW + O_MF + h];
            ig[tid] = CAP * tanhf(ip / CAP);
            const float fc = CAP * tanhf(fp / CAP);
            cum[tid] = fc >= 0.f ? -log1pf(expf(-fc)) : fc - log1pf(expf(fc));
        }
        __syncthreads();
        if (tid == 0) { float a = 0.f; for (int t = 0; t < 64; ++t) { a += cum[t]; cum[t] = a; } }
        __syncthreads();
        const float m_prev = sc[0];
        if (tid < 64) {
            float mx = -INFINITY;
            for (int s = 0; s <= tid; ++s) mx = fmaxf(mx, cum[tid] - cum[s] + ig[s]);
            const float li = cum[tid] + m_prev, m = fmaxf(li, mx);
            mt[tid] = m; wint[tid] = expf(li - m);
        }
        if (tid == 64) {
            const float total = cum[63]; float mx = -INFINITY;
            for (int s = 0; s < 64; ++s) mx = fmaxf(mx, total - cum[s] + ig[s]);
            const float mn = fmaxf(total + m_prev, mx);
            sc[1] = mn; sc[2] = expf(total + m_prev - mn);
        }
        __syncthreads();
        if (tid < 64) wk[tid] = expf(cum[63] - cum[tid] + ig[tid] - sc[1]);
        for (int i = tid; i < 64 * 64; i += 256) {
            const int t = i >> 6, s = i & 63; float v = 0.f;
            if (s <= t) { float d = 0.f; for (int k = 0; k < 64; ++k) d = fmaf(qs[t * 65 + k], ks[s * 65 + k], d); v = d * expf(cum[t] - cum[s] + ig[s] - mt[t]); }
            Ss[t * 65 + s] = v;
        }
        __syncthreads();
        if (tid < 64) { float d = 0.f; for (int s = 0; s < 64; ++s) d += Ss[tid * 65 + s]; float qn = 0.f; for (int k = 0; k < 64; ++k) qn = fmaf(qs[tid * 65 + k], ns[k], qn);
            d += wint[tid] * qn; den[tid] = fmaxf(fabsf(d), expf(-mt[tid])); }
        __syncthreads();
        for (int i = tid; i < 64 * 128; i += 256) {
            const int t = i >> 7, v = i & 127; float a = 0.f, b = 0.f;
            for (int s = 0; s <= t; ++s) a = fmaf(Ss[t * 65 + s], vs[s * 128 + v], a);
            for (int k = 0; k < 64; ++k) b = fmaf(qs[t * 65 + k], Cs[k * 128 + v], b);
            hs[i] = (a + wint[t] * b) / den[t];
        }
        __syncthreads();
        for (int i = tid; i < 64 * 128; i += 256) {
            const int d = i >> 7, v = i & 127; float a = 0.f;
            for (int s = 0; s < 64; ++s) a = fmaf(wk[s] * ks[s * 65 + d], vs[s * 128 + v], a);
            Cs[i] = sc[2] * Cs[i] + a;
        }
        if (tid < 64) { float a = 0.f; for (int s = 0; s < 64; ++s) a = fmaf(wk[s], ks[s * 65 + tid], a); ns[tid] = sc[2] * ns[tid] + a; }
        {
            const int wv = tid >> 6, lane = tid & 63;
            for (int t = wv; t < 64; t += 4) {
                const float a = hs[t * 128 + lane], b = hs[t * 128 + 64 + lane];
                const float r = rsqrtf(wave_sum(a * a + b * b) * (1.0f / 128.0f) + EPS);
                const size_t zo = (size_t)(t0 + t) * INW + O_MO + h * 128;
                hm[(size_t)(t0 + t) * D + h * 128 + lane] = sigmoidf_(z[zo + lane]) * a * r * hnorm[h * 128 + lane];
                hm[(size_t)(t0 + t) * D + h * 128 + 64 + lane] = sigmoidf_(z[zo + 64 + lane]) * b * r * hnorm[h * 128 + 64 + lane];
            }
        }
        __syncthreads();
        if (tid == 0) sc[0] = sc[1];
        __syncthreads();
    }
}

__global__ void merge_k(const float* __restrict__ z, const float* __restrict__ ya, const float* __restrict__ ym, float* __restrict__ mg) {
    const int idx = blockIdx.x * 256 + threadIdx.x; const int t = idx >> 10, c = idx & 1023;
    mg[idx] = sigmoidf_(z[(size_t)t * INW + O_G + c]) * ya[idx] + sigmoidf_(z[(size_t)t * INW + O_G + 1024 + c]) * ym[idx];
}
}

extern "C" void kernel_launch(void* const* d_in, const int* in_sizes, int n_in, void* d_out, int out_size, void* d_ws, size_t ws_size, hipStream_t stream) {
    const float* x = (const float*)d_in[0];
    const float *n1 = (const float*)d_in[1], *wg1 = (const float*)d_in[2], *wu1 = (const float*)d_in[3], *wd1 = (const float*)d_in[4];
    const float *nmix = (const float*)d_in[5], *win = (const float*)d_in[6], *bin = (const float*)d_in[7], *sinks = (const float*)d_in[8];
    const float *cw = (const float*)d_in[9], *hnorm = (const float*)d_in[10], *wpa = (const float*)d_in[11], *wpm = (const float*)d_in[12], *wout = (const float*)d_in[13];
    const float *n2 = (const float*)d_in[14], *wg2 = (const float*)d_in[15], *wu2 = (const float*)d_in[16], *wd2 = (const float*)d_in[17], *nf = (const float*)d_in[18];
    float* out = (float*)d_out;
    float* ws = (float*)d_ws;
    float* hbuf = ws;
    float* act = hbuf + (size_t)S * D;
    float* zb = act + (size_t)S * FF;
    float* ao = zb + (size_t)S * INW;
    float* qkb = ao + (size_t)S * D;
    float* hmb = qkb + (size_t)S * D;
    float* ya = qkb;
    float* ym = hmb + (size_t)S * D;
    static bool attr_done = false;
    const int MLSTM_LDS = (64 * 128 * 3 + 64 * 65 * 3 + 64 * 6 + 8 + 64) * 4;
    if (!attr_done) { hipFuncSetAttribute((const void*)mlstm_k, hipFuncAttributeMaxDynamicSharedMemorySize, MLSTM_LDS); attr_done = true; }
    for (int b = 0; b < B; ++b) {
        const float* xb = x + (size_t)b * S * D; float* ob = out + (size_t)b * S * D; float* x1 = ob;
        rmsnorm_k<<<S / 4, 256, 0, stream>>>(xb, n1, hbuf, S);
        gemm_k<1><<<dim3(FF / 64, S / 64), 256, 0, stream>>>(hbuf, D, wg1, wu1, FF, nullptr, nullptr, 0.f, act, FF, S, FF, D);
        gemm_k<2><<<dim3(D / 64, S / 64), 256, 0, stream>>>(act, FF, wd1, nullptr, D, nullptr, xb, 0.5f, x1, D, S, D, FF);
        rmsnorm_k<<<S / 4, 256, 0, stream>>>(x1, nmix, hbuf, S);
        gemm_k<0><<<dim3((INW + 63) / 64, S / 64), 256, 0, stream>>>(hbuf, D, win, nullptr, INW, bin, nullptr, 0.f, zb, INW, S, INW, D);
        attn_k<<<S * AH / 4, 256, 0, stream>>>(zb, sinks, ao);
        conv_k<<<S * 1024 / 256, 256, 0, stream>>>(zb, cw, qkb);
        mlstm_k<<<MH, 256, MLSTM_LDS, stream>>>(zb, qkb, hnorm, hmb);
        gemm_k<0><<<dim3(D / 64, S / 64), 256, 0, stream>>>(ao, D, wpa, nullptr, D, nullptr, nullptr, 0.f, ya, D, S, D, D);
        gemm_k<0><<<dim3(D / 64, S / 64), 256, 0, stream>>>(hmb, D, wpm, nullptr, D, nullptr, nullptr, 0.f, ym, D, S, D, D);
        merge_k<<<S * 1024 / 256, 256, 0, stream>>>(zb, ya, ym, hbuf);
        gemm_k<2><<<dim3(D / 64, S / 64), 256, 0, stream>>>(hbuf, D, wout, nullptr, D, nullptr, x1, 1.0f, x1, D, S, D, D);
        rmsnorm_k<<<S / 4, 256, 0, stream>>>(x1, n2, hbuf, S);
        gemm_k<1><<<dim3(FF / 64, S / 64), 256, 0, stream>>>(hbuf, D, wg2, wu2, FF, nullptr, nullptr, 0.f, act, FF, S, FF, D);
        gemm_k<2><<<dim3(D / 64, S / 64), 256, 0, stream>>>(act, FF, wd2, nullptr, D, nullptr, x1, 0.5f, x1, D, S, D, FF);
        rmsnorm_k<<<S / 4, 256, 0, stream>>>(x1, nf, ob, S);
    }
}
```

```cpp
#include <hip/hip_runtime.h>
#include <cstdio>
#include <cstdint>
namespace pg8 {
#define PG8_LAS __attribute__((address_space(3)))
typedef unsigned short bf16_t;
typedef short bf16x8 __attribute__((ext_vector_type(8)));
typedef float f32x4 __attribute__((ext_vector_type(4)));
typedef unsigned u32x4 __attribute__((ext_vector_type(4)));
typedef unsigned u32x2 __attribute__((ext_vector_type(2)));
constexpr int BM = 256, BK = 64, HALF = 128, HTB = HALF * BK * 2  , STAGE_BYTES = 8 * HTB, NXCD = 8, WGM = 8;
constexpr float RMS_EPS = 1e-6f;

__host__ __device__ __forceinline__ int lds_byte(int r, int c) { const int st = (r >> 4) * 2 + (c >> 5), rr = r & 15, cc = c & 31, ob = rr * 64 + cc * 2; return st * 1024 + (ob ^ (((ob >> 9) & 1) << 5)); }
__host__ __device__ __forceinline__ void stage_rc(int b, int& R, int& C) { const int st = b / 1024, sb = b % 1024, swz = sb ^ (((sb >> 9) & 1) << 5); R = (st >> 1) * 16 + swz / 64; C = (st & 1) * 32 + (swz % 64) / 2; }
__host__ __device__ __forceinline__ int perm32(int rho) { const int n = rho >> 4, i = rho & 15; return 8 * (i >> 2) + 4 * n + (i & 3); }

struct Unit { int pm, pn; };
struct Gemm { const bf16_t* A; const bf16_t* A2; const bf16_t* Bt; int lda, ldb, K, ksplit; };

struct StaticOrder {
    int nM, nN, nwg, G, c;
    __host__ __device__ void init(int M, int N, int G_, int c_) { nM = M / BM; nN = N / BM; nwg = nM * nN; G = G_; c = c_; }
    __host__ __device__ bool next(int i, Unit& u) const {
        const long L = (long)i * G + c; if (L >= nwg) return false;
        int wgid = (int)L; { const int q = nwg / NXCD, r = nwg % NXCD, xcd = wgid % NXCD, off = wgid / NXCD; wgid = (xcd < r ? xcd * (q + 1) : r * (q + 1) + (xcd - r) * q) + off; }
        const int nig = WGM * nN, gid = wgid / nig, fm = gid * WGM, gsz = (nM - fm) < WGM ? (nM - fm) : WGM;
        u.pm = fm + ((wgid % nig) % gsz); u.pn = (wgid % nig) / gsz; return true;
    }
    __device__ __forceinline__ void a_ready(const Unit&) const {}
    __device__ __forceinline__ void done(const Unit&) const {}
};

__device__ __forceinline__ unsigned cvt_pk_bf16(float lo, float hi) { unsigned r; asm volatile("v_cvt_pk_bf16_f32 %0, %1, %2" : "=v"(r) : "v"(lo), "v"(hi)); return r; }
__device__ __forceinline__ float fast_sigmoid(float x) { return __builtin_amdgcn_rcpf(1.0f + __builtin_amdgcn_exp2f(-1.4426950408889634f * x)); }
__device__ __forceinline__ float rstd_of(float ssq) { return __builtin_amdgcn_rsqf(ssq * (1.0f / 1024.0f) + RMS_EPS); }

struct EpiSwiglu {
    static constexpr bool PERM = true, HAS_MID = false;
    bf16_t* O; int ldo; const float* ssq;
    __device__ __forceinline__ void operator()(const f32x4 (&acc)[2][2][4][2], const Unit& u, int wr, int wc, int fr, int fq) const {
        const int row0 = u.pm * BM + wr * 64 + fr, col0 = u.pn * HALF + wc * 32 + 8 * fq;
#pragma unroll
        for (int ai = 0; ai < 2; ++ai)
#pragma unroll
            for (int m = 0; m < 4; ++m) {
                const int r = row0 + ai * HALF + m * 16; const float rs = rstd_of(ssq[r]);
                float o[8];
#pragma unroll
                for (int n = 0; n < 2; ++n)
#pragma unroll
                    for (int j = 0; j < 4; ++j) { const float gv = acc[ai][0][m][n][j] * rs, uv = acc[ai][1][m][n][j] * rs; o[4 * n + j] = gv * fast_sigmoid(gv) * uv; }
                u32x4 w; w.x = cvt_pk_bf16(o[0], o[1]); w.y = cvt_pk_bf16(o[2], o[3]); w.z = cvt_pk_bf16(o[4], o[5]); w.w = cvt_pk_bf16(o[6], o[7]);
                *(u32x4*)(O + (size_t)r * ldo + col0) = w;
            }
    }
};
struct EpiRes {
    static constexpr bool PERM = false, HAS_MID = false;
    const float* R; float* X; bf16_t* Xb; float* ssq; float alpha;
    __device__ __forceinline__ void operator()(const f32x4 (&acc)[2][2][4][2], const Unit& u, int wr, int wc, int fr, int fq) const {
        const int row0 = u.pm * BM + wr * 64 + fr, col0 = u.pn * BM + wc * 32 + 4 * fq;
#pragma unroll
        for (int ai = 0; ai < 2; ++ai)
#pragma unroll
            for (int m = 0; m < 4; ++m) {
                const int r = row0 + ai * HALF + m * 16; float sq = 0.f;
#pragma unroll
                for (int bj = 0; bj < 2; ++bj)
#pragma unroll
                    for (int n = 0; n < 2; ++n) {
                        const size_t off = (size_t)r * 1024 + col0 + bj * HALF + n * 16;
                        const f32x4 x = *(const f32x4*)(R + off) + acc[ai][bj][m][n] * alpha;
                        *(f32x4*)(X + off) = x; sq += (x[0] * x[0] + x[1] * x[1]) + (x[2] * x[2] + x[3] * x[3]);
                        if (Xb) { u32x2 w; w.x = cvt_pk_bf16(x[0], x[1]); w.y = cvt_pk_bf16(x[2], x[3]); *(u32x2*)(Xb + off) = w; }
                    }
                sq += __shfl_xor(sq, 16); sq += __shfl_xor(sq, 32);
                if (fq == 0) atomicAdd(ssq + r, sq);
            }
    }
};
struct EpiWin {
    static constexpr bool PERM = true, HAS_MID = false;
    bf16_t* Z; int ldz; float* IF; const float* bias; const float* ssq;
    __device__ __forceinline__ void operator()(const f32x4 (&acc)[2][2][4][2], const Unit& u, int wr, int wc, int fr, int fq) const {
        const int row0 = u.pm * BM + wr * 64 + fr, cw = wc * 32 + 8 * fq;
        const bool ztile = u.pn < 18;
#pragma unroll
        for (int ai = 0; ai < 2; ++ai)
#pragma unroll
            for (int m = 0; m < 4; ++m) {
                const int r = row0 + ai * HALF + m * 16; const float rs = rstd_of(ssq[r]);
#pragma unroll
                for (int bj = 0; bj < 2; ++bj) {
                    const int c = u.pn * BM + bj * HALF + cw;
                    const f32x4 v0 = acc[ai][bj][m][0] * rs + *(const f32x4*)(bias + c), v1 = acc[ai][bj][m][1] * rs + *(const f32x4*)(bias + c + 4);
                    if (ztile) { u32x4 w; w.x = cvt_pk_bf16(v0[0], v0[1]); w.y = cvt_pk_bf16(v0[2], v0[3]); w.z = cvt_pk_bf16(v1[0], v1[1]); w.w = cvt_pk_bf16(v1[2], v1[3]);
                        *(u32x4*)(Z + (size_t)r * ldz + c) = w; }
                    else if (bj == 0 && cw < 16) { *(f32x4*)(IF + (size_t)r * 16 + cw) = v0; *(f32x4*)(IF + (size_t)r * 16 + cw + 4) = v1; }
                }
            }
    }
};
struct EpiGate {
    static constexpr bool PERM = true, HAS_MID = false;
    bf16_t* Z; int ldz, off0, off1; const float* bias; const float* ssq;
    __device__ __forceinline__ void operator()(const f32x4 (&acc)[2][2][4][2], const Unit& u, int wr, int wc, int fr, int fq) const {
        const int row0 = u.pm * BM + wr * 64 + fr, cw = wc * 32 + 8 * fq;
        const int cdst0 = (u.pn < 4 ? off0 : off1) + (u.pn & 3) * BM;
#pragma unroll
        for (int ai = 0; ai < 2; ++ai)
#pragma unroll
            for (int m = 0; m < 4; ++m) {
                const int r = row0 + ai * HALF + m * 16; const float rs = rstd_of(ssq[r]);
#pragma unroll
                for (int bj = 0; bj < 2; ++bj) {
                    const int c = u.pn * BM + bj * HALF + cw;
                    const f32x4 v0 = acc[ai][bj][m][0] * rs + *(const f32x4*)(bias + c), v1 = acc[ai][bj][m][1] * rs + *(const f32x4*)(bias + c + 4);
                    u32x4 w; w.x = cvt_pk_bf16(fast_sigmoid(v0[0]), fast_sigmoid(v0[1])); w.y = cvt_pk_bf16(fast_sigmoid(v0[2]), fast_sigmoid(v0[3]));
                    w.z = cvt_pk_bf16(fast_sigmoid(v1[0]), fast_sigmoid(v1[1])); w.w = cvt_pk_bf16(fast_sigmoid(v1[2]), fast_sigmoid(v1[3]));
                    *(u32x4*)(Z + (size_t)r * ldz + cdst0 + bj * HALF + cw) = w;
                }
            }
    }
};
struct EpiProj {
    static constexpr bool PERM = true, HAS_MID = true;
    const bf16_t* Z; int ldz, off0, off1; bf16_t* O;
    __device__ __forceinline__ static float bfl(unsigned w) { return __builtin_bit_cast(float, w << 16); }
    __device__ __forceinline__ static float bfh(unsigned w) { return __builtin_bit_cast(float, w & 0xffff0000u); }
    __device__ __forceinline__ void mid(f32x4 (&acc)[2][2][4][2], const Unit& u, int wr, int wc, int fr, int fq) const {
        unsigned base = (unsigned)((u.pm * BM + wr * 64 + fr) * ldz + u.pn * BM + wc * 32 + 8 * fq) * 2u; asm volatile("" : "+v"(base));
        const char* zb = (const char*)Z;
#pragma unroll
        for (int ai = 0; ai < 2; ++ai)
#pragma unroll
            for (int m = 0; m < 4; ++m) {
#pragma unroll
                for (int bj = 0; bj < 2; ++bj) {
                    const unsigned o = base + (unsigned)(((ai * HALF + m * 16) * ldz + bj * HALF) * 2);
                    const u32x4 a = *(const u32x4*)(zb + o + (unsigned)(off0 * 2)), b = *(const u32x4*)(zb + o + (unsigned)(off1 * 2));
#pragma unroll
                    for (int q = 0; q < 4; ++q) {
                        const float rl = bfl(a[q]) * __builtin_amdgcn_rcpf(fmaxf(bfl(b[q]), 1e-30f)), rh = bfh(a[q]) * __builtin_amdgcn_rcpf(fmaxf(bfh(b[q]), 1e-30f));
                        acc[ai][bj][m][q >> 1][(q & 1) * 2] *= rl; acc[ai][bj][m][q >> 1][(q & 1) * 2 + 1] *= rh;
                    }
                    asm volatile("" ::: "memory");
                }
            }
    }
    __device__ __forceinline__ void operator()(const f32x4 (&acc)[2][2][4][2], const Unit& u, int wr, int wc, int fr, int fq) const {
        const int row0 = u.pm * BM + wr * 64 + fr, cw = wc * 32 + 8 * fq;
#pragma unroll
        for (int ai = 0; ai < 2; ++ai)
#pragma unroll
            for (int m = 0; m < 4; ++m) {
                const int r = row0 + ai * HALF + m * 16;
#pragma unroll
                for (int bj = 0; bj < 2; ++bj) {
                    const int c = u.pn * BM + bj * HALF + cw;
                    const u32x4 b = *(const u32x4*)(Z + (size_t)r * ldz + off1 + c);
                    u32x4 w;
#pragma unroll
                    for (int q = 0; q < 4; ++q) w[q] = cvt_pk_bf16(acc[ai][bj][m][q >> 1][(q & 1) * 2] * fmaxf(bfl(b[q]), 1e-30f), acc[ai][bj][m][q >> 1][(q & 1) * 2 + 1] * fmaxf(bfh(b[q]), 1e-30f));
                    *(u32x4*)(O + (size_t)r * 1024 + c) = w;
                    asm volatile("" ::: "memory");
                }
            }
    }
};
template <class Epi, class Sched, bool ALIGN_EPI = false, bool SP2 = false>
__device__ __forceinline__ void gemm_phase(PG8_LAS unsigned char* lds, const Gemm g, const Sched& S, const Epi& E) {
    const int tid = threadIdx.x, wid = __builtin_amdgcn_readfirstlane(tid >> 6), lane = tid & 63, wr = wid >> 2, wc = wid & 3, fr = lane & 15, fq = lane >> 4;
    const int K = g.K, nt = K / BK;
    unsigned voffA[2], voffB[2];
#pragma unroll
    for (int i = 0; i < 2; ++i) { int R, C; stage_rc(tid * 16 + i * 8192, R, C); const int Rb = Epi::PERM ? ((R & ~31) + perm32(R & 31)) : R;
        voffA[i] = (unsigned)(R * g.lda + C) * 2u; voffB[i] = (unsigned)(Rb * g.ldb + C) * 2u; }
    const size_t kstep = (size_t)(BK * 2);
    const size_t hstepA = (size_t)HALF * g.lda * 2, hstepB = (size_t)HALF * g.ldb * 2;
    const size_t tstepA = 2 * hstepA, tstepB = 2 * hstepB;
    const unsigned ldsw = (unsigned)wid * 1024u;
    const int aoff = lds_byte(wr * 64 + fr, fq * 8), boff = lds_byte(wc * 32 + fr, fq * 8);
#define PG8_SA(b, h) (((b) * 2 + (h)) * HTB)
#define PG8_SB(b, h) ((4 + (b) * 2 + (h)) * HTB)
#define PG8_STAGE(bufoff, gbase, voff) do { _Pragma("unroll") for (int _i = 0; _i < 2; ++_i) \
        __builtin_amdgcn_global_load_lds((const unsigned*)((const char*)(gbase) + (voff)[_i]), (PG8_LAS unsigned*)(lds + (bufoff) + ldsw + _i * 8192), 16, 0, 0); } while (0)
#define PG8_LDA(dst, b, h) do { _Pragma("unroll") for (int m = 0; m < 4; ++m) _Pragma("unroll") for (int k = 0; k < 2; ++k) dst[m][k] = *(const PG8_LAS bf16x8*)(lds + PG8_SA(b, h) + aoff + m * 2048 + k * 1024); } while (0)
#define PG8_LDB(dst, b, h) do { _Pragma("unroll") for (int n = 0; n < 2; ++n) _Pragma("unroll") for (int k = 0; k < 2; ++k) dst[n][k] = *(const PG8_LAS bf16x8*)(lds + PG8_SB(b, h) + boff + n * 2048 + k * 1024); } while (0)
#define PG8_MMA(ai, bj, At, Bt) do { __builtin_amdgcn_s_setprio(1); _Pragma("unroll") for (int m = 0; m < 4; ++m) _Pragma("unroll") for (int n = 0; n < 2; ++n) _Pragma("unroll") for (int k = 0; k < 2; ++k) \
        acc[ai][bj][m][n] = __builtin_amdgcn_mfma_f32_16x16x32_bf16(Bt[n][k], At[m][k], acc[ai][bj][m][n], 0, 0, 0); __builtin_amdgcn_s_setprio(0); } while (0)
#define PG8_WAIT_V(n) asm volatile("s_waitcnt vmcnt(" #n ")" ::: "memory")
#define PG8_WAIT_L(n) asm volatile("s_waitcnt lgkmcnt(" #n ")" ::: "memory")
#define PG8_BAR __builtin_amdgcn_s_barrier()
#define PG8_SCHED __builtin_amdgcn_sched_barrier(0)
    Unit cur, nxt; int ui = 0;
    if (!S.next(0, cur)) return;
    f32x4 acc[2][2][4][2];
#pragma unroll
    for (int a = 0; a < 2; ++a)
#pragma unroll
        for (int b = 0; b < 2; ++b)
#pragma unroll
            for (int m = 0; m < 4; ++m)
#pragma unroll
                for (int n = 0; n < 2; ++n) acc[a][b][m][n] = (f32x4){0.f, 0.f, 0.f, 0.f};
    bf16x8 At[4][2], B0[2][2], B1[2][2];
    const char* cA = (const char*)g.A + (size_t)cur.pm * tstepA; const char* cA2 = (const char*)g.A2 + (size_t)cur.pm * tstepA; const char* cB = (const char*)g.Bt + (size_t)cur.pn * tstepB;
    S.a_ready(cur);
    if constexpr (SP2) {
        PG8_STAGE(PG8_SB(0, 0), cB, voffB); PG8_STAGE(PG8_SB(0, 1), cB + hstepB, voffB); PG8_STAGE(PG8_SA(0, 0), cA, voffA); PG8_STAGE(PG8_SA(0, 1), cA + hstepA, voffA);
        if (wr == 1) PG8_BAR;
        PG8_WAIT_V(2); PG8_BAR;
        PG8_STAGE(PG8_SB(1, 0), cB + kstep, voffB); PG8_STAGE(PG8_SA(1, 0), cA + kstep, voffA); PG8_STAGE(PG8_SB(1, 1), cB + hstepB + kstep, voffB);
        PG8_WAIT_V(6); PG8_BAR;
    } else {
        PG8_STAGE(PG8_SB(0, 0), cB, voffB); PG8_STAGE(PG8_SA(0, 0), cA, voffA); PG8_STAGE(PG8_SB(0, 1), cB + hstepB, voffB); PG8_STAGE(PG8_SA(0, 1), cA + hstepA, voffA);
        if (wr == 1) PG8_BAR;
        PG8_WAIT_V(4); PG8_BAR;
        PG8_STAGE(PG8_SB(1, 0), cB + kstep, voffB); PG8_STAGE(PG8_SA(1, 0), cA + kstep, voffA); PG8_STAGE(PG8_SB(1, 1), cB + hstepB + kstep, voffB);
        PG8_WAIT_V(6); PG8_BAR;
    }
    for (;;) {
        const bool has_next = S.next(ui + 1, nxt);
        const char* nA = has_next ? (const char*)g.A + (size_t)nxt.pm * tstepA : cA; const char* nA2 = has_next ? (const char*)g.A2 + (size_t)nxt.pm * tstepA : cA2; const char* nB = has_next ? (const char*)g.Bt + (size_t)nxt.pn * tstepB : cB;
        for (int t = 0; t < nt; t += 2) {
            const bool last = (t == nt - 2);
            if constexpr (Epi::HAS_MID) { if (t == g.ksplit) E.mid(acc, cur, wr, wc, fr, fq); }
            const char* a1 = ((t + 1) < g.ksplit ? cA : cA2) + (size_t)(t + 1) * kstep;
            const char* a2 = last ? nA : ((t + 2) < g.ksplit ? cA : cA2) + (size_t)(t + 2) * kstep; const char* b2 = last ? nB : cB + (size_t)(t + 2) * kstep;
            const char* a3 = a2 + kstep; const char* b3 = b2 + kstep;
            if (last && has_next) S.a_ready(nxt);
            if constexpr (SP2) {
            PG8_LDB(B0, 0, 0); PG8_LDB(B1, 0, 1); PG8_SCHED; PG8_LDA(At, 0, 0); PG8_STAGE(PG8_SA(1, 1), a1 + hstepA, voffA);
            PG8_WAIT_V(8); PG8_WAIT_L(0); PG8_BAR; PG8_MMA(0, 0, At, B0); PG8_MMA(0, 1, At, B1); PG8_BAR; PG8_SCHED;
            PG8_LDA(At, 0, 1); PG8_STAGE(PG8_SB(0, 0), b2, voffB); PG8_STAGE(PG8_SB(0, 1), b2 + hstepB, voffB); PG8_STAGE(PG8_SA(0, 0), a2, voffA);
            PG8_WAIT_V(8); PG8_WAIT_L(0); PG8_BAR; PG8_MMA(1, 0, At, B0); PG8_MMA(1, 1, At, B1); PG8_BAR; PG8_SCHED;
            PG8_LDB(B0, 1, 0); PG8_LDB(B1, 1, 1); PG8_SCHED; PG8_LDA(At, 1, 0); PG8_STAGE(PG8_SA(0, 1), a2 + hstepA, voffA);
            PG8_WAIT_V(8); PG8_WAIT_L(0); PG8_BAR; PG8_MMA(0, 0, At, B0); PG8_MMA(0, 1, At, B1); PG8_BAR; PG8_SCHED;
            PG8_LDA(At, 1, 1); PG8_STAGE(PG8_SB(1, 0), b3, voffB); PG8_STAGE(PG8_SB(1, 1), b3 + hstepB, voffB); PG8_STAGE(PG8_SA(1, 0), a3, voffA);
            PG8_WAIT_V(8); PG8_WAIT_L(0); PG8_BAR; PG8_MMA(1, 0, At, B0); PG8_MMA(1, 1, At, B1); PG8_BAR; PG8_SCHED;
            } else {
            PG8_LDB(B0, 0, 0); PG8_SCHED; PG8_LDA(At, 0, 0); PG8_STAGE(PG8_SA(1, 1), a1 + hstepA, voffA);
            PG8_WAIT_L(8); PG8_BAR; PG8_WAIT_L(0); PG8_MMA(0, 0, At, B0); PG8_BAR; PG8_SCHED;
            PG8_LDB(B1, 0, 1); PG8_STAGE(PG8_SB(0, 0), b2, voffB);
            PG8_BAR; PG8_WAIT_L(0); PG8_MMA(0, 1, At, B1); PG8_BAR;
            PG8_LDA(At, 0, 1); PG8_STAGE(PG8_SA(0, 0), a2, voffA);
            PG8_BAR; PG8_WAIT_L(0); PG8_MMA(1, 0, At, B0); PG8_BAR; PG8_SCHED;
            PG8_STAGE(PG8_SB(0, 1), b2 + hstepB, voffB);
            PG8_WAIT_V(6); PG8_BAR; PG8_MMA(1, 1, At, B1); PG8_BAR;
            PG8_LDB(B0, 1, 0); PG8_SCHED; PG8_LDA(At, 1, 0); PG8_STAGE(PG8_SA(0, 1), a2 + hstepA, voffA);
            PG8_WAIT_L(8); PG8_BAR; PG8_WAIT_L(0); PG8_MMA(0, 0, At, B0); PG8_BAR; PG8_SCHED;
            PG8_LDB(B1, 1, 1); PG8_STAGE(PG8_SB(1, 0), b3, voffB);
            PG8_BAR; PG8_WAIT_L(0); PG8_MMA(0, 1, At, B1); PG8_BAR;
            PG8_LDA(At, 1, 1); PG8_STAGE(PG8_SA(1, 0), a3, voffA);
            PG8_BAR; PG8_WAIT_L(0); PG8_MMA(1, 0, At, B0); PG8_BAR; PG8_SCHED;
            PG8_STAGE(PG8_SB(1, 1), b3 + hstepB, voffB);
            PG8_WAIT_V(6); PG8_BAR; PG8_MMA(1, 1, At, B1); PG8_BAR;
            }
        }
        if constexpr (ALIGN_EPI) { if (wr == 0) PG8_BAR; }
        E(acc, cur, wr, wc, fr, fq); S.done(cur);
        if (!has_next) break;
#pragma unroll
        for (int a = 0; a < 2; ++a)
#pragma unroll
            for (int b = 0; b < 2; ++b)
#pragma unroll
                for (int m = 0; m < 4; ++m)
#pragma unroll
                    for (int n = 0; n < 2; ++n) acc[a][b][m][n] = (f32x4){0.f, 0.f, 0.f, 0.f};
        cur = nxt; cA = nA; cA2 = nA2; cB = nB; ++ui;
        if constexpr (ALIGN_EPI) { if (wr == 1) PG8_BAR; }
    }
    PG8_WAIT_V(0);
    if constexpr (!ALIGN_EPI) { if (wr == 0) PG8_BAR; }
    PG8_BAR;

#undef PG8_SA
#undef PG8_SB
#undef PG8_STAGE
#undef PG8_LDA
#undef PG8_LDB
#undef PG8_MMA
#undef PG8_WAIT_V
#undef PG8_WAIT_L
#undef PG8_BAR
#undef PG8_SCHED
}
}

constexpr int NWAVES = 8;
constexpr int BATCH = 4, SEQ = 4096, DM = 1024, M = BATCH * SEQ, FF = 2816, INW = 6672;
constexpr int NGU = 2 * FF;
constexpr int ZP = 4608;
constexpr int NWIN = 4864;
constexpr int NZREAL = 4624;
constexpr size_t MiB = 1u << 20;
constexpr size_t WS_CTL = 0, CTL_ZERO_BYTES = 1 * MiB;
constexpr size_t WS_BIN = 1 * MiB, WS_BG = WS_BIN + 32768;
constexpr size_t WS_WG = 2 * MiB, WS_WPROJ = 6 * MiB, WS_WOUT = 10 * MiB, WS_WGU2 = 12 * MiB, WS_WD2 = 23 * MiB;
constexpr size_t WS_ST = 29 * MiB;
constexpr size_t WS_WGU1 = 29 * MiB, WS_WD1 = 40 * MiB, WS_WIN = WS_WD1 + 5767168;
constexpr size_t WS_XB = 61 * MiB;
constexpr size_t WS_BIG = 93 * MiB;
constexpr size_t WS_IF = 237 * MiB;
constexpr size_t WS_END = 240 * MiB;
static_assert(WS_WIN + (size_t)NWIN * 1024 * 2 <= WS_XB && WS_ST + 32 * MiB <= WS_XB && WS_WD2 + (size_t)1024 * FF * 2 <= WS_ST, "ws map");
constexpr int CW_BAR = 4096;
constexpr size_t CTL_SSQ = 512 * 1024;
constexpr int RING_OFF = 0, RING_BYTES = 131072;
constexpr int LDSCTL_OFF = RING_BYTES, MISC_OFF = LDSCTL_OFF + 320;
constexpr int LDS_BYTES = 147456;

#define GAS __attribute__((address_space(1)))
#define LAS __attribute__((address_space(3)))
typedef unsigned short bf16;
typedef unsigned v4u __attribute__((ext_vector_type(4)));
typedef unsigned v2u __attribute__((ext_vector_type(2)));
typedef float f32x4 __attribute__((ext_vector_type(4)));
typedef short bf16x8 __attribute__((ext_vector_type(8)));
typedef GAS unsigned gu32;
#define RLX_AGENT __ATOMIC_RELAXED, __HIP_MEMORY_SCOPE_AGENT
#define LDS_WAIT() asm volatile("s_waitcnt lgkmcnt(0)" ::: "memory")
#define VM_WAIT() asm volatile("s_waitcnt vmcnt(0)" ::: "memory")
__device__ __forceinline__ unsigned f2bf(float f) { unsigned u = __builtin_bit_cast(unsigned, f); return (u + 0x7fffu + ((u >> 16) & 1u)) >> 16; }
__device__ __forceinline__ unsigned pk2(float lo, float hi) { return f2bf(lo) | (f2bf(hi) << 16); }
__device__ __forceinline__ float bf2f(unsigned short b) { return __builtin_bit_cast(float, (unsigned)b << 16); }

#define XB_TMO      128
#define XB_XCNT(j)  (256  + 64 * (j))
#define XB_XSUB(j)  (1280 + 64 * (j))
#define XB_XGEN(j)  (2304 + 64 * (j))
#define XB_TOP      3328
#define XB_TOPGEN   3392
#define XCD_BAR_WORDS 3456
#define XB_SPIN_CAP (1u << 18)
__device__ __forceinline__ unsigned xb_ld(unsigned* p)              { return __hip_atomic_load(p, __ATOMIC_RELAXED, __HIP_MEMORY_SCOPE_AGENT); }
__device__ __forceinline__ unsigned xb_add(unsigned* p, unsigned v) { return __hip_atomic_fetch_add(p, v, __ATOMIC_RELAXED, __HIP_MEMORY_SCOPE_AGENT); }
__device__ __forceinline__ unsigned xb_xcc_id() { return (unsigned)__builtin_amdgcn_s_getreg((3 << 11) | 20) & 0xFu; }
#define XB_SPIN(cond, bar) do { unsigned _sp = 0; while (cond) { __builtin_amdgcn_s_sleep(1); \
    if ((++_sp & 255u) == 0u) { if (xb_ld(&(bar)[XB_TMO])) break; if (_sp > XB_SPIN_CAP) { atomicAdd(&(bar)[XB_TMO], 1u); break; } } } } while (0)
struct XcdBarrier { unsigned* bar; unsigned x; volatile LAS unsigned* st; };
__device__ __forceinline__ XcdBarrier xcd_barrier_post(unsigned* bar, volatile LAS unsigned* st) {
    XcdBarrier b; b.bar = bar; b.x = xb_xcc_id(); b.st = st;
    if (threadIdx.x == 0) (void)xb_add(&bar[XB_XCNT(b.x)], 1u);
    return b;
}
__device__ __forceinline__ void xcd_barrier_complete(unsigned* bar, unsigned x, unsigned& nloc, unsigned& nx) {
    const unsigned G = gridDim.x * gridDim.y * gridDim.z;
    unsigned sum, cnt, mine, sp = 0u;
    for (;;) {
        sum = 0u; cnt = 0u; mine = 0u;
#pragma unroll
        for (unsigned j = 0; j < 16; ++j) { const unsigned c = xb_ld(&bar[XB_XCNT(j)]); sum += c; cnt += (c > 0u) ? 1u : 0u; mine = (j == x) ? c : mine; }
        if (sum == G) break;
        __builtin_amdgcn_s_sleep(1);
        if ((++sp & 255u) == 0u) { if (xb_ld(&bar[XB_TMO])) break; if (sp > XB_SPIN_CAP) { atomicAdd(&bar[XB_TMO], 1u); break; } }
    }
    nloc = mine > 0u ? mine : 1u; nx = cnt > 0u ? cnt : 1u;
}
__device__ __forceinline__ void xcd_barrier(const XcdBarrier& b) {
    asm volatile("s_waitcnt vmcnt(0)" ::: "memory");
    __syncthreads();
    if (threadIdx.x == 0) {
        unsigned* bar = b.bar;
        __builtin_amdgcn_s_waitcnt(0);
        unsigned nloc = b.st[0], nx = b.st[1];
        if (nloc == 0u) { xcd_barrier_complete(bar, b.x, nloc, nx); b.st[0] = nloc; b.st[1] = nx; }
        const unsigned old = xb_add(&bar[XB_XSUB(b.x)], 1u);
        const unsigned gen = old / nloc;
        if (old + 1u == (gen + 1u) * nloc) {
            __builtin_amdgcn_fence(__ATOMIC_RELEASE, "agent");
            asm volatile("s_waitcnt vmcnt(0)" ::: "memory");
            const unsigned og = xb_add(&bar[XB_TOP], 1u);
            const unsigned tg = og / nx;
            if (og + 1u == (tg + 1u) * nx) xb_add(&bar[XB_TOPGEN], 1u);
            else XB_SPIN(xb_ld(&bar[XB_TOPGEN]) == tg, bar);
            __builtin_amdgcn_fence(__ATOMIC_ACQUIRE, "agent");
            xb_add(&bar[XB_XGEN(b.x)], 1u);
            asm volatile("s_waitcnt vmcnt(0)" ::: "memory");
        } else {
            XB_SPIN(xb_ld(&bar[XB_XGEN(b.x)]) == gen, bar);
            __builtin_amdgcn_fence(__ATOMIC_ACQUIRE, "agent");
            asm volatile("s_waitcnt vmcnt(0)" ::: "memory");
        }
    }
    __syncthreads();
}

__device__ __forceinline__ float wave_sum(float v) {
#pragma unroll
    for (int o = 1; o < 64; o <<= 1) v += __shfl_xor(v, o);
    return v;
}
template <class RowMap>
__device__ __forceinline__ void transpose_item(const float* W, int N, const float* g, LAS float* scr, int item, int lane, const RowMap& rm) {
    const int nblk = (N + 31) / 32, kb = item / nblk, nb = item % nblk, k0 = 64 * kb, n0 = 32 * nb;
    const int nl = lane & 31, nsrc = n0 + nl;
#pragma unroll 8
    for (int i = 0; i < 32; ++i) { const int kk = 2 * i + (lane >> 5); float v = nsrc < N ? W[(size_t)(k0 + kk) * N + nsrc] : 0.f; if (g) v *= g[k0 + kk]; scr[kk * 33 + nl] = v; }
    LDS_WAIT(); asm volatile("" ::: "memory");
    const int c = lane & 7;
#pragma unroll
    for (int j = 0; j < 4; ++j) { const int n = (lane >> 3) + 8 * j; const LAS float* s = scr + (8 * c) * 33 + n;
        v4u o; o.x = pk2(s[0 * 33], s[1 * 33]); o.y = pk2(s[2 * 33], s[3 * 33]); o.z = pk2(s[4 * 33], s[5 * 33]); o.w = pk2(s[6 * 33], s[7 * 33]);
        if (n0 + n < N) *(GAS v4u*)(rm(n0 + n) + k0 + 8 * c) = o; }
    LDS_WAIT(); asm volatile("" ::: "memory");
}
struct RmGate { bf16* W; __device__ __forceinline__ bf16* operator()(int n) const { return W + (size_t)(256 * (n >> 7) + (n & 127)) * 1024; } };
struct RmUp   { bf16* W; __device__ __forceinline__ bf16* operator()(int n) const { return W + (size_t)(256 * (n >> 7) + 128 + (n & 127)) * 1024; } };
struct RmLin  { bf16* W; int ld, koff; __device__ __forceinline__ bf16* operator()(int n) const { return W + (size_t)n * ld + koff; } };
struct RmWin  { bf16* Win; bf16* Wg; __device__ __forceinline__ bf16* operator()(int n) const { return n < NZREAL ? Win + (size_t)n * 1024 : Wg + (size_t)(n - NZREAL) * 1024; } };

struct Args { const float* in[19]; float* out; unsigned char* ws; int ph_lo, ph_hi, use_bar, pad; };

__global__ void __launch_bounds__(NWAVES * 64, 2) mk_fwd(Args args) {
    extern __shared__ __attribute__((aligned(16))) unsigned char lds_raw[];
    LAS unsigned char* lds = (LAS unsigned char*)lds_raw;
    volatile LAS unsigned* MISC = (volatile LAS unsigned*)(lds + MISC_OFF);
    const int tid = threadIdx.x, lane = tid & 63, wave = __builtin_amdgcn_readfirstlane(tid >> 6);
    const int G = gridDim.x, bx = blockIdx.x, vcu = (G % 8 == 0) ? (bx % 8) * (G / 8) + bx / 8 : bx;
    unsigned char* ws = args.ws;
    gu32* ctl = (gu32*)(ws + WS_CTL);
    float* SSQ = (float*)(ws + WS_CTL + CTL_SSQ);
    const float* x = args.in[0];
    bf16 *WGU1 = (bf16*)(ws + WS_WGU1), *WD1 = (bf16*)(ws + WS_WD1), *WIN = (bf16*)(ws + WS_WIN), *WG = (bf16*)(ws + WS_WG), *WPROJ = (bf16*)(ws + WS_WPROJ),
         *WOUT = (bf16*)(ws + WS_WOUT), *WGU2 = (bf16*)(ws + WS_WGU2), *WD2 = (bf16*)(ws + WS_WD2);
    bf16 *XB = (bf16*)(ws + WS_XB), *BIG = (bf16*)(ws + WS_BIG);
    float *BIN = (float*)(ws + WS_BIN), *BG = (float*)(ws + WS_BG), *IFB = (float*)(ws + WS_IF);
    bf16* MG = (bf16*)(ws + WS_ST);
    for (int u = tid; u < (LDS_BYTES - LDSCTL_OFF) / 4; u += NWAVES * 64) ((LAS unsigned*)(lds + LDSCTL_OFF))[u] = 0u;
    __syncthreads();
    XcdBarrier bar; bar.bar = (unsigned*)(ctl + CW_BAR); bar.x = 0; bar.st = nullptr;
    if (args.use_bar) bar = xcd_barrier_post((unsigned*)(ctl + CW_BAR), MISC + 8);
    const int lo = args.ph_lo, hi = args.ph_hi;
#define IN(k) (lo <= (k) && (k) < hi)
#define SEAM(k) do { if (IN(k) && IN((k) + 1)) xcd_barrier(bar); } while (0)

    if (IN(0)) {
        LAS float* scr = (LAS float*)(lds + RING_OFF + wave * 16384);
        const int gw = vcu * NWAVES + wave, NGW = G * NWAVES;
        constexpr int I_GU = 16 * (FF / 32), I_D = (FF / 64) * 32, I_WIN = 16 * ((INW + 31) / 32), I_SQ = 16 * 32;
        constexpr int NITEMS = 4 * I_GU + 2 * I_D + I_WIN + 3 * I_SQ;
        for (int it = gw; it < NITEMS; it += NGW) {
            int r = it;
            if (r < I_GU) { transpose_item(args.in[2], FF, args.in[1], scr, r, lane, RmGate{WGU1}); continue; } r -= I_GU;
            if (r < I_GU) { transpose_item(args.in[3], FF, args.in[1], scr, r, lane, RmUp{WGU1}); continue; } r -= I_GU;
            if (r < I_D) { transpose_item(args.in[4], DM, nullptr, scr, r, lane, RmLin{WD1, FF, 0}); continue; } r -= I_D;
            if (r < I_WIN) { transpose_item(args.in[6], INW, args.in[5], scr, r, lane, RmWin{WIN, WG}); continue; } r -= I_WIN;
            if (r < I_SQ) { transpose_item(args.in[11], DM, nullptr, scr, r, lane, RmLin{WPROJ, 2048, 0}); continue; } r -= I_SQ;
            if (r < I_SQ) { transpose_item(args.in[12], DM, nullptr, scr, r, lane, RmLin{WPROJ, 2048, 1024}); continue; } r -= I_SQ;
            if (r < I_SQ) { transpose_item(args.in[13], DM, nullptr, scr, r, lane, RmLin{WOUT, 1024, 0}); continue; } r -= I_SQ;
            if (r < I_GU) { transpose_item(args.in[15], FF, args.in[14], scr, r, lane, RmGate{WGU2}); continue; } r -= I_GU;
            if (r < I_GU) { transpose_item(args.in[16], FF, args.in[14], scr, r, lane, RmUp{WGU2}); continue; } r -= I_GU;
            transpose_item(args.in[17], DM, nullptr, scr, r, lane, RmLin{WD2, FF, 0});
        }
        { const int gt = vcu * (NWAVES * 64) + tid, NGT = G * NWAVES * 64;
          GAS v4u* z = (GAS v4u*)(WIN + (size_t)NZREAL * 1024);
          for (int i = gt; i < (NWIN - NZREAL) * 1024 * 2 / 16; i += NGT) z[i] = (v4u){0u, 0u, 0u, 0u};
          for (int i = gt; i < NWIN; i += NGT) BIN[i] = i < NZREAL ? args.in[7][i] : 0.f;
          for (int i = gt; i < 2048; i += NGT) BG[i] = args.in[7][NZREAL + i]; }
        for (int m = gw; m < M; m += NGW) {
            const GAS f32x4* xr = (const GAS f32x4*)(x + (size_t)m * DM) + lane;
            f32x4 v[4]; float s = 0.f;
#pragma unroll
            for (int j = 0; j < 4; ++j) { v[j] = xr[64 * j]; s += (v[j].x * v[j].x + v[j].y * v[j].y) + (v[j].z * v[j].z + v[j].w * v[j].w); }
            s = wave_sum(s);
            GAS v2u* o8 = (GAS v2u*)(XB + (size_t)m * DM) + lane;
#pragma unroll
            for (int j = 0; j < 4; ++j) o8[64 * j] = (v2u){pk2(v[j].x, v[j].y), pk2(v[j].z, v[j].w)};
            if (lane == 0) SSQ[m] = s;
        }
        SEAM(0);
    }
    if (IN(1)) {
        pg8::Gemm g{XB, XB, WGU1, 1024, 1024, 1024, 1 << 30}; pg8::StaticOrder S; S.init(M, NGU, G, bx);
        pg8::EpiSwiglu E{BIG, FF, SSQ};
        pg8::gemm_phase<pg8::EpiSwiglu, pg8::StaticOrder, true, true>(lds + RING_OFF, g, S, E);
        SEAM(1);
    }
    if (IN(2)) {
        pg8::Gemm g{BIG, BIG, WD1, FF, FF, FF, 1 << 30}; pg8::StaticOrder S; S.init(M, DM, G, bx);
        pg8::EpiRes E{x, args.out, XB, SSQ + M, 0.5f};
        pg8::gemm_phase<pg8::EpiRes, pg8::StaticOrder, true, true>(lds + RING_OFF, g, S, E);
        SEAM(2);
    }

    if (IN(3)) {
        pg8::Gemm g{XB, XB, WIN, 1024, 1024, 1024, 1 << 30}; pg8::StaticOrder S; S.init(M, NWIN, G, bx);
        pg8::EpiWin E{BIG, ZP, IFB, BIN, SSQ + M};
        pg8::gemm_phase<pg8::EpiWin, pg8::StaticOrder, true, true>(lds + RING_OFF, g, S, E);
        SEAM(3);
    }
    if (IN(5)) {
        pg8::Gemm g{XB, XB, WG, 1024, 1024, 1024, 1 << 30}; pg8::StaticOrder S; S.init(M, 2048, G, bx);
        pg8::EpiGate E{BIG, ZP, 1536, 3584, BG, SSQ + M};
        pg8::gemm_phase<pg8::EpiGate, pg8::StaticOrder, true, true>(lds + RING_OFF, g, S, E);
        SEAM(5);
    }
    if (IN(6)) {
        pg8::Gemm g{BIG, BIG + 2560 - 1024, WPROJ, ZP, 2048, 2048, 16}; pg8::StaticOrder S; S.init(M, DM, G, bx);
        pg8::EpiProj E{BIG, ZP, 1536, 3584, MG};
        pg8::gemm_phase<pg8::EpiProj, pg8::StaticOrder, true, true>(lds + RING_OFF, g, S, E);
        SEAM(6);
    }
    if (IN(7)) {
        pg8::Gemm g{MG, MG, WOUT, 1024, 1024, 1024, 1 << 30}; pg8::StaticOrder S; S.init(M, DM, G, bx);
        pg8::EpiRes E{args.out, args.out, XB, SSQ + 2 * M, 1.0f};
        pg8::gemm_phase<pg8::EpiRes, pg8::StaticOrder, true, true>(lds + RING_OFF, g, S, E);
        SEAM(7);
    }
    if (IN(8)) {
        pg8::Gemm g{XB, XB, WGU2, 1024, 1024, 1024, 1 << 30}; pg8::StaticOrder S; S.init(M, NGU, G, bx);
        pg8::EpiSwiglu E{BIG, FF, SSQ + 2 * M};
        pg8::gemm_phase<pg8::EpiSwiglu, pg8::StaticOrder, true, true>(lds + RING_OFF, g, S, E);
        SEAM(8);
    }
    if (IN(9)) {
        pg8::Gemm g{BIG, BIG, WD2, FF, FF, FF, 1 << 30}; pg8::StaticOrder S; S.init(M, DM, G, bx);
        pg8::EpiRes E{args.out, args.out, nullptr, SSQ + 3 * M, 0.5f};
        pg8::gemm_phase<pg8::EpiRes, pg8::StaticOrder, true, true>(lds + RING_OFF, g, S, E);
        SEAM(9);
    }
    if (IN(10)) {
        const int gw = vcu * NWAVES + wave, NGW = G * NWAVES; const float* gf = args.in[18];
        for (int m = gw; m < M; m += NGW) {
            GAS f32x4* xr = (GAS f32x4*)(args.out + (size_t)m * DM) + lane;
            const float rs = pg8::rstd_of(SSQ[3 * M + m]);
#pragma unroll
            for (int j = 0; j < 4; ++j) { const f32x4 gv = *((const f32x4*)gf + lane + 64 * j); f32x4 v = xr[64 * j]; xr[64 * j] = v * rs * gv; }
        }
    }
#undef IN
#undef SEAM
}

namespace nv {
constexpr int S = 4096, AH = 16, AKV = 4, HD = 64, WIN_ = 128, MH = 8, CH = 64;
constexpr float EPS = 1e-6f, CAP = 15.0f;
__device__ __forceinline__ float sigmoidf_(float x) { return 1.0f / (1.0f + expf(-x)); }
__device__ __forceinline__ float siluf_(float x) { return x / (1.0f + expf(-x)); }
__device__ __forceinline__ float ld(const bf16* p) { return bf2f(*p); }
__device__ __forceinline__ void st(bf16* p, float v) { *p = (bf16)f2bf(v); }
__global__ void attn_k(bf16* Z, const float* __restrict__ sinks) {
    const int w = blockIdx.x * 4 + (threadIdx.x >> 6), lane = threadIdx.x & 63;
    const int r = w / AH, hq = w % AH, hk = hq / (AH / AKV), t = r % S, rb = r - t;
    const float q = ld(Z + (size_t)r * ZP + hq * HD + lane);
    float m = sinks[hq], l = 1.0f, acc = 0.f;
    const int j0 = t - (WIN_ - 1) < 0 ? 0 : t - (WIN_ - 1);
    for (int j = j0; j <= t; ++j) {
        const float kv = ld(Z + (size_t)(rb + j) * ZP + 1024 + hk * HD + lane);
        const float s = wave_sum(q * kv) * 0.125f;
        const float mn = fmaxf(m, s), f = expf(m - mn), p = expf(s - mn);
        l = l * f + p; acc = acc * f + p * ld(Z + (size_t)(rb + j) * ZP + 1280 + hk * HD + lane); m = mn;
    }
    st(Z + (size_t)r * ZP + hq * HD + lane, acc / l);
}
__global__ void conv_k(const bf16* __restrict__ Z, const float* __restrict__ cw, bf16* __restrict__ qk) {
    const int idx = blockIdx.x * 256 + threadIdx.x; const int r = idx >> 10, c = idx & 1023, t = r % S;
    float a = 0.f;
#pragma unroll
    for (int j = 0; j < 4; ++j) { const int tt = t - 3 + j; if (tt >= 0) a += ld(Z + (size_t)(r - 3 + j) * ZP + 1536 + c) * cw[j * 1024 + c]; }
    a = siluf_(a); if (c >= 512) a *= 0.125f;
    st(qk + (size_t)r * 1024 + c, a);
}
constexpr int MLSTM_LDS = (64 * 128 * 3 + 64 * 65 * 3 + 64 * 6 + 8 + 64) * 4;
__global__ void __launch_bounds__(256) mlstm_k(bf16* Z, const float* __restrict__ IF, const bf16* __restrict__ qk, const float* __restrict__ hnorm) {
    extern __shared__ float sm[];
    float* Cs = sm; float* qs = Cs + 64 * 128; float* ks = qs + 64 * 65; float* vs = ks + 64 * 65; float* Ss = vs + 64 * 128; float* ns = Ss + 64 * 65;
    float* ig = ns + 64; float* cum = ig + 64; float* mt = cum + 64; float* wint = mt + 64; float* wk = wint + 64; float* hs = wk + 64; float* sc = hs + 64 * 128; float* den = sc + 8;
    const int h = blockIdx.x % MH, b = blockIdx.x / MH, tid = threadIdx.x;
    for (int i = tid; i < 64 * 128; i += 256) Cs[i] = 0.f;
    if (tid < 64) ns[tid] = 0.f;
    if (tid == 0) sc[0] = 0.f;
    __syncthreads();
    for (int c = 0; c < S / CH; ++c) {
        const size_t r0 = (size_t)b * S + c * CH;
        for (int i = tid; i < 64 * 64; i += 256) { const int t = i >> 6, d = i & 63; qs[t * 65 + d] = ld(qk + (r0 + t) * 1024 + h * 64 + d); ks[t * 65 + d] = ld(qk + (r0 + t) * 1024 + 512 + h * 64 + d); }
        for (int i = tid; i < 64 * 128; i += 256) { const int t = i >> 7, v = i & 127; vs[i] = ld(Z + (r0 + t) * ZP + 2560 + h * 128 + v); }
        if (tid < 64) {
            const float ip = IF[(r0 + tid) * 16 + h], fp = IF[(r0 + tid) * 16 + 8 + h];
            ig[tid] = CAP * tanhf(ip / CAP);
            const float fc = CAP * tanhf(fp / CAP);
            cum[tid] = fc >= 0.f ? -log1pf(expf(-fc)) : fc - log1pf(expf(fc));
        }
        __syncthreads();
        if (tid == 0) { float a = 0.f; for (int t = 0; t < 64; ++t) { a += cum[t]; cum[t] = a; } }
        __syncthreads();
        const float m_prev = sc[0];
        if (tid < 64) {
            float mx = -INFINITY;
            for (int s = 0; s <= tid; ++s) mx = fmaxf(mx, cum[tid] - cum[s] + ig[s]);
            const float li = cum[tid] + m_prev, m = fmaxf(li, mx);
            mt[tid] = m; wint[tid] = expf(li - m);
        }
        if (tid == 64) {
            const float total = cum[63]; float mx = -INFINITY;
            for (int s = 0; s < 64; ++s) mx = fmaxf(mx, total - cum[s] + ig[s]);
            const float mn = fmaxf(total + m_prev, mx);
            sc[1] = mn; sc[2] = expf(total + m_prev - mn);
        }
        __syncthreads();
        if (tid < 64) wk[tid] = expf(cum[63] - cum[tid] + ig[tid] - sc[1]);
        for (int i = tid; i < 64 * 64; i += 256) {
            const int t = i >> 6, s = i & 63; float v = 0.f;
            if (s <= t) { float d = 0.f; for (int k = 0; k < 64; ++k) d = fmaf(qs[t * 65 + k], ks[s * 65 + k], d); v = d * expf(cum[t] - cum[s] + ig[s] - mt[t]); }
            Ss[t * 65 + s] = v;
        }
        __syncthreads();
        if (tid < 64) { float d = 0.f; for (int s = 0; s < 64; ++s) d += Ss[tid * 65 + s]; float qn = 0.f; for (int k = 0; k < 64; ++k) qn = fmaf(qs[tid * 65 + k], ns[k], qn);
            d += wint[tid] * qn; den[tid] = fmaxf(fabsf(d), expf(-mt[tid])); }
        __syncthreads();
        for (int i = tid; i < 64 * 128; i += 256) {
            const int t = i >> 7, v = i & 127; float a = 0.f, bq = 0.f;
            for (int s = 0; s <= t; ++s) a = fmaf(Ss[t * 65 + s], vs[s * 128 + v], a);
            for (int k = 0; k < 64; ++k) bq = fmaf(qs[t * 65 + k], Cs[k * 128 + v], bq);
            hs[i] = (a + wint[t] * bq) / den[t];
        }
        __syncthreads();
        for (int i = tid; i < 64 * 128; i += 256) {
            const int d = i >> 7, v = i & 127; float a = 0.f;
            for (int s = 0; s < 64; ++s) a = fmaf(wk[s] * ks[s * 65 + d], vs[s * 128 + v], a);
            Cs[i] = sc[2] * Cs[i] + a;
        }
        if (tid < 64) { float a = 0.f; for (int s = 0; s < 64; ++s) a = fmaf(wk[s], ks[s * 65 + tid], a); ns[tid] = sc[2] * ns[tid] + a; }
        {
            const int wv = tid >> 6, lane = tid & 63;
            for (int t = wv; t < 64; t += 4) {
                const float a = hs[t * 128 + lane], bb = hs[t * 128 + 64 + lane];
                const float rr = rsqrtf(wave_sum(a * a + bb * bb) * (1.0f / 128.0f) + EPS);
                bf16* zr = Z + (r0 + t) * ZP;
                st(zr + 2560 + h * 128 + lane, sigmoidf_(ld(zr + 3584 + h * 128 + lane)) * a * rr * hnorm[h * 128 + lane]);
                st(zr + 2560 + h * 128 + 64 + lane, sigmoidf_(ld(zr + 3584 + h * 128 + 64 + lane)) * bb * rr * hnorm[h * 128 + 64 + lane]);
            }
        }
        __syncthreads();
        if (tid == 0) sc[0] = sc[1];
        __syncthreads();
    }
}
}

extern "C" void kernel_launch(void* const* d_in, const int* in_sizes, int n_in, void* d_out, int out_size, void* d_ws, size_t ws_size, hipStream_t stream) {
    static int grid = 0;
    if (grid == 0) {
        int dev = 0, cus = 0, per_cu = 0;
        if (n_in != 19 || out_size != M * DM || ws_size < WS_END) { fprintf(stderr, "kernel_launch: unexpected problem shape (n_in %d out %d ws %zu)\n", n_in, out_size, ws_size); grid = -1; return; }
        if (hipGetDevice(&dev) != hipSuccess || hipDeviceGetAttribute(&cus, hipDeviceAttributeMultiprocessorCount, dev) != hipSuccess) { grid = -1; return; }
        if (hipFuncSetAttribute((const void*)mk_fwd, hipFuncAttributeMaxDynamicSharedMemorySize, LDS_BYTES) != hipSuccess) { fprintf(stderr, "kernel_launch: hipFuncSetAttribute failed\n"); grid = -1; return; }
        if (hipOccupancyMaxActiveBlocksPerMultiprocessor(&per_cu, (const void*)mk_fwd, NWAVES * 64, LDS_BYTES) != hipSuccess || per_cu < 1) { fprintf(stderr, "kernel_launch: occupancy query says %d blocks per CU\n", per_cu); grid = -1; return; }
        (void)hipGetLastError();
        grid = cus;
        (void)hipFuncSetAttribute((const void*)nv::mlstm_k, hipFuncAttributeMaxDynamicSharedMemorySize, nv::MLSTM_LDS);
    }
    if (grid < 0) return;
    (void)hipMemsetAsync((char*)d_ws + WS_CTL, 0, CTL_ZERO_BYTES, stream);
    Args a{};
    for (int i = 0; i < 19; ++i) a.in[i] = (const float*)d_in[i];
    a.out = (float*)d_out; a.ws = (unsigned char*)d_ws; a.use_bar = 0;
    auto run = [&](int lo, int hi) { for (int ph = lo; ph < hi; ++ph) { a.ph_lo = ph; a.ph_hi = ph + 1; hipLaunchKernelGGL(mk_fwd, dim3(grid), dim3(NWAVES * 64), LDS_BYTES, stream, a); } };
    run(0, 4);
    {
        bf16* Z = (bf16*)((char*)d_ws + WS_BIG); bf16* qk = (bf16*)((char*)d_ws + WS_ST); const float* IFp = (const float*)((char*)d_ws + WS_IF);
        nv::attn_k<<<M * 16 / 4, 256, 0, stream>>>(Z, (const float*)d_in[8]);
        nv::conv_k<<<M * 1024 / 256, 256, 0, stream>>>(Z, (const float*)d_in[9], qk);
        nv::mlstm_k<<<BATCH * 8, 256, nv::MLSTM_LDS, stream>>>(Z, IFp, qk, (const float*)d_in[10]);
    }
    run(5, 11);
}
```

```cpp
#include <hip/hip_runtime.h>
#include <cstdio>
#include <cstdint>
namespace pg8 {
#define PG8_LAS __attribute__((address_space(3)))
typedef unsigned short bf16_t;
typedef short bf16x8 __attribute__((ext_vector_type(8)));
typedef float f32x4 __attribute__((ext_vector_type(4)));
typedef unsigned u32x4 __attribute__((ext_vector_type(4)));
typedef unsigned u32x2 __attribute__((ext_vector_type(2)));
constexpr int BM = 256, BK = 64, HALF = 128, HTB = HALF * BK * 2  , STAGE_BYTES = 8 * HTB, NXCD = 8, WGM = 8;
constexpr float RMS_EPS = 1e-6f;

__host__ __device__ __forceinline__ int lds_byte(int r, int c) { const int st = (r >> 4) * 2 + (c >> 5), rr = r & 15, cc = c & 31, ob = rr * 64 + cc * 2; return st * 1024 + (ob ^ (((ob >> 9) & 1) << 5)); }
__host__ __device__ __forceinline__ void stage_rc(int b, int& R, int& C) { const int st = b / 1024, sb = b % 1024, swz = sb ^ (((sb >> 9) & 1) << 5); R = (st >> 1) * 16 + swz / 64; C = (st & 1) * 32 + (swz % 64) / 2; }
__host__ __device__ __forceinline__ int perm32(int rho) { const int n = rho >> 4, i = rho & 15; return 8 * (i >> 2) + 4 * n + (i & 3); }

struct Unit { int pm, pn; };
struct Gemm { const bf16_t* A; const bf16_t* A2; const bf16_t* Bt; int lda, ldb, K, ksplit; };

struct StaticOrder {
    int nM, nN, nwg, G, c;
    __host__ __device__ void init(int M, int N, int G_, int c_) { nM = M / BM; nN = N / BM; nwg = nM * nN; G = G_; c = c_; }
    __host__ __device__ bool next(int i, Unit& u) const {
        const long L = (long)i * G + c; if (L >= nwg) return false;
        int wgid = (int)L; { const int q = nwg / NXCD, r = nwg % NXCD, xcd = wgid % NXCD, off = wgid / NXCD; wgid = (xcd < r ? xcd * (q + 1) : r * (q + 1) + (xcd - r) * q) + off; }
        const int nig = WGM * nN, gid = wgid / nig, fm = gid * WGM, gsz = (nM - fm) < WGM ? (nM - fm) : WGM;
        u.pm = fm + ((wgid % nig) % gsz); u.pn = (wgid % nig) / gsz; return true;
    }
    __device__ __forceinline__ void a_ready(const Unit&) const {}
    __device__ __forceinline__ void done(const Unit&) const {}
};

__device__ __forceinline__ unsigned cvt_pk_bf16(float lo, float hi) { unsigned r; asm volatile("v_cvt_pk_bf16_f32 %0, %1, %2" : "=v"(r) : "v"(lo), "v"(hi)); return r; }
__device__ __forceinline__ float fast_sigmoid(float x) { return __builtin_amdgcn_rcpf(1.0f + __builtin_amdgcn_exp2f(-1.4426950408889634f * x)); }
__device__ __forceinline__ float rstd_of(float ssq) { return __builtin_amdgcn_rsqf(ssq * (1.0f / 1024.0f) + RMS_EPS); }

struct EpiSwiglu {
    static constexpr bool PERM = true, HAS_MID = false;
    bf16_t* O; int ldo; const float* ssq;
    __device__ __forceinline__ void operator()(const f32x4 (&acc)[2][2][4][2], const Unit& u, int wr, int wc, int fr, int fq) const {
        const int row0 = u.pm * BM + wr * 64 + fr, col0 = u.pn * HALF + wc * 32 + 8 * fq;
#pragma unroll
        for (int ai = 0; ai < 2; ++ai)
#pragma unroll
            for (int m = 0; m < 4; ++m) {
                const int r = row0 + ai * HALF + m * 16; const float rs = rstd_of(ssq[r]);
                float o[8];
#pragma unroll
                for (int n = 0; n < 2; ++n)
#pragma unroll
                    for (int j = 0; j < 4; ++j) { const float gv = acc[ai][0][m][n][j] * rs, uv = acc[ai][1][m][n][j] * rs; o[4 * n + j] = gv * fast_sigmoid(gv) * uv; }
                u32x4 w; w.x = cvt_pk_bf16(o[0], o[1]); w.y = cvt_pk_bf16(o[2], o[3]); w.z = cvt_pk_bf16(o[4], o[5]); w.w = cvt_pk_bf16(o[6], o[7]);
                *(u32x4*)(O + (size_t)r * ldo + col0) = w;
            }
    }
};
struct EpiRes {
    static constexpr bool PERM = false, HAS_MID = false;
    const float* R; float* X; bf16_t* Xb; float* ssq; float alpha;
    __device__ __forceinline__ void operator()(const f32x4 (&acc)[2][2][4][2], const Unit& u, int wr, int wc, int fr, int fq) const {
        const int row0 = u.pm * BM + wr * 64 + fr, col0 = u.pn * BM + wc * 32 + 4 * fq;
#pragma unroll
        for (int ai = 0; ai < 2; ++ai)
#pragma unroll
            for (int m = 0; m < 4; ++m) {
                const int r = row0 + ai * HALF + m * 16; float sq = 0.f;
#pragma unroll
                for (int bj = 0; bj < 2; ++bj)
#pragma unroll
                    for (int n = 0; n < 2; ++n) {
                        const size_t off = (size_t)r * 1024 + col0 + bj * HALF + n * 16;
                        const f32x4 x = *(const f32x4*)(R + off) + acc[ai][bj][m][n] * alpha;
                        *(f32x4*)(X + off) = x; sq += (x[0] * x[0] + x[1] * x[1]) + (x[2] * x[2] + x[3] * x[3]);
                        if (Xb) { u32x2 w; w.x = cvt_pk_bf16(x[0], x[1]); w.y = cvt_pk_bf16(x[2], x[3]); *(u32x2*)(Xb + off) = w; }
                    }
                sq += __shfl_xor(sq, 16); sq += __shfl_xor(sq, 32);
                if (fq == 0) atomicAdd(ssq + r, sq);
            }
    }
};
struct EpiWin {
    static constexpr bool PERM = true, HAS_MID = false;
    bf16_t* Z; int ldz; float* IF; const float* bias; const float* ssq;
    __device__ __forceinline__ void operator()(const f32x4 (&acc)[2][2][4][2], const Unit& u, int wr, int wc, int fr, int fq) const {
        const int row0 = u.pm * BM + wr * 64 + fr, cw = wc * 32 + 8 * fq;
        const bool ztile = u.pn < 18;
#pragma unroll
        for (int ai = 0; ai < 2; ++ai)
#pragma unroll
            for (int m = 0; m < 4; ++m) {
                const int r = row0 + ai * HALF + m * 16; const float rs = rstd_of(ssq[r]);
#pragma unroll
                for (int bj = 0; bj < 2; ++bj) {
                    const int c = u.pn * BM + bj * HALF + cw;
                    const f32x4 v0 = acc[ai][bj][m][0] * rs + *(const f32x4*)(bias + c), v1 = acc[ai][bj][m][1] * rs + *(const f32x4*)(bias + c + 4);
                    if (ztile) { u32x4 w; w.x = cvt_pk_bf16(v0[0], v0[1]); w.y = cvt_pk_bf16(v0[2], v0[3]); w.z = cvt_pk_bf16(v1[0], v1[1]); w.w = cvt_pk_bf16(v1[2], v1[3]);
                        *(u32x4*)(Z + (size_t)r * ldz + c) = w; }
                    else if (bj == 0 && cw < 16) { *(f32x4*)(IF + (size_t)r * 16 + cw) = v0; *(f32x4*)(IF + (size_t)r * 16 + cw + 4) = v1; }
                }
            }
    }
};
struct EpiGate {
    static constexpr bool PERM = true, HAS_MID = false;
    bf16_t* Z; int ldz, off0, off1; const float* bias; const float* ssq;
    __device__ __forceinline__ void operator()(const f32x4 (&acc)[2][2][4][2], const Unit& u, int wr, int wc, int fr, int fq) const {
        const int row0 = u.pm * BM + wr * 64 + fr, cw = wc * 32 + 8 * fq;
        const int cdst0 = (u.pn < 4 ? off0 : off1) + (u.pn & 3) * BM;
#pragma unroll
        for (int ai = 0; ai < 2; ++ai)
#pragma unroll
            for (int m = 0; m < 4; ++m) {
                const int r = row0 + ai * HALF + m * 16; const float rs = rstd_of(ssq[r]);
#pragma unroll
                for (int bj = 0; bj < 2; ++bj) {
                    const int c = u.pn * BM + bj * HALF + cw;
                    const f32x4 v0 = acc[ai][bj][m][0] * rs + *(const f32x4*)(bias + c), v1 = acc[ai][bj][m][1] * rs + *(const f32x4*)(bias + c + 4);
                    u32x4 w; w.x = cvt_pk_bf16(fast_sigmoid(v0[0]), fast_sigmoid(v0[1])); w.y = cvt_pk_bf16(fast_sigmoid(v0[2]), fast_sigmoid(v0[3]));
                    w.z = cvt_pk_bf16(fast_sigmoid(v1[0]), fast_sigmoid(v1[1])); w.w = cvt_pk_bf16(fast_sigmoid(v1[2]), fast_sigmoid(v1[3]));
                    *(u32x4*)(Z + (size_t)r * ldz + cdst0 + bj * HALF + cw) = w;
                }
            }
    }
};
struct EpiProj {
    static constexpr bool PERM = true, HAS_MID = true;
    const bf16_t* Z; int ldz, off0, off1; bf16_t* O;
    __device__ __forceinline__ static float bfl(unsigned w) { return __builtin_bit_cast(float, w << 16); }
    __device__ __forceinline__ static float bfh(unsigned w) { return __builtin_bit_cast(float, w & 0xffff0000u); }
    __device__ __forceinline__ void mid(f32x4 (&acc)[2][2][4][2], const Unit& u, int wr, int wc, int fr, int fq) const {
        unsigned base = (unsigned)((u.pm * BM + wr * 64 + fr) * ldz + u.pn * BM + wc * 32 + 8 * fq) * 2u; asm volatile("" : "+v"(base));
        const char* zb = (const char*)Z;
#pragma unroll
        for (int ai = 0; ai < 2; ++ai)
#pragma unroll
            for (int m = 0; m < 4; ++m) {
#pragma unroll
                for (int bj = 0; bj < 2; ++bj) {
                    const unsigned o = base + (unsigned)(((ai * HALF + m * 16) * ldz + bj * HALF) * 2);
                    const u32x4 a = *(const u32x4*)(zb + o + (unsigned)(off0 * 2)), b = *(const u32x4*)(zb + o + (unsigned)(off1 * 2));
#pragma unroll
                    for (int q = 0; q < 4; ++q) {
                        const float rl = bfl(a[q]) * __builtin_amdgcn_rcpf(fmaxf(bfl(b[q]), 1e-30f)), rh = bfh(a[q]) * __builtin_amdgcn_rcpf(fmaxf(bfh(b[q]), 1e-30f));
                        acc[ai][bj][m][q >> 1][(q & 1) * 2] *= rl; acc[ai][bj][m][q >> 1][(q & 1) * 2 + 1] *= rh;
                    }
                    asm volatile("" ::: "memory");
                }
            }
    }
    __device__ __forceinline__ void operator()(const f32x4 (&acc)[2][2][4][2], const Unit& u, int wr, int wc, int fr, int fq) const {
        const int row0 = u.pm * BM + wr * 64 + fr, cw = wc * 32 + 8 * fq;
#pragma unroll
        for (int ai = 0; ai < 2; ++ai)
#pragma unroll
            for (int m = 0; m < 4; ++m) {
                const int r = row0 + ai * HALF + m * 16;
#pragma unroll
                for (int bj = 0; bj < 2; ++bj) {
                    const int c = u.pn * BM + bj * HALF + cw;
                    const u32x4 b = *(const u32x4*)(Z + (size_t)r * ldz + off1 + c);
                    u32x4 w;
#pragma unroll
                    for (int q = 0; q < 4; ++q) w[q] = cvt_pk_bf16(acc[ai][bj][m][q >> 1][(q & 1) * 2] * fmaxf(bfl(b[q]), 1e-30f), acc[ai][bj][m][q >> 1][(q & 1) * 2 + 1] * fmaxf(bfh(b[q]), 1e-30f));
                    *(u32x4*)(O + (size_t)r * 1024 + c) = w;
                    asm volatile("" ::: "memory");
                }
            }
    }
};
template <class Epi, class Sched, bool ALIGN_EPI = false, bool SP2 = false>
__device__ __forceinline__ void gemm_phase(PG8_LAS unsigned char* lds, const Gemm g, const Sched& S, const Epi& E) {
    const int tid = threadIdx.x, wid = __builtin_amdgcn_readfirstlane(tid >> 6), lane = tid & 63, wr = wid >> 2, wc = wid & 3, fr = lane & 15, fq = lane >> 4;
    const int K = g.K, nt = K / BK;
    unsigned voffA[2], voffB[2];
#pragma unroll
    for (int i = 0; i < 2; ++i) { int R, C; stage_rc(tid * 16 + i * 8192, R, C); const int Rb = Epi::PERM ? ((R & ~31) + perm32(R & 31)) : R;
        voffA[i] = (unsigned)(R * g.lda + C) * 2u; voffB[i] = (unsigned)(Rb * g.ldb + C) * 2u; }
    const size_t kstep = (size_t)(BK * 2);
    const size_t hstepA = (size_t)HALF * g.lda * 2, hstepB = (size_t)HALF * g.ldb * 2;
    const size_t tstepA = 2 * hstepA, tstepB = 2 * hstepB;
    const unsigned ldsw = (unsigned)wid * 1024u;
    const int aoff = lds_byte(wr * 64 + fr, fq * 8), boff = lds_byte(wc * 32 + fr, fq * 8);
#define PG8_SA(b, h) (((b) * 2 + (h)) * HTB)
#define PG8_SB(b, h) ((4 + (b) * 2 + (h)) * HTB)
#define PG8_STAGE(bufoff, gbase, voff) do { _Pragma("unroll") for (int _i = 0; _i < 2; ++_i) \
        __builtin_amdgcn_global_load_lds((const unsigned*)((const char*)(gbase) + (voff)[_i]), (PG8_LAS unsigned*)(lds + (bufoff) + ldsw + _i * 8192), 16, 0, 0); } while (0)
#define PG8_LDA(dst, b, h) do { _Pragma("unroll") for (int m = 0; m < 4; ++m) _Pragma("unroll") for (int k = 0; k < 2; ++k) dst[m][k] = *(const PG8_LAS bf16x8*)(lds + PG8_SA(b, h) + aoff + m * 2048 + k * 1024); } while (0)
#define PG8_LDB(dst, b, h) do { _Pragma("unroll") for (int n = 0; n < 2; ++n) _Pragma("unroll") for (int k = 0; k < 2; ++k) dst[n][k] = *(const PG8_LAS bf16x8*)(lds + PG8_SB(b, h) + boff + n * 2048 + k * 1024); } while (0)
#define PG8_MMA(ai, bj, At, Bt) do { __builtin_amdgcn_s_setprio(1); _Pragma("unroll") for (int m = 0; m < 4; ++m) _Pragma("unroll") for (int n = 0; n < 2; ++n) _Pragma("unroll") for (int k = 0; k < 2; ++k) \
        acc[ai][bj][m][n] = __builtin_amdgcn_mfma_f32_16x16x32_bf16(Bt[n][k], At[m][k], acc[ai][bj][m][n], 0, 0, 0); __builtin_amdgcn_s_setprio(0); } while (0)
#define PG8_WAIT_V(n) asm volatile("s_waitcnt vmcnt(" #n ")" ::: "memory")
#define PG8_WAIT_L(n) asm volatile("s_waitcnt lgkmcnt(" #n ")" ::: "memory")
#define PG8_BAR __builtin_amdgcn_s_barrier()
#define PG8_SCHED __builtin_amdgcn_sched_barrier(0)
    Unit cur, nxt; int ui = 0;
    if (!S.next(0, cur)) return;
    f32x4 acc[2][2][4][2];
#pragma unroll
    for (int a = 0; a < 2; ++a)
#pragma unroll
        for (int b = 0; b < 2; ++b)
#pragma unroll
            for (int m = 0; m < 4; ++m)
#pragma unroll
                for (int n = 0; n < 2; ++n) acc[a][b][m][n] = (f32x4){0.f, 0.f, 0.f, 0.f};
    bf16x8 At[4][2], B0[2][2], B1[2][2];
    const char* cA = (const char*)g.A + (size_t)cur.pm * tstepA; const char* cA2 = (const char*)g.A2 + (size_t)cur.pm * tstepA; const char* cB = (const char*)g.Bt + (size_t)cur.pn * tstepB;
    S.a_ready(cur);
    if constexpr (SP2) {
        PG8_STAGE(PG8_SB(0, 0), cB, voffB); PG8_STAGE(PG8_SB(0, 1), cB + hstepB, voffB); PG8_STAGE(PG8_SA(0, 0), cA, voffA); PG8_STAGE(PG8_SA(0, 1), cA + hstepA, voffA);
        if (wr == 1) PG8_BAR;
        PG8_WAIT_V(2); PG8_BAR;
        PG8_STAGE(PG8_SB(1, 0), cB + kstep, voffB); PG8_STAGE(PG8_SA(1, 0), cA + kstep, voffA); PG8_STAGE(PG8_SB(1, 1), cB + hstepB + kstep, voffB);
        PG8_WAIT_V(6); PG8_BAR;
    } else {
        PG8_STAGE(PG8_SB(0, 0), cB, voffB); PG8_STAGE(PG8_SA(0, 0), cA, voffA); PG8_STAGE(PG8_SB(0, 1), cB + hstepB, voffB); PG8_STAGE(PG8_SA(0, 1), cA + hstepA, voffA);
        if (wr == 1) PG8_BAR;
        PG8_WAIT_V(4); PG8_BAR;
        PG8_STAGE(PG8_SB(1, 0), cB + kstep, voffB); PG8_STAGE(PG8_SA(1, 0), cA + kstep, voffA); PG8_STAGE(PG8_SB(1, 1), cB + hstepB + kstep, voffB);
        PG8_WAIT_V(6); PG8_BAR;
    }
    for (;;) {
        const bool has_next = S.next(ui + 1, nxt);
        const char* nA = has_next ? (const char*)g.A + (size_t)nxt.pm * tstepA : cA; const char* nA2 = has_next ? (const char*)g.A2 + (size_t)nxt.pm * tstepA : cA2; const char* nB = has_next ? (const char*)g.Bt + (size_t)nxt.pn * tstepB : cB;
        for (int t = 0; t < nt; t += 2) {
            const bool last = (t == nt - 2);
            if constexpr (Epi::HAS_MID) { if (t == g.ksplit) E.mid(acc, cur, wr, wc, fr, fq); }
            const char* a1 = ((t + 1) < g.ksplit ? cA : cA2) + (size_t)(t + 1) * kstep;
            const char* a2 = last ? nA : ((t + 2) < g.ksplit ? cA : cA2) + (size_t)(t + 2) * kstep; const char* b2 = last ? nB : cB + (size_t)(t + 2) * kstep;
            const char* a3 = a2 + kstep; const char* b3 = b2 + kstep;
            if (last && has_next) S.a_ready(nxt);
            if constexpr (SP2) {
            PG8_LDB(B0, 0, 0); PG8_LDB(B1, 0, 1); PG8_SCHED; PG8_LDA(At, 0, 0); PG8_STAGE(PG8_SA(1, 1), a1 + hstepA, voffA);
            PG8_WAIT_V(8); PG8_WAIT_L(0); PG8_BAR; PG8_MMA(0, 0, At, B0); PG8_MMA(0, 1, At, B1); PG8_BAR; PG8_SCHED;
            PG8_LDA(At, 0, 1); PG8_STAGE(PG8_SB(0, 0), b2, voffB); PG8_STAGE(PG8_SB(0, 1), b2 + hstepB, voffB); PG8_STAGE(PG8_SA(0, 0), a2, voffA);
            PG8_WAIT_V(8); PG8_WAIT_L(0); PG8_BAR; PG8_MMA(1, 0, At, B0); PG8_MMA(1, 1, At, B1); PG8_BAR; PG8_SCHED;
            PG8_LDB(B0, 1, 0); PG8_LDB(B1, 1, 1); PG8_SCHED; PG8_LDA(At, 1, 0); PG8_STAGE(PG8_SA(0, 1), a2 + hstepA, voffA);
            PG8_WAIT_V(8); PG8_WAIT_L(0); PG8_BAR; PG8_MMA(0, 0, At, B0); PG8_MMA(0, 1, At, B1); PG8_BAR; PG8_SCHED;
            PG8_LDA(At, 1, 1); PG8_STAGE(PG8_SB(1, 0), b3, voffB); PG8_STAGE(PG8_SB(1, 1), b3 + hstepB, voffB); PG8_STAGE(PG8_SA(1, 0), a3, voffA);
            PG8_WAIT_V(8); PG8_WAIT_L(0); PG8_BAR; PG8_MMA(1, 0, At, B0); PG8_MMA(1, 1, At, B1); PG8_BAR; PG8_SCHED;
            } else {
            PG8_LDB(B0, 0, 0); PG8_SCHED; PG8_LDA(At, 0, 0); PG8_STAGE(PG8_SA(1, 1), a1 + hstepA, voffA);
            PG8_WAIT_L(8); PG8_BAR; PG8_WAIT_L(0); PG8_MMA(0, 0, At, B0); PG8_BAR; PG8_SCHED;
            PG8_LDB(B1, 0, 1); PG8_STAGE(PG8_SB(0, 0), b2, voffB);
            PG8_BAR; PG8_WAIT_L(0); PG8_MMA(0, 1, At, B1); PG8_BAR;
            PG8_LDA(At, 0, 1); PG8_STAGE(PG8_SA(0, 0), a2, voffA);
            PG8_BAR; PG8_WAIT_L(0); PG8_MMA(1, 0, At, B0); PG8_BAR; PG8_SCHED;
            PG8_STAGE(PG8_SB(0, 1), b2 + hstepB, voffB);
            PG8_WAIT_V(6); PG8_BAR; PG8_MMA(1, 1, At, B1); PG8_BAR;
            PG8_LDB(B0, 1, 0); PG8_SCHED; PG8_LDA(At, 1, 0); PG8_STAGE(PG8_SA(0, 1), a2 + hstepA, voffA);
            PG8_WAIT_L(8); PG8_BAR; PG8_WAIT_L(0); PG8_MMA(0, 0, At, B0); PG8_BAR; PG8_SCHED;
            PG8_LDB(B1, 1, 1); PG8_STAGE(PG8_SB(1, 0), b3, voffB);
            PG8_BAR; PG8_WAIT_L(0); PG8_MMA(0, 1, At, B1); PG8_BAR;
            PG8_LDA(At, 1, 1); PG8_STAGE(PG8_SA(1, 0), a3, voffA);
            PG8_BAR; PG8_WAIT_L(0); PG8_MMA(1, 0, At, B0); PG8_BAR; PG8_SCHED;
            PG8_STAGE(PG8_SB(1, 1), b3 + hstepB, voffB);
            PG8_WAIT_V(6); PG8_BAR; PG8_MMA(1, 1, At, B1); PG8_BAR;
            }
        }
        if constexpr (ALIGN_EPI) { if (wr == 0) PG8_BAR; }
        E(acc, cur, wr, wc, fr, fq); S.done(cur);
        if (!has_next) break;
#pragma unroll
        for (int a = 0; a < 2; ++a)
#pragma unroll
            for (int b = 0; b < 2; ++b)
#pragma unroll
                for (int m = 0; m < 4; ++m)
#pragma unroll
                    for (int n = 0; n < 2; ++n) acc[a][b][m][n] = (f32x4){0.f, 0.f, 0.f, 0.f};
        cur = nxt; cA = nA; cA2 = nA2; cB = nB; ++ui;
        if constexpr (ALIGN_EPI) { if (wr == 1) PG8_BAR; }
    }
    PG8_WAIT_V(0);
    if constexpr (!ALIGN_EPI) { if (wr == 0) PG8_BAR; }
    PG8_BAR;

#undef PG8_SA
#undef PG8_SB
#undef PG8_STAGE
#undef PG8_LDA
#undef PG8_LDB
#undef PG8_MMA
#undef PG8_WAIT_V
#undef PG8_WAIT_L
#undef PG8_BAR
#undef PG8_SCHED
}
}

constexpr int NWAVES = 8;
constexpr int BATCH = 4, SEQ = 4096, DM = 1024, M = BATCH * SEQ, FF = 2816, INW = 6672;
constexpr int NGU = 2 * FF;
constexpr int ZP = 4608;
constexpr int NWIN = 4864;
constexpr int NZREAL = 4624;
constexpr size_t MiB = 1u << 20;
constexpr size_t WS_CTL = 0, CTL_ZERO_BYTES = 1 * MiB;
constexpr size_t WS_BIN = 1 * MiB, WS_BG = WS_BIN + 32768;
constexpr size_t WS_WG = 2 * MiB, WS_WPROJ = 6 * MiB, WS_WOUT = 10 * MiB, WS_WGU2 = 12 * MiB, WS_WD2 = 23 * MiB;
constexpr size_t WS_ST = 29 * MiB;
constexpr size_t WS_WGU1 = 29 * MiB, WS_WD1 = 40 * MiB, WS_WIN = WS_WD1 + 5767168;
constexpr size_t WS_XB = 61 * MiB;
constexpr size_t WS_BIG = 93 * MiB;
constexpr size_t WS_IF = 237 * MiB;
constexpr size_t WS_END = 240 * MiB;
static_assert(WS_WIN + (size_t)NWIN * 1024 * 2 <= WS_XB && WS_ST + 32 * MiB <= WS_XB && WS_WD2 + (size_t)1024 * FF * 2 <= WS_ST, "ws map");
constexpr int CW_BAR = 4096;
constexpr size_t CTL_SSQ = 512 * 1024;
constexpr int RING_OFF = 0, RING_BYTES = 131072;
constexpr int LDSCTL_OFF = 151552, MISC_OFF = LDSCTL_OFF + 320;
constexpr int LDS_BYTES = 155648;

#define GAS __attribute__((address_space(1)))
#define LAS __attribute__((address_space(3)))
typedef unsigned short bf16;
typedef unsigned v4u __attribute__((ext_vector_type(4)));
typedef unsigned v2u __attribute__((ext_vector_type(2)));
typedef float f32x4 __attribute__((ext_vector_type(4)));
typedef short bf16x8 __attribute__((ext_vector_type(8)));
typedef GAS unsigned gu32;
#define RLX_AGENT __ATOMIC_RELAXED, __HIP_MEMORY_SCOPE_AGENT
#define LDS_WAIT() asm volatile("s_waitcnt lgkmcnt(0)" ::: "memory")
#define VM_WAIT() asm volatile("s_waitcnt vmcnt(0)" ::: "memory")
__device__ __forceinline__ unsigned f2bf(float f) { unsigned u = __builtin_bit_cast(unsigned, f); return (u + 0x7fffu + ((u >> 16) & 1u)) >> 16; }
__device__ __forceinline__ unsigned pk2(float lo, float hi) { return f2bf(lo) | (f2bf(hi) << 16); }
__device__ __forceinline__ float bf2f(unsigned short b) { return __builtin_bit_cast(float, (unsigned)b << 16); }

#define XB_TMO      128
#define XB_XCNT(j)  (256  + 64 * (j))
#define XB_XSUB(j)  (1280 + 64 * (j))
#define XB_XGEN(j)  (2304 + 64 * (j))
#define XB_TOP      3328
#define XB_TOPGEN   3392
#define XCD_BAR_WORDS 3456
#define XB_SPIN_CAP (1u << 23)
__device__ __forceinline__ unsigned xb_ld(unsigned* p)              { return __hip_atomic_load(p, __ATOMIC_RELAXED, __HIP_MEMORY_SCOPE_AGENT); }
__device__ __forceinline__ unsigned xb_add(unsigned* p, unsigned v) { return __hip_atomic_fetch_add(p, v, __ATOMIC_RELAXED, __HIP_MEMORY_SCOPE_AGENT); }
__device__ __forceinline__ unsigned xb_xcc_id() { return (unsigned)__builtin_amdgcn_s_getreg((3 << 11) | 20) & 0xFu; }
#define XB_SPIN(cond, bar) do { unsigned _sp = 0; while (cond) { __builtin_amdgcn_s_sleep(1); \
    if ((++_sp & 255u) == 0u) { if (xb_ld(&(bar)[XB_TMO])) break; if (_sp > XB_SPIN_CAP) { atomicAdd(&(bar)[XB_TMO], 1u); break; } } } } while (0)
struct XcdBarrier { unsigned* bar; unsigned x; volatile LAS unsigned* st; };
__device__ __forceinline__ XcdBarrier xcd_barrier_post(unsigned* bar, volatile LAS unsigned* st) {
    XcdBarrier b; b.bar = bar; b.x = xb_xcc_id(); b.st = st;
    if (threadIdx.x == 0) (void)xb_add(&bar[XB_XCNT(b.x)], 1u);
    return b;
}
__device__ __forceinline__ void xcd_barrier_complete(unsigned* bar, unsigned x, unsigned& nloc, unsigned& nx) {
    const unsigned G = gridDim.x * gridDim.y * gridDim.z;
    unsigned sum, cnt, mine, sp = 0u;
    for (;;) {
        sum = 0u; cnt = 0u; mine = 0u;
#pragma unroll
        for (unsigned j = 0; j < 16; ++j) { const unsigned c = xb_ld(&bar[XB_XCNT(j)]); sum += c; cnt += (c > 0u) ? 1u : 0u; mine = (j == x) ? c : mine; }
        if (sum == G) break;
        __builtin_amdgcn_s_sleep(1);
        if ((++sp & 255u) == 0u) { if (xb_ld(&bar[XB_TMO])) break; if (sp > XB_SPIN_CAP) { atomicAdd(&bar[XB_TMO], 1u); break; } }
    }
    nloc = mine > 0u ? mine : 1u; nx = cnt > 0u ? cnt : 1u;
}
__device__ __forceinline__ void xcd_barrier(const XcdBarrier& b) {
    asm volatile("s_waitcnt vmcnt(0)" ::: "memory");
    __syncthreads();
    if (threadIdx.x == 0) {
        unsigned* bar = b.bar;
        __builtin_amdgcn_s_waitcnt(0);
        unsigned nloc = b.st[0], nx = b.st[1];
        if (nloc == 0u) { xcd_barrier_complete(bar, b.x, nloc, nx); b.st[0] = nloc; b.st[1] = nx; }
        const unsigned old = xb_add(&bar[XB_XSUB(b.x)], 1u);
        const unsigned gen = old / nloc;
        if (old + 1u == (gen + 1u) * nloc) {
            __builtin_amdgcn_fence(__ATOMIC_RELEASE, "agent");
            asm volatile("s_waitcnt vmcnt(0)" ::: "memory");
            const unsigned og = xb_add(&bar[XB_TOP], 1u);
            const unsigned tg = og / nx;
            if (og + 1u == (tg + 1u) * nx) xb_add(&bar[XB_TOPGEN], 1u);
            else XB_SPIN(xb_ld(&bar[XB_TOPGEN]) == tg, bar);
            __builtin_amdgcn_fence(__ATOMIC_ACQUIRE, "agent");
            xb_add(&bar[XB_XGEN(b.x)], 1u);
            asm volatile("s_waitcnt vmcnt(0)" ::: "memory");
        } else {
            XB_SPIN(xb_ld(&bar[XB_XGEN(b.x)]) == gen, bar);
            __builtin_amdgcn_fence(__ATOMIC_ACQUIRE, "agent");
            asm volatile("s_waitcnt vmcnt(0)" ::: "memory");
        }
    }
    __syncthreads();
}

__device__ __forceinline__ float wave_sum(float v) {
#pragma unroll
    for (int o = 1; o < 64; o <<= 1) v += __shfl_xor(v, o);
    return v;
}
template <class RowMap>
__device__ __forceinline__ void transpose_item(const float* W, int N, const float* g, LAS float* scr, int item, int lane, const RowMap& rm) {
    const int nblk = (N + 31) / 32, kb = item / nblk, nb = item % nblk, k0 = 64 * kb, n0 = 32 * nb;
    const int nl = lane & 31, nsrc = n0 + nl;
#pragma unroll 8
    for (int i = 0; i < 32; ++i) { const int kk = 2 * i + (lane >> 5); float v = nsrc < N ? W[(size_t)(k0 + kk) * N + nsrc] : 0.f; if (g) v *= g[k0 + kk]; scr[kk * 33 + nl] = v; }
    LDS_WAIT(); asm volatile("" ::: "memory");
    const int c = lane & 7;
#pragma unroll
    for (int j = 0; j < 4; ++j) { const int n = (lane >> 3) + 8 * j; const LAS float* s = scr + (8 * c) * 33 + n;
        v4u o; o.x = pk2(s[0 * 33], s[1 * 33]); o.y = pk2(s[2 * 33], s[3 * 33]); o.z = pk2(s[4 * 33], s[5 * 33]); o.w = pk2(s[6 * 33], s[7 * 33]);
        if (n0 + n < N) *(GAS v4u*)(rm(n0 + n) + k0 + 8 * c) = o; }
    LDS_WAIT(); asm volatile("" ::: "memory");
}
struct RmGate { bf16* W; __device__ __forceinline__ bf16* operator()(int n) const { return W + (size_t)(256 * (n >> 7) + (n & 127)) * 1024; } };
struct RmUp   { bf16* W; __device__ __forceinline__ bf16* operator()(int n) const { return W + (size_t)(256 * (n >> 7) + 128 + (n & 127)) * 1024; } };
struct RmLin  { bf16* W; int ld, koff; __device__ __forceinline__ bf16* operator()(int n) const { return W + (size_t)n * ld + koff; } };
struct RmWin  { bf16* Win; bf16* Wg; __device__ __forceinline__ bf16* operator()(int n) const { return n < NZREAL ? Win + (size_t)n * 1024 : Wg + (size_t)(n - NZREAL) * 1024; } };


namespace nv {
constexpr int S = 4096, AH = 16, AKV = 4, HD = 64, WIN_ = 128, MH = 8, CH = 64;
constexpr float EPS = 1e-6f, CAP = 15.0f;
__device__ __forceinline__ float sigmoidf_(float x) { return 1.0f / (1.0f + expf(-x)); }
__device__ __forceinline__ float siluf_(float x) { return x / (1.0f + expf(-x)); }
__device__ __forceinline__ float ld(const bf16* p) { return bf2f(*p); }
__device__ __forceinline__ void st(bf16* p, float v) { *p = (bf16)f2bf(v); }
__device__ __forceinline__ void attn_item(bf16* Z, const float* sinks, int w, int lane) {
    const int r = w / AH, hq = w % AH, hk = hq / (AH / AKV), t = r % S, rb = r - t;
    const float q = ld(Z + (size_t)r * ZP + hq * HD + lane);
    float m = sinks[hq], l = 1.0f, acc = 0.f;
    const int j0 = t - (WIN_ - 1) < 0 ? 0 : t - (WIN_ - 1);
    for (int j = j0; j <= t; ++j) {
        const float kv = ld(Z + (size_t)(rb + j) * ZP + 1024 + hk * HD + lane);
        const float s = wave_sum(q * kv) * 0.125f;
        const float mn = fmaxf(m, s), f = expf(m - mn), p = expf(s - mn);
        l = l * f + p; acc = acc * f + p * ld(Z + (size_t)(rb + j) * ZP + 1280 + hk * HD + lane); m = mn;
    }
    st(Z + (size_t)r * ZP + hq * HD + lane, acc / l);
}
__device__ __forceinline__ void conv_item(const bf16* Z, const float* cw, bf16* qk, int idx) {
    const int r = idx >> 10, c = idx & 1023, t = r % S;
    float a = 0.f;
#pragma unroll
    for (int j = 0; j < 4; ++j) { const int tt = t - 3 + j; if (tt >= 0) a += ld(Z + (size_t)(r - 3 + j) * ZP + 1536 + c) * cw[j * 1024 + c]; }
    a = siluf_(a); if (c >= 512) a *= 0.125f;
    st(qk + (size_t)r * 1024 + c, a);
}
constexpr int MLSTM_LDS = (64 * 128 * 3 + 64 * 65 * 3 + 64 * 6 + 8 + 64) * 4;
__device__ __forceinline__ void mlstm_seq(bf16* Z, const float* IF, const bf16* qk, const float* hnorm, int bh, LAS float* sm) {
    LAS float* Cs = sm; LAS float* qs = Cs + 64 * 128; LAS float* ks = qs + 64 * 65; LAS float* vs = ks + 64 * 65; LAS float* Ss = vs + 64 * 128; LAS float* ns = Ss + 64 * 65;
    LAS float* ig = ns + 64; LAS float* cum = ig + 64; LAS float* mt = cum + 64; LAS float* wint = mt + 64; LAS float* wk = wint + 64; LAS float* hs = wk + 64; LAS float* sc = hs + 64 * 128; LAS float* den = sc + 8;
    const int h = bh % MH, b = bh / MH, tid = threadIdx.x;
    for (int i = tid; i < 64 * 128; i += 512) Cs[i] = 0.f;
    if (tid < 64) ns[tid] = 0.f;
    if (tid == 0) sc[0] = 0.f;
    __syncthreads();
    for (int c = 0; c < S / CH; ++c) {
        const size_t r0 = (size_t)b * S + c * CH;
        for (int i = tid; i < 64 * 64; i += 512) { const int t = i >> 6, d = i & 63; qs[t * 65 + d] = ld(qk + (r0 + t) * 1024 + h * 64 + d); ks[t * 65 + d] = ld(qk + (r0 + t) * 1024 + 512 + h * 64 + d); }
        for (int i = tid; i < 64 * 128; i += 512) { const int t = i >> 7, v = i & 127; vs[i] = ld(Z + (r0 + t) * ZP + 2560 + h * 128 + v); }
        if (tid < 64) {
            const float ip = IF[(r0 + tid) * 16 + h], fp = IF[(r0 + tid) * 16 + 8 + h];
            ig[tid] = CAP * tanhf(ip / CAP);
            const float fc = CAP * tanhf(fp / CAP);
            cum[tid] = fc >= 0.f ? -log1pf(expf(-fc)) : fc - log1pf(expf(fc));
        }
        __syncthreads();
        if (tid == 0) { float a = 0.f; for (int t = 0; t < 64; ++t) { a += cum[t]; cum[t] = a; } }
        __syncthreads();
        const float m_prev = sc[0];
        if (tid < 64) {
            float mx = -INFINITY;
            for (int s = 0; s <= tid; ++s) mx = fmaxf(mx, cum[tid] - cum[s] + ig[s]);
            const float li = cum[tid] + m_prev, m = fmaxf(li, mx);
            mt[tid] = m; wint[tid] = expf(li - m);
        }
        if (tid == 64) {
            const float total = cum[63]; float mx = -INFINITY;
            for (int s = 0; s < 64; ++s) mx = fmaxf(mx, total - cum[s] + ig[s]);
            const float mn = fmaxf(total + m_prev, mx);
            sc[1] = mn; sc[2] = expf(total + m_prev - mn);
        }
        __syncthreads();
        if (tid < 64) wk[tid] = expf(cum[63] - cum[tid] + ig[tid] - sc[1]);
        for (int i = tid; i < 64 * 64; i += 512) {
            const int t = i >> 6, s = i & 63; float v = 0.f;
            if (s <= t) { float d = 0.f; for (int k = 0; k < 64; ++k) d = fmaf(qs[t * 65 + k], ks[s * 65 + k], d); v = d * expf(cum[t] - cum[s] + ig[s] - mt[t]); }
            Ss[t * 65 + s] = v;
        }
        __syncthreads();
        if (tid < 64) { float d = 0.f; for (int s = 0; s < 64; ++s) d += Ss[tid * 65 + s]; float qn = 0.f; for (int k = 0; k < 64; ++k) qn = fmaf(qs[tid * 65 + k], ns[k], qn);
            d += wint[tid] * qn; den[tid] = fmaxf(fabsf(d), expf(-mt[tid])); }
        __syncthreads();
        for (int i = tid; i < 64 * 128; i += 512) {
            const int t = i >> 7, v = i & 127; float a = 0.f, bq = 0.f;
            for (int s = 0; s <= t; ++s) a = fmaf(Ss[t * 65 + s], vs[s * 128 + v], a);
            for (int k = 0; k < 64; ++k) bq = fmaf(qs[t * 65 + k], Cs[k * 128 + v], bq);
            hs[i] = (a + wint[t] * bq) / den[t];
        }
        __syncthreads();
        for (int i = tid; i < 64 * 128; i += 512) {
            const int d = i >> 7, v = i & 127; float a = 0.f;
            for (int s = 0; s < 64; ++s) a = fmaf(wk[s] * ks[s * 65 + d], vs[s * 128 + v], a);
            Cs[i] = sc[2] * Cs[i] + a;
        }
        if (tid < 64) { float a = 0.f; for (int s = 0; s < 64; ++s) a = fmaf(wk[s], ks[s * 65 + tid], a); ns[tid] = sc[2] * ns[tid] + a; }
        {
            const int wv = tid >> 6, lane = tid & 63;
            for (int t = wv; t < 64; t += 8) {
                const float a = hs[t * 128 + lane], bb = hs[t * 128 + 64 + lane];
                const float rr = rsqrtf(wave_sum(a * a + bb * bb) * (1.0f / 128.0f) + EPS);
                bf16* zr = Z + (r0 + t) * ZP;
                st(zr + 2560 + h * 128 + lane, sigmoidf_(ld(zr + 3584 + h * 128 + lane)) * a * rr * hnorm[h * 128 + lane]);
                st(zr + 2560 + h * 128 + 64 + lane, sigmoidf_(ld(zr + 3584 + h * 128 + 64 + lane)) * bb * rr * hnorm[h * 128 + 64 + lane]);
            }
        }
        __syncthreads();
        if (tid == 0) sc[0] = sc[1];
        __syncthreads();
    }
}
}

struct Args { const float* in[19]; float* out; unsigned char* ws; int ph_lo, ph_hi, use_bar, pad; };

__global__ void __launch_bounds__(NWAVES * 64, 2) mk_fwd(Args args) {
    extern __shared__ __attribute__((aligned(16))) unsigned char lds_raw[];
    LAS unsigned char* lds = (LAS unsigned char*)lds_raw;
    volatile LAS unsigned* MISC = (volatile LAS unsigned*)(lds + MISC_OFF);
    const int tid = threadIdx.x, lane = tid & 63, wave = __builtin_amdgcn_readfirstlane(tid >> 6);
    const int G = gridDim.x, bx = blockIdx.x, vcu = (G % 8 == 0) ? (bx % 8) * (G / 8) + bx / 8 : bx;
    unsigned char* ws = args.ws;
    gu32* ctl = (gu32*)(ws + WS_CTL);
    float* SSQ = (float*)(ws + WS_CTL + CTL_SSQ);
    const float* x = args.in[0];
    bf16 *WGU1 = (bf16*)(ws + WS_WGU1), *WD1 = (bf16*)(ws + WS_WD1), *WIN = (bf16*)(ws + WS_WIN), *WG = (bf16*)(ws + WS_WG), *WPROJ = (bf16*)(ws + WS_WPROJ),
         *WOUT = (bf16*)(ws + WS_WOUT), *WGU2 = (bf16*)(ws + WS_WGU2), *WD2 = (bf16*)(ws + WS_WD2);
    bf16 *XB = (bf16*)(ws + WS_XB), *BIG = (bf16*)(ws + WS_BIG);
    float *BIN = (float*)(ws + WS_BIN), *BG = (float*)(ws + WS_BG), *IFB = (float*)(ws + WS_IF);
    bf16* MG = (bf16*)(ws + WS_ST);
    for (int u = tid; u < (LDS_BYTES - LDSCTL_OFF) / 4; u += NWAVES * 64) ((LAS unsigned*)(lds + LDSCTL_OFF))[u] = 0u;
    __syncthreads();
    XcdBarrier bar; bar.bar = (unsigned*)(ctl + CW_BAR); bar.x = 0; bar.st = nullptr;
    if (args.use_bar) bar = xcd_barrier_post((unsigned*)(ctl + CW_BAR), MISC + 8);
    const int lo = args.ph_lo, hi = args.ph_hi;
#define IN(k) (lo <= (k) && (k) < hi)
#define SEAM(k) do { if (IN(k) && IN((k) + 1)) xcd_barrier(bar); } while (0)

    if (IN(0)) {
        LAS float* scr = (LAS float*)(lds + RING_OFF + wave * 16384);
        const int gw = vcu * NWAVES + wave, NGW = G * NWAVES;
        constexpr int I_GU = 16 * (FF / 32), I_D = (FF / 64) * 32, I_WIN = 16 * ((INW + 31) / 32), I_SQ = 16 * 32;
        constexpr int NITEMS = 4 * I_GU + 2 * I_D + I_WIN + 3 * I_SQ;
        for (int it = gw; it < NITEMS; it += NGW) {
            int r = it;
            if (r < I_GU) { transpose_item(args.in[2], FF, args.in[1], scr, r, lane, RmGate{WGU1}); continue; } r -= I_GU;
            if (r < I_GU) { transpose_item(args.in[3], FF, args.in[1], scr, r, lane, RmUp{WGU1}); continue; } r -= I_GU;
            if (r < I_D) { transpose_item(args.in[4], DM, nullptr, scr, r, lane, RmLin{WD1, FF, 0}); continue; } r -= I_D;
            if (r < I_WIN) { transpose_item(args.in[6], INW, args.in[5], scr, r, lane, RmWin{WIN, WG}); continue; } r -= I_WIN;
            if (r < I_SQ) { transpose_item(args.in[11], DM, nullptr, scr, r, lane, RmLin{WPROJ, 2048, 0}); continue; } r -= I_SQ;
            if (r < I_SQ) { transpose_item(args.in[12], DM, nullptr, scr, r, lane, RmLin{WPROJ, 2048, 1024}); continue; } r -= I_SQ;
            if (r < I_SQ) { transpose_item(args.in[13], DM, nullptr, scr, r, lane, RmLin{WOUT, 1024, 0}); continue; } r -= I_SQ;
            if (r < I_GU) { transpose_item(args.in[15], FF, args.in[14], scr, r, lane, RmGate{WGU2}); continue; } r -= I_GU;
            if (r < I_GU) { transpose_item(args.in[16], FF, args.in[14], scr, r, lane, RmUp{WGU2}); continue; } r -= I_GU;
            transpose_item(args.in[17], DM, nullptr, scr, r, lane, RmLin{WD2, FF, 0});
        }
        { const int gt = vcu * (NWAVES * 64) + tid, NGT = G * NWAVES * 64;
          GAS v4u* z = (GAS v4u*)(WIN + (size_t)NZREAL * 1024);
          for (int i = gt; i < (NWIN - NZREAL) * 1024 * 2 / 16; i += NGT) z[i] = (v4u){0u, 0u, 0u, 0u};
          for (int i = gt; i < NWIN; i += NGT) BIN[i] = i < NZREAL ? args.in[7][i] : 0.f;
          for (int i = gt; i < 2048; i += NGT) BG[i] = args.in[7][NZREAL + i]; }
        for (int m = gw; m < M; m += NGW) {
            const GAS f32x4* xr = (const GAS f32x4*)(x + (size_t)m * DM) + lane;
            f32x4 v[4]; float s = 0.f;
#pragma unroll
            for (int j = 0; j < 4; ++j) { v[j] = xr[64 * j]; s += (v[j].x * v[j].x + v[j].y * v[j].y) + (v[j].z * v[j].z + v[j].w * v[j].w); }
            s = wave_sum(s);
            GAS v2u* o8 = (GAS v2u*)(XB + (size_t)m * DM) + lane;
#pragma unroll
            for (int j = 0; j < 4; ++j) o8[64 * j] = (v2u){pk2(v[j].x, v[j].y), pk2(v[j].z, v[j].w)};
            if (lane == 0) SSQ[m] = s;
        }
        SEAM(0);
    }
    if (IN(1)) {
        pg8::Gemm g{XB, XB, WGU1, 1024, 1024, 1024, 1 << 30}; pg8::StaticOrder S; S.init(M, NGU, G, bx);
        pg8::EpiSwiglu E{BIG, FF, SSQ};
        pg8::gemm_phase<pg8::EpiSwiglu, pg8::StaticOrder, true, true>(lds + RING_OFF, g, S, E);
        SEAM(1);
    }
    if (IN(2)) {
        pg8::Gemm g{BIG, BIG, WD1, FF, FF, FF, 1 << 30}; pg8::StaticOrder S; S.init(M, DM, G, bx);
        pg8::EpiRes E{x, args.out, XB, SSQ + M, 0.5f};
        pg8::gemm_phase<pg8::EpiRes, pg8::StaticOrder, true, true>(lds + RING_OFF, g, S, E);
        SEAM(2);
    }

    if (IN(3)) {
        pg8::Gemm g{XB, XB, WIN, 1024, 1024, 1024, 1 << 30}; pg8::StaticOrder S; S.init(M, NWIN, G, bx);
        pg8::EpiWin E{BIG, ZP, IFB, BIN, SSQ + M};
        pg8::gemm_phase<pg8::EpiWin, pg8::StaticOrder, true, true>(lds + RING_OFF, g, S, E);
        SEAM(3);
    }

    if (IN(4)) {
        const int gw = vcu * NWAVES + wave, NGW = G * NWAVES;
        for (int w = gw; w < M * 16; w += NGW) nv::attn_item(BIG, args.in[8], w, lane);
        const int gt = vcu * (NWAVES * 64) + tid, NGT = G * NWAVES * 64;
        for (int i = gt; i < M * 1024; i += NGT) nv::conv_item(BIG, args.in[9], MG, i);
        SEAM(4);
    }
    if (IN(5)) {
        if (bx < 32) nv::mlstm_seq(BIG, IFB, MG, args.in[10], bx, (LAS float*)(lds + RING_OFF));
        SEAM(5);
    }
    if (IN(6)) {
        pg8::Gemm g{XB, XB, WG, 1024, 1024, 1024, 1 << 30}; pg8::StaticOrder S; S.init(M, 2048, G, bx);
        pg8::EpiGate E{BIG, ZP, 1536, 3584, BG, SSQ + M};
        pg8::gemm_phase<pg8::EpiGate, pg8::StaticOrder, true, true>(lds + RING_OFF, g, S, E);
        SEAM(6);
    }
    if (IN(7)) {
        pg8::Gemm g{BIG, BIG + 2560 - 1024, WPROJ, ZP, 2048, 2048, 16}; pg8::StaticOrder S; S.init(M, DM, G, bx);
        pg8::EpiProj E{BIG, ZP, 1536, 3584, MG};
        pg8::gemm_phase<pg8::EpiProj, pg8::StaticOrder, true, true>(lds + RING_OFF, g, S, E);
        SEAM(7);
    }
    if (IN(8)) {
        pg8::Gemm g{MG, MG, WOUT, 1024, 1024, 1024, 1 << 30}; pg8::StaticOrder S; S.init(M, DM, G, bx);
        pg8::EpiRes E{args.out, args.out, XB, SSQ + 2 * M, 1.0f};
        pg8::gemm_phase<pg8::EpiRes, pg8::StaticOrder, true, true>(lds + RING_OFF, g, S, E);
        SEAM(8);
    }
    if (IN(9)) {
        pg8::Gemm g{XB, XB, WGU2, 1024, 1024, 1024, 1 << 30}; pg8::StaticOrder S; S.init(M, NGU, G, bx);
        pg8::EpiSwiglu E{BIG, FF, SSQ + 2 * M};
        pg8::gemm_phase<pg8::EpiSwiglu, pg8::StaticOrder, true, true>(lds + RING_OFF, g, S, E);
        SEAM(9);
    }
    if (IN(10)) {
        pg8::Gemm g{BIG, BIG, WD2, FF, FF, FF, 1 << 30}; pg8::StaticOrder S; S.init(M, DM, G, bx);
        pg8::EpiRes E{args.out, args.out, nullptr, SSQ + 3 * M, 0.5f};
        pg8::gemm_phase<pg8::EpiRes, pg8::StaticOrder, true, true>(lds + RING_OFF, g, S, E);
        SEAM(10);
    }
    if (IN(11)) {
        const int gw = vcu * NWAVES + wave, NGW = G * NWAVES; const float* gf = args.in[18];
        for (int m = gw; m < M; m += NGW) {
            GAS f32x4* xr = (GAS f32x4*)(args.out + (size_t)m * DM) + lane;
            const float rs = pg8::rstd_of(SSQ[3 * M + m]);
#pragma unroll
            for (int j = 0; j < 4; ++j) { const f32x4 gv = *((const f32x4*)gf + lane + 64 * j); f32x4 v = xr[64 * j]; xr[64 * j] = v * rs * gv; }
        }
    }
#undef IN
#undef SEAM
}

extern "C" void kernel_launch(void* const* d_in, const int* in_sizes, int n_in, void* d_out, int out_size, void* d_ws, size_t ws_size, hipStream_t stream) {
    static int grid = 0;
    if (grid == 0) {
        int dev = 0, cus = 0, per_cu = 0;
        if (n_in != 19 || out_size != M * DM || ws_size < WS_END) { fprintf(stderr, "kernel_launch: unexpected problem shape (n_in %d out %d ws %zu)\n", n_in, out_size, ws_size); grid = -1; return; }
        if (hipGetDevice(&dev) != hipSuccess || hipDeviceGetAttribute(&cus, hipDeviceAttributeMultiprocessorCount, dev) != hipSuccess) { grid = -1; return; }
        if (hipFuncSetAttribute((const void*)mk_fwd, hipFuncAttributeMaxDynamicSharedMemorySize, LDS_BYTES) != hipSuccess) { fprintf(stderr, "kernel_launch: hipFuncSetAttribute failed\n"); grid = -1; return; }
        if (hipOccupancyMaxActiveBlocksPerMultiprocessor(&per_cu, (const void*)mk_fwd, NWAVES * 64, LDS_BYTES) != hipSuccess || per_cu < 1) { fprintf(stderr, "kernel_launch: occupancy query says %d blocks per CU\n", per_cu); grid = -1; return; }
        (void)hipGetLastError();
        grid = cus;
    }
    if (grid < 0) return;
    (void)hipMemsetAsync((char*)d_ws + WS_CTL, 0, CTL_ZERO_BYTES, stream);
    Args a{};
    for (int i = 0; i < 19; ++i) a.in[i] = (const float*)d_in[i];
    a.out = (float*)d_out; a.ws = (unsigned char*)d_ws; a.use_bar = 1; a.ph_lo = 0; a.ph_hi = 12;
    hipLaunchKernelGGL(mk_fwd, dim3(grid), dim3(NWAVES * 64), LDS_BYTES, stream, a);
}
```

```cpp
#include <hip/hip_runtime.h>
#include <cstdio>
#include <cstdint>
namespace pg8 {
#define PG8_LAS __attribute__((address_space(3)))
typedef unsigned short bf16_t;
typedef short bf16x8 __attribute__((ext_vector_type(8)));
typedef float f32x4 __attribute__((ext_vector_type(4)));
typedef unsigned u32x4 __attribute__((ext_vector_type(4)));
typedef unsigned u32x2 __attribute__((ext_vector_type(2)));
constexpr int BM = 256, BK = 64, HALF = 128, HTB = HALF * BK * 2  , STAGE_BYTES = 8 * HTB, NXCD = 8, WGM = 8;
constexpr float RMS_EPS = 1e-6f;

__host__ __device__ __forceinline__ int lds_byte(int r, int c) { const int st = (r >> 4) * 2 + (c >> 5), rr = r & 15, cc = c & 31, ob = rr * 64 + cc * 2; return st * 1024 + (ob ^ (((ob >> 9) & 1) << 5)); }
__host__ __device__ __forceinline__ void stage_rc(int b, int& R, int& C) { const int st = b / 1024, sb = b % 1024, swz = sb ^ (((sb >> 9) & 1) << 5); R = (st >> 1) * 16 + swz / 64; C = (st & 1) * 32 + (swz % 64) / 2; }
__host__ __device__ __forceinline__ int perm32(int rho) { const int n = rho >> 4, i = rho & 15; return 8 * (i >> 2) + 4 * n + (i & 3); }

struct Unit { int pm, pn; };
struct Gemm { const bf16_t* A; const bf16_t* A2; const bf16_t* Bt; int lda, ldb, K, ksplit; };

struct StaticOrder {
    int nM, nN, nwg, G, c;
    __host__ __device__ void init(int M, int N, int G_, int c_) { nM = M / BM; nN = N / BM; nwg = nM * nN; G = G_; c = c_; }
    __host__ __device__ bool next(int i, Unit& u) const {
        const long L = (long)i * G + c; if (L >= nwg) return false;
        int wgid = (int)L; { const int q = nwg / NXCD, r = nwg % NXCD, xcd = wgid % NXCD, off = wgid / NXCD; wgid = (xcd < r ? xcd * (q + 1) : r * (q + 1) + (xcd - r) * q) + off; }
        const int nig = WGM * nN, gid = wgid / nig, fm = gid * WGM, gsz = (nM - fm) < WGM ? (nM - fm) : WGM;
        u.pm = fm + ((wgid % nig) % gsz); u.pn = (wgid % nig) / gsz; return true;
    }
    __device__ __forceinline__ void a_ready(const Unit&) const {}
    __device__ __forceinline__ void done(const Unit&) const {}
};

__device__ __forceinline__ unsigned cvt_pk_bf16(float lo, float hi) { unsigned r; asm volatile("v_cvt_pk_bf16_f32 %0, %1, %2" : "=v"(r) : "v"(lo), "v"(hi)); return r; }
__device__ __forceinline__ float fast_sigmoid(float x) { return __builtin_amdgcn_rcpf(1.0f + __builtin_amdgcn_exp2f(-1.4426950408889634f * x)); }
__device__ __forceinline__ float rstd_of(float ssq) { return __builtin_amdgcn_rsqf(ssq * (1.0f / 1024.0f) + RMS_EPS); }

struct EpiSwiglu {
    static constexpr bool PERM = true, HAS_MID = false;
    bf16_t* O; int ldo; const float* ssq;
    __device__ __forceinline__ void operator()(const f32x4 (&acc)[2][2][4][2], const Unit& u, int wr, int wc, int fr, int fq) const {
        const int row0 = u.pm * BM + wr * 64 + fr, col0 = u.pn * HALF + wc * 32 + 8 * fq;
#pragma unroll
        for (int ai = 0; ai < 2; ++ai)
#pragma unroll
            for (int m = 0; m < 4; ++m) {
                const int r = row0 + ai * HALF + m * 16; const float rs = rstd_of(ssq[r]);
                float o[8];
#pragma unroll
                for (int n = 0; n < 2; ++n)
#pragma unroll
                    for (int j = 0; j < 4; ++j) { const float gv = acc[ai][0][m][n][j] * rs, uv = acc[ai][1][m][n][j] * rs; o[4 * n + j] = gv * fast_sigmoid(gv) * uv; }
                u32x4 w; w.x = cvt_pk_bf16(o[0], o[1]); w.y = cvt_pk_bf16(o[2], o[3]); w.z = cvt_pk_bf16(o[4], o[5]); w.w = cvt_pk_bf16(o[6], o[7]);
                *(u32x4*)(O + (size_t)r * ldo + col0) = w;
            }
    }
};
struct EpiRes {
    static constexpr bool PERM = false, HAS_MID = false;
    const float* R; float* X; bf16_t* Xb; float* ssq; float alpha;
    __device__ __forceinline__ void operator()(const f32x4 (&acc)[2][2][4][2], const Unit& u, int wr, int wc, int fr, int fq) const {
        const int row0 = u.pm * BM + wr * 64 + fr, col0 = u.pn * BM + wc * 32 + 4 * fq;
#pragma unroll
        for (int ai = 0; ai < 2; ++ai)
#pragma unroll
            for (int m = 0; m < 4; ++m) {
                const int r = row0 + ai * HALF + m * 16; float sq = 0.f;
#pragma unroll
                for (int bj = 0; bj < 2; ++bj)
#pragma unroll
                    for (int n = 0; n < 2; ++n) {
                        const size_t off = (size_t)r * 1024 + col0 + bj * HALF + n * 16;
                        const f32x4 x = *(const f32x4*)(R + off) + acc[ai][bj][m][n] * alpha;
                        *(f32x4*)(X + off) = x; sq += (x[0] * x[0] + x[1] * x[1]) + (x[2] * x[2] + x[3] * x[3]);
                        if (Xb) { u32x2 w; w.x = cvt_pk_bf16(x[0], x[1]); w.y = cvt_pk_bf16(x[2], x[3]); *(u32x2*)(Xb + off) = w; }
                    }
                sq += __shfl_xor(sq, 16); sq += __shfl_xor(sq, 32);
                if (fq == 0) atomicAdd(ssq + r, sq);
            }
    }
};
struct EpiWin {
    static constexpr bool PERM = true, HAS_MID = false;
    bf16_t* Z; int ldz; float* IF; const float* bias; const float* ssq;
    __device__ __forceinline__ void operator()(const f32x4 (&acc)[2][2][4][2], const Unit& u, int wr, int wc, int fr, int fq) const {
        const int row0 = u.pm * BM + wr * 64 + fr, cw = wc * 32 + 8 * fq;
        const bool ztile = u.pn < 18;
#pragma unroll
        for (int ai = 0; ai < 2; ++ai)
#pragma unroll
            for (int m = 0; m < 4; ++m) {
                const int r = row0 + ai * HALF + m * 16; const float rs = rstd_of(ssq[r]);
#pragma unroll
                for (int bj = 0; bj < 2; ++bj) {
                    const int c = u.pn * BM + bj * HALF + cw;
                    const f32x4 v0 = acc[ai][bj][m][0] * rs + *(const f32x4*)(bias + c), v1 = acc[ai][bj][m][1] * rs + *(const f32x4*)(bias + c + 4);
                    if (ztile) { u32x4 w; w.x = cvt_pk_bf16(v0[0], v0[1]); w.y = cvt_pk_bf16(v0[2], v0[3]); w.z = cvt_pk_bf16(v1[0], v1[1]); w.w = cvt_pk_bf16(v1[2], v1[3]);
                        *(u32x4*)(Z + (size_t)r * ldz + c) = w; }
                    else if (bj == 0 && cw < 16) { *(f32x4*)(IF + (size_t)r * 16 + cw) = v0; *(f32x4*)(IF + (size_t)r * 16 + cw + 4) = v1; }
                }
            }
    }
};
struct EpiGate {
    static constexpr bool PERM = true, HAS_MID = false;
    bf16_t* Z; int ldz, off0, off1; const float* bias; const float* ssq;
    __device__ __forceinline__ void operator()(const f32x4 (&acc)[2][2][4][2], const Unit& u, int wr, int wc, int fr, int fq) const {
        const int row0 = u.pm * BM + wr * 64 + fr, cw = wc * 32 + 8 * fq;
        const int cdst0 = (u.pn < 4 ? off0 : off1) + (u.pn & 3) * BM;
#pragma unroll
        for (int ai = 0; ai < 2; ++ai)
#pragma unroll
            for (int m = 0; m < 4; ++m) {
                const int r = row0 + ai * HALF + m * 16; const float rs = rstd_of(ssq[r]);
#pragma unroll
                for (int bj = 0; bj < 2; ++bj) {
                    const int c = u.pn * BM + bj * HALF + cw;
                    const f32x4 v0 = acc[ai][bj][m][0] * rs + *(const f32x4*)(bias + c), v1 = acc[ai][bj][m][1] * rs + *(const f32x4*)(bias + c + 4);
                    u32x4 w; w.x = cvt_pk_bf16(fast_sigmoid(v0[0]), fast_sigmoid(v0[1])); w.y = cvt_pk_bf16(fast_sigmoid(v0[2]), fast_sigmoid(v0[3]));
                    w.z = cvt_pk_bf16(fast_sigmoid(v1[0]), fast_sigmoid(v1[1])); w.w = cvt_pk_bf16(fast_sigmoid(v1[2]), fast_sigmoid(v1[3]));
                    *(u32x4*)(Z + (size_t)r * ldz + cdst0 + bj * HALF + cw) = w;
                }
            }
    }
};
struct EpiProj {
    static constexpr bool PERM = true, HAS_MID = true;
    const bf16_t* Z; int ldz, off0, off1; bf16_t* O;
    __device__ __forceinline__ static float bfl(unsigned w) { return __builtin_bit_cast(float, w << 16); }
    __device__ __forceinline__ static float bfh(unsigned w) { return __builtin_bit_cast(float, w & 0xffff0000u); }
    __device__ __forceinline__ void mid(f32x4 (&acc)[2][2][4][2], const Unit& u, int wr, int wc, int fr, int fq) const {
        unsigned base = (unsigned)((u.pm * BM + wr * 64 + fr) * ldz + u.pn * BM + wc * 32 + 8 * fq) * 2u; asm volatile("" : "+v"(base));
        const char* zb = (const char*)Z;
#pragma unroll
        for (int ai = 0; ai < 2; ++ai)
#pragma unroll
            for (int m = 0; m < 4; ++m) {
#pragma unroll
                for (int bj = 0; bj < 2; ++bj) {
                    const unsigned o = base + (unsigned)(((ai * HALF + m * 16) * ldz + bj * HALF) * 2);
                    const u32x4 a = *(const u32x4*)(zb + o + (unsigned)(off0 * 2)), b = *(const u32x4*)(zb + o + (unsigned)(off1 * 2));
#pragma unroll
                    for (int q = 0; q < 4; ++q) {
                        const float rl = bfl(a[q]) * __builtin_amdgcn_rcpf(fmaxf(bfl(b[q]), 1e-30f)), rh = bfh(a[q]) * __builtin_amdgcn_rcpf(fmaxf(bfh(b[q]), 1e-30f));
                        acc[ai][bj][m][q >> 1][(q & 1) * 2] *= rl; acc[ai][bj][m][q >> 1][(q & 1) * 2 + 1] *= rh;
                    }
                    asm volatile("" ::: "memory");
                }
            }
    }
    __device__ __forceinline__ void operator()(const f32x4 (&acc)[2][2][4][2], const Unit& u, int wr, int wc, int fr, int fq) const {
        const int row0 = u.pm * BM + wr * 64 + fr, cw = wc * 32 + 8 * fq;
#pragma unroll
        for (int ai = 0; ai < 2; ++ai)
#pragma unroll
            for (int m = 0; m < 4; ++m) {
                const int r = row0 + ai * HALF + m * 16;
#pragma unroll
                for (int bj = 0; bj < 2; ++bj) {
                    const int c = u.pn * BM + bj * HALF + cw;
                    const u32x4 b = *(const u32x4*)(Z + (size_t)r * ldz + off1 + c);
                    u32x4 w;
#pragma unroll
                    for (int q = 0; q < 4; ++q) w[q] = cvt_pk_bf16(acc[ai][bj][m][q >> 1][(q & 1) * 2] * fmaxf(bfl(b[q]), 1e-30f), acc[ai][bj][m][q >> 1][(q & 1) * 2 + 1] * fmaxf(bfh(b[q]), 1e-30f));
                    *(u32x4*)(O + (size_t)r * 1024 + c) = w;
                    asm volatile("" ::: "memory");
                }
            }
    }
};
template <class Epi, class Sched, bool ALIGN_EPI = false, bool SP2 = false>
__device__ __forceinline__ void gemm_phase(PG8_LAS unsigned char* lds, const Gemm g, const Sched& S, const Epi& E) {
    const int tid = threadIdx.x, wid = __builtin_amdgcn_readfirstlane(tid >> 6), lane = tid & 63, wr = wid >> 2, wc = wid & 3, fr = lane & 15, fq = lane >> 4;
    const int K = g.K, nt = K / BK;
    unsigned voffA[2], voffB[2];
#pragma unroll
    for (int i = 0; i < 2; ++i) { int R, C; stage_rc(tid * 16 + i * 8192, R, C); const int Rb = Epi::PERM ? ((R & ~31) + perm32(R & 31)) : R;
        voffA[i] = (unsigned)(R * g.lda + C) * 2u; voffB[i] = (unsigned)(Rb * g.ldb + C) * 2u; }
    const size_t kstep = (size_t)(BK * 2);
    const size_t hstepA = (size_t)HALF * g.lda * 2, hstepB = (size_t)HALF * g.ldb * 2;
    const size_t tstepA = 2 * hstepA, tstepB = 2 * hstepB;
    const unsigned ldsw = (unsigned)wid * 1024u;
    const int aoff = lds_byte(wr * 64 + fr, fq * 8), boff = lds_byte(wc * 32 + fr, fq * 8);
#define PG8_SA(b, h) (((b) * 2 + (h)) * HTB)
#define PG8_SB(b, h) ((4 + (b) * 2 + (h)) * HTB)
#define PG8_STAGE(bufoff, gbase, voff) do { _Pragma("unroll") for (int _i = 0; _i < 2; ++_i) \
        __builtin_amdgcn_global_load_lds((const unsigned*)((const char*)(gbase) + (voff)[_i]), (PG8_LAS unsigned*)(lds + (bufoff) + ldsw + _i * 8192), 16, 0, 0); } while (0)
#define PG8_LDA(dst, b, h) do { _Pragma("unroll") for (int m = 0; m < 4; ++m) _Pragma("unroll") for (int k = 0; k < 2; ++k) dst[m][k] = *(const PG8_LAS bf16x8*)(lds + PG8_SA(b, h) + aoff + m * 2048 + k * 1024); } while (0)
#define PG8_LDB(dst, b, h) do { _Pragma("unroll") for (int n = 0; n < 2; ++n) _Pragma("unroll") for (int k = 0; k < 2; ++k) dst[n][k] = *(const PG8_LAS bf16x8*)(lds + PG8_SB(b, h) + boff + n * 2048 + k * 1024); } while (0)
#define PG8_MMA(ai, bj, At, Bt) do { __builtin_amdgcn_s_setprio(1); _Pragma("unroll") for (int m = 0; m < 4; ++m) _Pragma("unroll") for (int n = 0; n < 2; ++n) _Pragma("unroll") for (int k = 0; k < 2; ++k) \
        acc[ai][bj][m][n] = __builtin_amdgcn_mfma_f32_16x16x32_bf16(Bt[n][k], At[m][k], acc[ai][bj][m][n], 0, 0, 0); __builtin_amdgcn_s_setprio(0); } while (0)
#define PG8_WAIT_V(n) asm volatile("s_waitcnt vmcnt(" #n ")" ::: "memory")
#define PG8_WAIT_L(n) asm volatile("s_waitcnt lgkmcnt(" #n ")" ::: "memory")
#define PG8_BAR __builtin_amdgcn_s_barrier()
#define PG8_SCHED __builtin_amdgcn_sched_barrier(0)
    Unit cur, nxt; int ui = 0;
    if (!S.next(0, cur)) return;
    f32x4 acc[2][2][4][2];
#pragma unroll
    for (int a = 0; a < 2; ++a)
#pragma unroll
        for (int b = 0; b < 2; ++b)
#pragma unroll
            for (int m = 0; m < 4; ++m)
#pragma unroll
                for (int n = 0; n < 2; ++n) acc[a][b][m][n] = (f32x4){0.f, 0.f, 0.f, 0.f};
    bf16x8 At[4][2], B0[2][2], B1[2][2];
    const char* cA = (const char*)g.A + (size_t)cur.pm * tstepA; const char* cA2 = (const char*)g.A2 + (size_t)cur.pm * tstepA; const char* cB = (const char*)g.Bt + (size_t)cur.pn * tstepB;
    S.a_ready(cur);
    if constexpr (SP2) {
        PG8_STAGE(PG8_SB(0, 0), cB, voffB); PG8_STAGE(PG8_SB(0, 1), cB + hstepB, voffB); PG8_STAGE(PG8_SA(0, 0), cA, voffA); PG8_STAGE(PG8_SA(0, 1), cA + hstepA, voffA);
        if (wr == 1) PG8_BAR;
        PG8_WAIT_V(2); PG8_BAR;
        PG8_STAGE(PG8_SB(1, 0), cB + kstep, voffB); PG8_STAGE(PG8_SA(1, 0), cA + kstep, voffA); PG8_STAGE(PG8_SB(1, 1), cB + hstepB + kstep, voffB);
        PG8_WAIT_V(6); PG8_BAR;
    } else {
        PG8_STAGE(PG8_SB(0, 0), cB, voffB); PG8_STAGE(PG8_SA(0, 0), cA, voffA); PG8_STAGE(PG8_SB(0, 1), cB + hstepB, voffB); PG8_STAGE(PG8_SA(0, 1), cA + hstepA, voffA);
        if (wr == 1) PG8_BAR;
        PG8_WAIT_V(4); PG8_BAR;
        PG8_STAGE(PG8_SB(1, 0), cB + kstep, voffB); PG8_STAGE(PG8_SA(1, 0), cA + kstep, voffA); PG8_STAGE(PG8_SB(1, 1), cB + hstepB + kstep, voffB);
        PG8_WAIT_V(6); PG8_BAR;
    }
    for (;;) {
        const bool has_next = S.next(ui + 1, nxt);
        const char* nA = has_next ? (const char*)g.A + (size_t)nxt.pm * tstepA : cA; const char* nA2 = has_next ? (const char*)g.A2 + (size_t)nxt.pm * tstepA : cA2; const char* nB = has_next ? (const char*)g.Bt + (size_t)nxt.pn * tstepB : cB;
        for (int t = 0; t < nt; t += 2) {
            const bool last = (t == nt - 2);
            if constexpr (Epi::HAS_MID) { if (t == g.ksplit) E.mid(acc, cur, wr, wc, fr, fq); }
            const char* a1 = ((t + 1) < g.ksplit ? cA : cA2) + (size_t)(t + 1) * kstep;
            const char* a2 = last ? nA : ((t + 2) < g.ksplit ? cA : cA2) + (size_t)(t + 2) * kstep; const char* b2 = last ? nB : cB + (size_t)(t + 2) * kstep;
            const char* a3 = a2 + kstep; const char* b3 = b2 + kstep;
            if (last && has_next) S.a_ready(nxt);
            if constexpr (SP2) {
            PG8_LDB(B0, 0, 0); PG8_LDB(B1, 0, 1); PG8_SCHED; PG8_LDA(At, 0, 0); PG8_STAGE(PG8_SA(1, 1), a1 + hstepA, voffA);
            PG8_WAIT_V(8); PG8_WAIT_L(0); PG8_BAR; PG8_MMA(0, 0, At, B0); PG8_MMA(0, 1, At, B1); PG8_BAR; PG8_SCHED;
            PG8_LDA(At, 0, 1); PG8_STAGE(PG8_SB(0, 0), b2, voffB); PG8_STAGE(PG8_SB(0, 1), b2 + hstepB, voffB); PG8_STAGE(PG8_SA(0, 0), a2, voffA);
            PG8_WAIT_V(8); PG8_WAIT_L(0); PG8_BAR; PG8_MMA(1, 0, At, B0); PG8_MMA(1, 1, At, B1); PG8_BAR; PG8_SCHED;
            PG8_LDB(B0, 1, 0); PG8_LDB(B1, 1, 1); PG8_SCHED; PG8_LDA(At, 1, 0); PG8_STAGE(PG8_SA(0, 1), a2 + hstepA, voffA);
            PG8_WAIT_V(8); PG8_WAIT_L(0); PG8_BAR; PG8_MMA(0, 0, At, B0); PG8_MMA(0, 1, At, B1); PG8_BAR; PG8_SCHED;
            PG8_LDA(At, 1, 1); PG8_STAGE(PG8_SB(1, 0), b3, voffB); PG8_STAGE(PG8_SB(1, 1), b3 + hstepB, voffB); PG8_STAGE(PG8_SA(1, 0), a3, voffA);
            PG8_WAIT_V(8); PG8_WAIT_L(0); PG8_BAR; PG8_MMA(1, 0, At, B0); PG8_MMA(1, 1, At, B1); PG8_BAR; PG8_SCHED;
            } else {
            PG8_LDB(B0, 0, 0); PG8_SCHED; PG8_LDA(At, 0, 0); PG8_STAGE(PG8_SA(1, 1), a1 + hstepA, voffA);
            PG8_WAIT_L(8); PG8_BAR; PG8_WAIT_L(0); PG8_MMA(0, 0, At, B0); PG8_BAR; PG8_SCHED;
            PG8_LDB(B1, 0, 1); PG8_STAGE(PG8_SB(0, 0), b2, voffB);
            PG8_BAR; PG8_WAIT_L(0); PG8_MMA(0, 1, At, B1); PG8_BAR;
            PG8_LDA(At, 0, 1); PG8_STAGE(PG8_SA(0, 0), a2, voffA);
            PG8_BAR; PG8_WAIT_L(0); PG8_MMA(1, 0, At, B0); PG8_BAR; PG8_SCHED;
            PG8_STAGE(PG8_SB(0, 1), b2 + hstepB, voffB);
            PG8_WAIT_V(6); PG8_BAR; PG8_MMA(1, 1, At, B1); PG8_BAR;
            PG8_LDB(B0, 1, 0); PG8_SCHED; PG8_LDA(At, 1, 0); PG8_STAGE(PG8_SA(0, 1), a2 + hstepA, voffA);
            PG8_WAIT_L(8); PG8_BAR; PG8_WAIT_L(0); PG8_MMA(0, 0, At, B0); PG8_BAR; PG8_SCHED;
            PG8_LDB(B1, 1, 1); PG8_STAGE(PG8_SB(1, 0), b3, voffB);
            PG8_BAR; PG8_WAIT_L(0); PG8_MMA(0, 1, At, B1); PG8_BAR;
            PG8_LDA(At, 1, 1); PG8_STAGE(PG8_SA(1, 0), a3, voffA);
            PG8_BAR; PG8_WAIT_L(0); PG8_MMA(1, 0, At, B0); PG8_BAR; PG8_SCHED;
            PG8_STAGE(PG8_SB(1, 1), b3 + hstepB, voffB);
            PG8_WAIT_V(6); PG8_BAR; PG8_MMA(1, 1, At, B1); PG8_BAR;
            }
        }
        if constexpr (ALIGN_EPI) { if (wr == 0) PG8_BAR; }
        E(acc, cur, wr, wc, fr, fq); S.done(cur);
        if (!has_next) break;
#pragma unroll
        for (int a = 0; a < 2; ++a)
#pragma unroll
            for (int b = 0; b < 2; ++b)
#pragma unroll
                for (int m = 0; m < 4; ++m)
#pragma unroll
                    for (int n = 0; n < 2; ++n) acc[a][b][m][n] = (f32x4){0.f, 0.f, 0.f, 0.f};
        cur = nxt; cA = nA; cA2 = nA2; cB = nB; ++ui;
        if constexpr (ALIGN_EPI) { if (wr == 1) PG8_BAR; }
    }
    PG8_WAIT_V(0);
    if constexpr (!ALIGN_EPI) { if (wr == 0) PG8_BAR; }
    PG8_BAR;

#undef PG8_SA
#undef PG8_SB
#undef PG8_STAGE
#undef PG8_LDA
#undef PG8_LDB
#undef PG8_MMA
#undef PG8_WAIT_V
#undef PG8_WAIT_L
#undef PG8_BAR
#undef PG8_SCHED
}
}

constexpr int NWAVES = 8;
constexpr int BATCH = 4, SEQ = 4096, DM = 1024, M = BATCH * SEQ, FF = 2816, INW = 6672;
constexpr int NGU = 2 * FF;
constexpr int ZP = 4608;
constexpr int NWIN = 4864;
constexpr int NZREAL = 4624;
constexpr size_t MiB = 1u << 20;
constexpr size_t WS_CTL = 0, CTL_ZERO_BYTES = 1 * MiB;
constexpr size_t WS_BIN = 1 * MiB, WS_BG = WS_BIN + 32768;
constexpr size_t WS_WG = 2 * MiB, WS_WPROJ = 6 * MiB, WS_WOUT = 10 * MiB, WS_WGU2 = 12 * MiB, WS_WD2 = 23 * MiB;
constexpr size_t WS_ST = 29 * MiB;
constexpr size_t WS_WGU1 = 29 * MiB, WS_WD1 = 40 * MiB, WS_WIN = WS_WD1 + 5767168;
constexpr size_t WS_XB = 61 * MiB;
constexpr size_t WS_BIG = 93 * MiB;
constexpr size_t WS_IF = 237 * MiB;
constexpr size_t WS_END = 240 * MiB;
static_assert(WS_WIN + (size_t)NWIN * 1024 * 2 <= WS_XB && WS_ST + 32 * MiB <= WS_XB && WS_WD2 + (size_t)1024 * FF * 2 <= WS_ST, "ws map");
constexpr int CW_BAR = 4096;
constexpr size_t CTL_SSQ = 512 * 1024;
constexpr int RING_OFF = 0, RING_BYTES = 131072;
constexpr int LDSCTL_OFF = 151552, MISC_OFF = LDSCTL_OFF + 320;
constexpr int LDS_BYTES = 155648;

#define GAS __attribute__((address_space(1)))
#define LAS __attribute__((address_space(3)))
typedef unsigned short bf16;
typedef unsigned v4u __attribute__((ext_vector_type(4)));
typedef unsigned v2u __attribute__((ext_vector_type(2)));
typedef float f32x4 __attribute__((ext_vector_type(4)));
typedef short bf16x8 __attribute__((ext_vector_type(8)));
typedef GAS unsigned gu32;
#define RLX_AGENT __ATOMIC_RELAXED, __HIP_MEMORY_SCOPE_AGENT
#define LDS_WAIT() asm volatile("s_waitcnt lgkmcnt(0)" ::: "memory")
#define VM_WAIT() asm volatile("s_waitcnt vmcnt(0)" ::: "memory")
__device__ __forceinline__ unsigned f2bf(float f) { unsigned u = __builtin_bit_cast(unsigned, f); return (u + 0x7fffu + ((u >> 16) & 1u)) >> 16; }
__device__ __forceinline__ unsigned pk2(float lo, float hi) { return f2bf(lo) | (f2bf(hi) << 16); }
__device__ __forceinline__ float bf2f(unsigned short b) { return __builtin_bit_cast(float, (unsigned)b << 16); }

#define XB_TMO      128
#define XB_XCNT(j)  (256  + 64 * (j))
#define XB_XSUB(j)  (1280 + 64 * (j))
#define XB_XGEN(j)  (2304 + 64 * (j))
#define XB_TOP      3328
#define XB_TOPGEN   3392
#define XCD_BAR_WORDS 3456
#define XB_SPIN_CAP (1u << 23)
__device__ __forceinline__ unsigned xb_ld(unsigned* p)              { return __hip_atomic_load(p, __ATOMIC_RELAXED, __HIP_MEMORY_SCOPE_AGENT); }
__device__ __forceinline__ unsigned xb_add(unsigned* p, unsigned v) { return __hip_atomic_fetch_add(p, v, __ATOMIC_RELAXED, __HIP_MEMORY_SCOPE_AGENT); }
__device__ __forceinline__ unsigned xb_xcc_id() { return (unsigned)__builtin_amdgcn_s_getreg((3 << 11) | 20) & 0xFu; }
#define XB_SPIN(cond, bar) do { unsigned _sp = 0; while (cond) { __builtin_amdgcn_s_sleep(1); \
    if ((++_sp & 255u) == 0u) { if (xb_ld(&(bar)[XB_TMO])) break; if (_sp > XB_SPIN_CAP) { atomicAdd(&(bar)[XB_TMO], 1u); break; } } } } while (0)
struct XcdBarrier { unsigned* bar; unsigned x; volatile LAS unsigned* st; };
__device__ __forceinline__ XcdBarrier xcd_barrier_post(unsigned* bar, volatile LAS unsigned* st) {
    XcdBarrier b; b.bar = bar; b.x = xb_xcc_id(); b.st = st;
    if (threadIdx.x == 0) (void)xb_add(&bar[XB_XCNT(b.x)], 1u);
    return b;
}
__device__ __forceinline__ void xcd_barrier_complete(unsigned* bar, unsigned x, unsigned& nloc, unsigned& nx) {
    const unsigned G = gridDim.x * gridDim.y * gridDim.z;
    unsigned sum, cnt, mine, sp = 0u;
    for (;;) {
        sum = 0u; cnt = 0u; mine = 0u;
#pragma unroll
        for (unsigned j = 0; j < 16; ++j) { const unsigned c = xb_ld(&bar[XB_XCNT(j)]); sum += c; cnt += (c > 0u) ? 1u : 0u; mine = (j == x) ? c : mine; }
        if (sum == G) break;
        __builtin_amdgcn_s_sleep(1);
        if ((++sp & 255u) == 0u) { if (xb_ld(&bar[XB_TMO])) break; if (sp > XB_SPIN_CAP) { atomicAdd(&bar[XB_TMO], 1u); break; } }
    }
    nloc = mine > 0u ? mine : 1u; nx = cnt > 0u ? cnt : 1u;
}
__device__ __forceinline__ void xcd_barrier(const XcdBarrier& b) {
    asm volatile("s_waitcnt vmcnt(0)" ::: "memory");
    __syncthreads();
    if (threadIdx.x == 0) {
        unsigned* bar = b.bar;
        __builtin_amdgcn_s_waitcnt(0);
        unsigned nloc = b.st[0], nx = b.st[1];
        if (nloc == 0u) { xcd_barrier_complete(bar, b.x, nloc, nx); b.st[0] = nloc; b.st[1] = nx; }
        const unsigned old = xb_add(&bar[XB_XSUB(b.x)], 1u);
        const unsigned gen = old / nloc;
        if (old + 1u == (gen + 1u) * nloc) {
            __builtin_amdgcn_fence(__ATOMIC_RELEASE, "agent");
            asm volatile("s_waitcnt vmcnt(0)" ::: "memory");
            const unsigned og = xb_add(&bar[XB_TOP], 1u);
            const unsigned tg = og / nx;
            if (og + 1u == (tg + 1u) * nx) xb_add(&bar[XB_TOPGEN], 1u);
            else XB_SPIN(xb_ld(&bar[XB_TOPGEN]) == tg, bar);
            __builtin_amdgcn_fence(__ATOMIC_ACQUIRE, "agent");
            xb_add(&bar[XB_XGEN(b.x)], 1u);
            asm volatile("s_waitcnt vmcnt(0)" ::: "memory");
        } else {
            XB_SPIN(xb_ld(&bar[XB_XGEN(b.x)]) == gen, bar);
            __builtin_amdgcn_fence(__ATOMIC_ACQUIRE, "agent");
            asm volatile("s_waitcnt vmcnt(0)" ::: "memory");
        }
    }
    __syncthreads();
}

__device__ __forceinline__ float wave_sum(float v) {
#pragma unroll
    for (int o = 1; o < 64; o <<= 1) v += __shfl_xor(v, o);
    return v;
}
template <class RowMap>
__device__ __forceinline__ void transpose_item(const float* W, int N, const float* g, LAS float* scr, int item, int lane, const RowMap& rm) {
    const int nblk = (N + 31) / 32, kb = item / nblk, nb = item % nblk, k0 = 64 * kb, n0 = 32 * nb;
    const int nl = lane & 31, nsrc = n0 + nl;
#pragma unroll 8
    for (int i = 0; i < 32; ++i) { const int kk = 2 * i + (lane >> 5); float v = nsrc < N ? W[(size_t)(k0 + kk) * N + nsrc] : 0.f; if (g) v *= g[k0 + kk]; scr[kk * 33 + nl] = v; }
    LDS_WAIT(); asm volatile("" ::: "memory");
    const int c = lane & 7;
#pragma unroll
    for (int j = 0; j < 4; ++j) { const int n = (lane >> 3) + 8 * j; const LAS float* s = scr + (8 * c) * 33 + n;
        v4u o; o.x = pk2(s[0 * 33], s[1 * 33]); o.y = pk2(s[2 * 33], s[3 * 33]); o.z = pk2(s[4 * 33], s[5 * 33]); o.w = pk2(s[6 * 33], s[7 * 33]);
        if (n0 + n < N) *(GAS v4u*)(rm(n0 + n) + k0 + 8 * c) = o; }
    LDS_WAIT(); asm volatile("" ::: "memory");
}
struct RmGate { bf16* W; __device__ __forceinline__ bf16* operator()(int n) const { return W + (size_t)(256 * (n >> 7) + (n & 127)) * 1024; } };
struct RmUp   { bf16* W; __device__ __forceinline__ bf16* operator()(int n) const { return W + (size_t)(256 * (n >> 7) + 128 + (n & 127)) * 1024; } };
struct RmLin  { bf16* W; int ld, koff; __device__ __forceinline__ bf16* operator()(int n) const { return W + (size_t)n * ld + koff; } };
struct RmWin  { bf16* Win; bf16* Wg; __device__ __forceinline__ bf16* operator()(int n) const { return n < NZREAL ? Win + (size_t)n * 1024 : Wg + (size_t)(n - NZREAL) * 1024; } };


namespace nv {
constexpr int S = 4096, AH = 16, AKV = 4, HD = 64, WIN_ = 128, MH = 8, CH = 64;
constexpr float EPS = 1e-6f, CAP = 15.0f;
__device__ __forceinline__ float sigmoidf_(float x) { return 1.0f / (1.0f + expf(-x)); }
__device__ __forceinline__ float siluf_(float x) { return x / (1.0f + expf(-x)); }
__device__ __forceinline__ float ld(const bf16* p) { return bf2f(*p); }
__device__ __forceinline__ void st(bf16* p, float v) { *p = (bf16)f2bf(v); }
__device__ __forceinline__ void attn_item(bf16* Z, const float* sinks, int w, int lane) {
    const int r = w / AH, hq = w % AH, hk = hq / (AH / AKV), t = r % S, rb = r - t;
    const float q = ld(Z + (size_t)r * ZP + hq * HD + lane);
    float m = sinks[hq], l = 1.0f, acc = 0.f;
    const int j0 = t - (WIN_ - 1) < 0 ? 0 : t - (WIN_ - 1);
    for (int j = j0; j <= t; ++j) {
        const float kv = ld(Z + (size_t)(rb + j) * ZP + 1024 + hk * HD + lane);
        const float s = wave_sum(q * kv) * 0.125f;
        const float mn = fmaxf(m, s), f = expf(m - mn), p = expf(s - mn);
        l = l * f + p; acc = acc * f + p * ld(Z + (size_t)(rb + j) * ZP + 1280 + hk * HD + lane); m = mn;
    }
    st(Z + (size_t)r * ZP + hq * HD + lane, acc / l);
}
__device__ __forceinline__ void conv_item(const bf16* Z, const float* cw, bf16* qk, int idx) {
    const int r = idx >> 10, c = idx & 1023, t = r % S;
    float a = 0.f;
#pragma unroll
    for (int j = 0; j < 4; ++j) { const int tt = t - 3 + j; if (tt >= 0) a += ld(Z + (size_t)(r - 3 + j) * ZP + 1536 + c) * cw[j * 1024 + c]; }
    a = siluf_(a); if (c >= 512) a *= 0.125f;
    st(qk + (size_t)r * 1024 + c, a);
}
constexpr int MLSTM_LDS = (64 * 128 * 3 + 64 * 65 * 3 + 64 * 6 + 8 + 64) * 4;
__device__ __forceinline__ void mlstm_seq(bf16* Z, const float* IF, const bf16* qk, const float* hnorm, int bh, LAS float* sm) {
    LAS float* Cs = sm; LAS float* qs = Cs + 64 * 128; LAS float* ks = qs + 64 * 65; LAS float* vs = ks + 64 * 65; LAS float* Ss = vs + 64 * 128; LAS float* ns = Ss + 64 * 65;
    LAS float* ig = ns + 64; LAS float* cum = ig + 64; LAS float* mt = cum + 64; LAS float* wint = mt + 64; LAS float* wk = wint + 64; LAS float* hs = wk + 64; LAS float* sc = hs + 64 * 128; LAS float* den = sc + 8;
    const int h = bh % MH, b = bh / MH, tid = threadIdx.x;
    for (int i = tid; i < 64 * 128; i += 512) Cs[i] = 0.f;
    if (tid < 64) ns[tid] = 0.f;
    if (tid == 0) sc[0] = 0.f;
    __syncthreads();
    for (int c = 0; c < S / CH; ++c) {
        const size_t r0 = (size_t)b * S + c * CH;
        for (int i = tid; i < 64 * 64; i += 512) { const int t = i >> 6, d = i & 63; qs[t * 65 + d] = ld(qk + (r0 + t) * 1024 + h * 64 + d); ks[t * 65 + d] = ld(qk + (r0 + t) * 1024 + 512 + h * 64 + d); }
        for (int i = tid; i < 64 * 128; i += 512) { const int t = i >> 7, v = i & 127; vs[i] = ld(Z + (r0 + t) * ZP + 2560 + h * 128 + v); }
        if (tid < 64) {
            const float ip = IF[(r0 + tid) * 16 + h], fp = IF[(r0 + tid) * 16 + 8 + h];
            ig[tid] = CAP * tanhf(ip / CAP);
            const float fc = CAP * tanhf(fp / CAP);
            cum[tid] = fc >= 0.f ? -log1pf(expf(-fc)) : fc - log1pf(expf(fc));
        }
        __syncthreads();
        if (tid == 0) { float a = 0.f; for (int t = 0; t < 64; ++t) { a += cum[t]; cum[t] = a; } }
        __syncthreads();
        const float m_prev = sc[0];
        if (tid < 64) {
            float mx = -INFINITY;
            for (int s = 0; s <= tid; ++s) mx = fmaxf(mx, cum[tid] - cum[s] + ig[s]);
            const float li = cum[tid] + m_prev, m = fmaxf(li, mx);
            mt[tid] = m; wint[tid] = expf(li - m);
        }
        if (tid == 64) {
            const float total = cum[63]; float mx = -INFINITY;
            for (int s = 0; s < 64; ++s) mx = fmaxf(mx, total - cum[s] + ig[s]);
            const float mn = fmaxf(total + m_prev, mx);
            sc[1] = mn; sc[2] = expf(total + m_prev - mn);
        }
        __syncthreads();
        if (tid < 64) wk[tid] = expf(cum[63] - cum[tid] + ig[tid] - sc[1]);
        for (int i = tid; i < 64 * 64; i += 512) {
            const int t = i >> 6, s = i & 63; float v = 0.f;
            if (s <= t) { float d = 0.f; for (int k = 0; k < 64; ++k) d = fmaf(qs[t * 65 + k], ks[s * 65 + k], d); v = d * expf(cum[t] - cum[s] + ig[s] - mt[t]); }
            Ss[t * 65 + s] = v;
        }
        __syncthreads();
        if (tid < 64) { float d = 0.f; for (int s = 0; s < 64; ++s) d += Ss[tid * 65 + s]; float qn = 0.f; for (int k = 0; k < 64; ++k) qn = fmaf(qs[tid * 65 + k], ns[k], qn);
            d += wint[tid] * qn; den[tid] = fmaxf(fabsf(d), expf(-mt[tid])); }
        __syncthreads();
        for (int i = tid; i < 64 * 128; i += 512) {
            const int t = i >> 7, v = i & 127; float a = 0.f, bq = 0.f;
            for (int s = 0; s <= t; ++s) a = fmaf(Ss[t * 65 + s], vs[s * 128 + v], a);
            for (int k = 0; k < 64; ++k) bq = fmaf(qs[t * 65 + k], Cs[k * 128 + v], bq);
            hs[i] = (a + wint[t] * bq) / den[t];
        }
        __syncthreads();
        for (int i = tid; i < 64 * 128; i += 512) {
            const int d = i >> 7, v = i & 127; float a = 0.f;
            for (int s = 0; s < 64; ++s) a = fmaf(wk[s] * ks[s * 65 + d], vs[s * 128 + v], a);
            Cs[i] = sc[2] * Cs[i] + a;
        }
        if (tid < 64) { float a = 0.f; for (int s = 0; s < 64; ++s) a = fmaf(wk[s], ks[s * 65 + tid], a); ns[tid] = sc[2] * ns[tid] + a; }
        {
            const int wv = tid >> 6, lane = tid & 63;
            for (int t = wv; t < 64; t += 8) {
                const float a = hs[t * 128 + lane], bb = hs[t * 128 + 64 + lane];
                const float rr = rsqrtf(wave_sum(a * a + bb * bb) * (1.0f / 128.0f) + EPS);
                bf16* zr = Z + (r0 + t) * ZP;
                st(zr + 2560 + h * 128 + lane, sigmoidf_(ld(zr + 3584 + h * 128 + lane)) * a * rr * hnorm[h * 128 + lane]);
                st(zr + 2560 + h * 128 + 64 + lane, sigmoidf_(ld(zr + 3584 + h * 128 + 64 + lane)) * bb * rr * hnorm[h * 128 + 64 + lane]);
            }
        }
        __syncthreads();
        if (tid == 0) sc[0] = sc[1];
        __syncthreads();
    }
}
}

namespace att {
typedef float f32x16 __attribute__((ext_vector_type(16)));
typedef short s16x4 __attribute__((ext_vector_type(4)));
constexpr int KSTR = 144, VSTR = 192, STG_STR = 144;
constexpr int LDS_K = 0, LDS_V = 256 * KSTR, LDS_STG = LDS_V + 256 * VSTR, LDS_END = LDS_STG + 8 * 32 * STG_STR;
__device__ __forceinline__ s16x4 tr_read(LAS const unsigned char* p) { return __builtin_bit_cast(s16x4, __builtin_amdgcn_ds_read_tr16_b64_v4i16((LAS s16x4*)p)); }
__device__ __forceinline__ unsigned pk_bf16(float lo, float hi) { unsigned r; asm volatile("v_cvt_pk_bf16_f32 %0, %1, %2" : "=v"(r) : "v"(lo), "v"(hi)); return r; }

__device__ __forceinline__ void attn_unit(bf16* Z, const float* sinks, int b, int hkv, int qb, LAS unsigned char* lds) {
    const int tid = threadIdx.x, lane = tid & 63, wave = __builtin_amdgcn_readfirstlane(tid >> 6), c = lane & 31, hi = lane >> 5;
    const int q0 = qb * 128; const size_t rowbase = (size_t)b * SEQ;
#pragma unroll
    for (int i = 0; i < 4; ++i) {
        const int idx = tid + 512 * i, kk = idx >> 3, ch = idx & 7, pos = q0 - 128 + kk;
        v4u kv = (v4u){0u, 0u, 0u, 0u}, vv = (v4u){0u, 0u, 0u, 0u};
        if (pos >= 0) { const bf16* zr = Z + (rowbase + pos) * ZP + hkv * 64 + ch * 8; kv = *(const v4u*)(zr + 1024); vv = *(const v4u*)(zr + 1280); }
        *(LAS v4u*)(lds + LDS_K + kk * KSTR + ch * 16) = kv;
        *(LAS v4u*)(lds + LDS_V + kk * VSTR + ch * 16) = vv;
    }
    __syncthreads();
    const int hq = hkv * 4 + (wave >> 1);
    const float sink8 = sinks[hq] * 8.0f;
    const float cs = 0.125f * 1.4426950408889634f;
#pragma unroll 1
    for (int blk = 0; blk < 2; ++blk) {
        const int i32 = 2 * (wave & 1) + blk, qs = q0 + 32 * i32;
        bf16* qrow = Z + (rowbase + qs + c) * ZP + hq * 64;
        bf16x8 qf[4];
#pragma unroll
        for (int s = 0; s < 4; ++s) qf[s] = *(const bf16x8*)(qrow + 16 * s + 8 * hi);
        f32x16 st[5];
#pragma unroll
        for (int j = 0; j < 5; ++j) {
            LAS const unsigned char* kb = lds + LDS_K + (32 * i32 + 32 * j + c) * KSTR + hi * 16;
            f32x16 acc = {};
#pragma unroll
            for (int s = 0; s < 4; ++s) { const bf16x8 kf = *(LAS const bf16x8*)(kb + s * 32); acc = __builtin_amdgcn_mfma_f32_32x32x16_bf16(kf, qf[s], acc, 0, 0, 0); }
            st[j] = acc;
        }
#pragma unroll
        for (int r = 0; r < 16; ++r) {
            const int rr = (r & 3) + 8 * (r >> 2) + 4 * hi;
            if (!(rr > c)) st[0][r] = -INFINITY;
            if (!(rr <= c)) st[4][r] = -INFINITY;
        }
        if (qb == 0) {
#pragma unroll
            for (int j = 0; j < 5; ++j)
#pragma unroll
                for (int r = 0; r < 16; ++r) { const int rr = (r & 3) + 8 * (r >> 2) + 4 * hi; if (32 * i32 + 32 * j + rr < 128) st[j][r] = -INFINITY; }
        }
        float m = sink8;
#pragma unroll
        for (int j = 0; j < 5; ++j)
#pragma unroll
            for (int r = 0; r < 16; ++r) m = fmaxf(m, st[j][r]);
        m = fmaxf(m, __shfl_xor(m, 32));
        const float mb = m * cs; float sum = 0.f;
        bf16x8 pf[5][2];
#pragma unroll
        for (int j = 0; j < 5; ++j) {
            float p[16];
#pragma unroll
            for (int r = 0; r < 16; ++r) { p[r] = __builtin_amdgcn_exp2f(st[j][r] * cs - mb); sum += p[r]; }
#pragma unroll
            for (int s = 0; s < 2; ++s) { v4u w; w.x = pk_bf16(p[8 * s], p[8 * s + 1]); w.y = pk_bf16(p[8 * s + 2], p[8 * s + 3]); w.z = pk_bf16(p[8 * s + 4], p[8 * s + 5]); w.w = pk_bf16(p[8 * s + 6], p[8 * s + 7]);
                pf[j][s] = __builtin_bit_cast(bf16x8, w); }
        }
        sum += __shfl_xor(sum, 32);
        sum += __builtin_amdgcn_exp2f(sink8 * cs - mb);
        f32x16 ot[2] = {};
        const int g16 = (lane >> 4) & 1, q4 = (lane & 15) >> 2, p4 = lane & 3;
        LAS const unsigned char* vb = lds + LDS_V + (32 * i32 + 4 * hi + q4) * VSTR + (16 * g16 + 4 * p4) * 2;
#pragma unroll
        for (int j = 0; j < 5; ++j)
#pragma unroll
            for (int s = 0; s < 2; ++s)
#pragma unroll
                for (int db = 0; db < 2; ++db) {
                    const s16x4 lo = tr_read(vb + (32 * j + 16 * s) * VSTR + db * 64), hh = tr_read(vb + (32 * j + 16 * s + 8) * VSTR + db * 64);
                    const bf16x8 vf = (bf16x8){lo[0], lo[1], lo[2], lo[3], hh[0], hh[1], hh[2], hh[3]};
                    ot[db] = __builtin_amdgcn_mfma_f32_32x32x16_bf16(vf, pf[j][s], ot[db], 0, 0, 0);
                }
        const float inv = __builtin_amdgcn_rcpf(sum);
        LAS unsigned char* stg = lds + LDS_STG + wave * (32 * STG_STR);
#pragma unroll
        for (int db = 0; db < 2; ++db)
#pragma unroll
            for (int g = 0; g < 4; ++g) {
                v2u w; w.x = pk_bf16(ot[db][4 * g] * inv, ot[db][4 * g + 1] * inv); w.y = pk_bf16(ot[db][4 * g + 2] * inv, ot[db][4 * g + 3] * inv);
                *(LAS v2u*)(stg + c * STG_STR + (32 * db + 8 * g + 4 * hi) * 2) = w;
            }
        LDS_WAIT(); asm volatile("" ::: "memory");
#pragma unroll
        for (int it = 0; it < 4; ++it) {
            const int row = it * 8 + (lane >> 3), chn = lane & 7;
            const v4u v = *(LAS const v4u*)(stg + row * STG_STR + chn * 16);
            *(v4u*)(Z + (rowbase + qs + row) * ZP + hq * 64 + chn * 8) = v;
        }
        LDS_WAIT(); asm volatile("" ::: "memory");
    }
    __syncthreads();
}
}

struct Args { const float* in[19]; float* out; unsigned char* ws; int ph_lo, ph_hi, use_bar, pad; };

__global__ void __launch_bounds__(NWAVES * 64, 2) mk_fwd(Args args) {
    extern __shared__ __attribute__((aligned(16))) unsigned char lds_raw[];
    LAS unsigned char* lds = (LAS unsigned char*)lds_raw;
    volatile LAS unsigned* MISC = (volatile LAS unsigned*)(lds + MISC_OFF);
    const int tid = threadIdx.x, lane = tid & 63, wave = __builtin_amdgcn_readfirstlane(tid >> 6);
    const int G = gridDim.x, bx = blockIdx.x, vcu = (G % 8 == 0) ? (bx % 8) * (G / 8) + bx / 8 : bx;
    unsigned char* ws = args.ws;
    gu32* ctl = (gu32*)(ws + WS_CTL);
    float* SSQ = (float*)(ws + WS_CTL + CTL_SSQ);
    const float* x = args.in[0];
    bf16 *WGU1 = (bf16*)(ws + WS_WGU1), *WD1 = (bf16*)(ws + WS_WD1), *WIN = (bf16*)(ws + WS_WIN), *WG = (bf16*)(ws + WS_WG), *WPROJ = (bf16*)(ws + WS_WPROJ),
         *WOUT = (bf16*)(ws + WS_WOUT), *WGU2 = (bf16*)(ws + WS_WGU2), *WD2 = (bf16*)(ws + WS_WD2);
    bf16 *XB = (bf16*)(ws + WS_XB), *BIG = (bf16*)(ws + WS_BIG);
    float *BIN = (float*)(ws + WS_BIN), *BG = (float*)(ws + WS_BG), *IFB = (float*)(ws + WS_IF);
    bf16* MG = (bf16*)(ws + WS_ST);
    for (int u = tid; u < (LDS_BYTES - LDSCTL_OFF) / 4; u += NWAVES * 64) ((LAS unsigned*)(lds + LDSCTL_OFF))[u] = 0u;
    __syncthreads();
    XcdBarrier bar; bar.bar = (unsigned*)(ctl + CW_BAR); bar.x = 0; bar.st = nullptr;
    if (args.use_bar) bar = xcd_barrier_post((unsigned*)(ctl + CW_BAR), MISC + 8);
    const int lo = args.ph_lo, hi = args.ph_hi;
#define IN(k) (lo <= (k) && (k) < hi)
#define SEAM(k) do { if (IN(k) && IN((k) + 1)) xcd_barrier(bar); } while (0)

    if (IN(0)) {
        LAS float* scr = (LAS float*)(lds + RING_OFF + wave * 16384);
        const int gw = vcu * NWAVES + wave, NGW = G * NWAVES;
        constexpr int I_GU = 16 * (FF / 32), I_D = (FF / 64) * 32, I_WIN = 16 * ((INW + 31) / 32), I_SQ = 16 * 32;
        constexpr int NITEMS = 4 * I_GU + 2 * I_D + I_WIN + 3 * I_SQ;
        for (int it = gw; it < NITEMS; it += NGW) {
            int r = it;
            if (r < I_GU) { transpose_item(args.in[2], FF, args.in[1], scr, r, lane, RmGate{WGU1}); continue; } r -= I_GU;
            if (r < I_GU) { transpose_item(args.in[3], FF, args.in[1], scr, r, lane, RmUp{WGU1}); continue; } r -= I_GU;
            if (r < I_D) { transpose_item(args.in[4], DM, nullptr, scr, r, lane, RmLin{WD1, FF, 0}); continue; } r -= I_D;
            if (r < I_WIN) { transpose_item(args.in[6], INW, args.in[5], scr, r, lane, RmWin{WIN, WG}); continue; } r -= I_WIN;
            if (r < I_SQ) { transpose_item(args.in[11], DM, nullptr, scr, r, lane, RmLin{WPROJ, 2048, 0}); continue; } r -= I_SQ;
            if (r < I_SQ) { transpose_item(args.in[12], DM, nullptr, scr, r, lane, RmLin{WPROJ, 2048, 1024}); continue; } r -= I_SQ;
            if (r < I_SQ) { transpose_item(args.in[13], DM, nullptr, scr, r, lane, RmLin{WOUT, 1024, 0}); continue; } r -= I_SQ;
            if (r < I_GU) { transpose_item(args.in[15], FF, args.in[14], scr, r, lane, RmGate{WGU2}); continue; } r -= I_GU;
            if (r < I_GU) { transpose_item(args.in[16], FF, args.in[14], scr, r, lane, RmUp{WGU2}); continue; } r -= I_GU;
            transpose_item(args.in[17], DM, nullptr, scr, r, lane, RmLin{WD2, FF, 0});
        }
        { const int gt = vcu * (NWAVES * 64) + tid, NGT = G * NWAVES * 64;
          GAS v4u* z = (GAS v4u*)(WIN + (size_t)NZREAL * 1024);
          for (int i = gt; i < (NWIN - NZREAL) * 1024 * 2 / 16; i += NGT) z[i] = (v4u){0u, 0u, 0u, 0u};
          for (int i = gt; i < NWIN; i += NGT) BIN[i] = i < NZREAL ? args.in[7][i] : 0.f;
          for (int i = gt; i < 2048; i += NGT) BG[i] = args.in[7][NZREAL + i]; }
        for (int m = gw; m < M; m += NGW) {
            const GAS f32x4* xr = (const GAS f32x4*)(x + (size_t)m * DM) + lane;
            f32x4 v[4]; float s = 0.f;
#pragma unroll
            for (int j = 0; j < 4; ++j) { v[j] = xr[64 * j]; s += (v[j].x * v[j].x + v[j].y * v[j].y) + (v[j].z * v[j].z + v[j].w * v[j].w); }
            s = wave_sum(s);
            GAS v2u* o8 = (GAS v2u*)(XB + (size_t)m * DM) + lane;
#pragma unroll
            for (int j = 0; j < 4; ++j) o8[64 * j] = (v2u){pk2(v[j].x, v[j].y), pk2(v[j].z, v[j].w)};
            if (lane == 0) SSQ[m] = s;
        }
        SEAM(0);
    }
    if (IN(1)) {
        pg8::Gemm g{XB, XB, WGU1, 1024, 1024, 1024, 1 << 30}; pg8::StaticOrder S; S.init(M, NGU, G, bx);
        pg8::EpiSwiglu E{BIG, FF, SSQ};
        pg8::gemm_phase<pg8::EpiSwiglu, pg8::StaticOrder, true, true>(lds + RING_OFF, g, S, E);
        SEAM(1);
    }
    if (IN(2)) {
        pg8::Gemm g{BIG, BIG, WD1, FF, FF, FF, 1 << 30}; pg8::StaticOrder S; S.init(M, DM, G, bx);
        pg8::EpiRes E{x, args.out, XB, SSQ + M, 0.5f};
        pg8::gemm_phase<pg8::EpiRes, pg8::StaticOrder, true, true>(lds + RING_OFF, g, S, E);
        SEAM(2);
    }

    if (IN(3)) {
        pg8::Gemm g{XB, XB, WIN, 1024, 1024, 1024, 1 << 30}; pg8::StaticOrder S; S.init(M, NWIN, G, bx);
        pg8::EpiWin E{BIG, ZP, IFB, BIN, SSQ + M};
        pg8::gemm_phase<pg8::EpiWin, pg8::StaticOrder, true, true>(lds + RING_OFF, g, S, E);
        SEAM(3);
    }

    if (IN(4)) {
        const int gw = vcu * NWAVES + wave, NGW = G * NWAVES;
        for (int u = bx; u < BATCH * 4 * 32; u += G) att::attn_unit(BIG, args.in[8], u >> 7, (u >> 5) & 3, u & 31, lds + RING_OFF);
        const int gt = vcu * (NWAVES * 64) + tid, NGT = G * NWAVES * 64;
        for (int i = gt; i < M * 1024; i += NGT) nv::conv_item(BIG, args.in[9], MG, i);
        SEAM(4);
    }
    if (IN(5)) {
        if (bx < 32) nv::mlstm_seq(BIG, IFB, MG, args.in[10], bx, (LAS float*)(lds + RING_OFF));
        SEAM(5);
    }
    if (IN(6)) {
        pg8::Gemm g{XB, XB, WG, 1024, 1024, 1024, 1 << 30}; pg8::StaticOrder S; S.init(M, 2048, G, bx);
        pg8::EpiGate E{BIG, ZP, 1536, 3584, BG, SSQ + M};
        pg8::gemm_phase<pg8::EpiGate, pg8::StaticOrder, true, true>(lds + RING_OFF, g, S, E);
        SEAM(6);
    }
    if (IN(7)) {
        pg8::Gemm g{BIG, BIG + 2560 - 1024, WPROJ, ZP, 2048, 2048, 16}; pg8::StaticOrder S; S.init(M, DM, G, bx);
        pg8::EpiProj E{BIG, ZP, 1536, 3584, MG};
        pg8::gemm_phase<pg8::EpiProj, pg8::StaticOrder, true, true>(lds + RING_OFF, g, S, E);
        SEAM(7);
    }
    if (IN(8)) {
        pg8::Gemm g{MG, MG, WOUT, 1024, 1024, 1024, 1 << 30}; pg8::StaticOrder S; S.init(M, DM, G, bx);
        pg8::EpiRes E{args.out, args.out, XB, SSQ + 2 * M, 1.0f};
        pg8::gemm_phase<pg8::EpiRes, pg8::StaticOrder, true, true>(lds + RING_OFF, g, S, E);
        SEAM(8);
    }
    if (IN(9)) {
        pg8::Gemm g{XB, XB, WGU2, 1024, 1024, 1024, 1 << 30}; pg8::StaticOrder S; S.init(M, NGU, G, bx);
        pg8::EpiSwiglu E{BIG, FF, SSQ + 2 * M};
        pg8::gemm_phase<pg8::EpiSwiglu, pg8::StaticOrder, true, true>(lds + RING_OFF, g, S, E);
        SEAM(9);
    }
    if (IN(10)) {
        pg8::Gemm g{BIG, BIG, WD2, FF, FF, FF, 1 << 30}; pg8::StaticOrder S; S.init(M, DM, G, bx);
        pg8::EpiRes E{args.out, args.out, nullptr, SSQ + 3 * M, 0.5f};
        pg8::gemm_phase<pg8::EpiRes, pg8::StaticOrder, true, true>(lds + RING_OFF, g, S, E);
        SEAM(10);
    }
    if (IN(11)) {
        const int gw = vcu * NWAVES + wave, NGW = G * NWAVES; const float* gf = args.in[18];
        for (int m = gw; m < M; m += NGW) {
            GAS f32x4* xr = (GAS f32x4*)(args.out + (size_t)m * DM) + lane;
            const float rs = pg8::rstd_of(SSQ[3 * M + m]);
#pragma unroll
            for (int j = 0; j < 4; ++j) { const f32x4 gv = *((const f32x4*)gf + lane + 64 * j); f32x4 v = xr[64 * j]; xr[64 * j] = v * rs * gv; }
        }
    }
#undef IN
#undef SEAM
}

extern "C" void kernel_launch(void* const* d_in, const int* in_sizes, int n_in, void* d_out, int out_size, void* d_ws, size_t ws_size, hipStream_t stream) {
    static int grid = 0;
    if (grid == 0) {
        int dev = 0, cus = 0, per_cu = 0;
        if (n_in != 19 || out_size != M * DM || ws_size < WS_END) { fprintf(stderr, "kernel_launch: unexpected problem shape (n_in %d out %d ws %zu)\n", n_in, out_size, ws_size); grid = -1; return; }
        if (hipGetDevice(&dev) != hipSuccess || hipDeviceGetAttribute(&cus, hipDeviceAttributeMultiprocessorCount, dev) != hipSuccess) { grid = -1; return; }
        if (hipFuncSetAttribute((const void*)mk_fwd, hipFuncAttributeMaxDynamicSharedMemorySize, LDS_BYTES) != hipSuccess) { fprintf(stderr, "kernel_launch: hipFuncSetAttribute failed\n"); grid = -1; return; }
        if (hipOccupancyMaxActiveBlocksPerMultiprocessor(&per_cu, (const void*)mk_fwd, NWAVES * 64, LDS_BYTES) != hipSuccess || per_cu < 1) { fprintf(stderr, "kernel_launch: occupancy query says %d blocks per CU\n", per_cu); grid = -1; return; }
        (void)hipGetLastError();
        grid = cus;
    }
    if (grid < 0) return;
    (void)hipMemsetAsync((char*)d_ws + WS_CTL, 0, CTL_ZERO_BYTES, stream);
    Args a{};
    for (int i = 0; i < 19; ++i) a.in[i] = (const float*)d_in[i];
    a.out = (float*)d_out; a.ws = (unsigned char*)d_ws; a.use_bar = 1; a.ph_lo = 0; a.ph_hi = 12;
    hipLaunchKernelGGL(mk_fwd, dim3(grid), dim3(NWAVES * 64), LDS_BYTES, stream, a);
}
```

```cpp
#include <hip/hip_runtime.h>
#include <cstdio>
#include <cstdint>
namespace pg8 {
#define PG8_LAS __attribute__((address_space(3)))
typedef unsigned short bf16_t;
typedef short bf16x8 __attribute__((ext_vector_type(8)));
typedef float f32x4 __attribute__((ext_vector_type(4)));
typedef unsigned u32x4 __attribute__((ext_vector_type(4)));
typedef unsigned u32x2 __attribute__((ext_vector_type(2)));
constexpr int BM = 256, BK = 64, HALF = 128, HTB = HALF * BK * 2  , STAGE_BYTES = 8 * HTB, NXCD = 8, WGM = 8;
constexpr float RMS_EPS = 1e-6f;

__host__ __device__ __forceinline__ int lds_byte(int r, int c) { const int st = (r >> 4) * 2 + (c >> 5), rr = r & 15, cc = c & 31, ob = rr * 64 + cc * 2; return st * 1024 + (ob ^ (((ob >> 9) & 1) << 5)); }
__host__ __device__ __forceinline__ void stage_rc(int b, int& R, int& C) { const int st = b / 1024, sb = b % 1024, swz = sb ^ (((sb >> 9) & 1) << 5); R = (st >> 1) * 16 + swz / 64; C = (st & 1) * 32 + (swz % 64) / 2; }
__host__ __device__ __forceinline__ int perm32(int rho) { const int n = rho >> 4, i = rho & 15; return 8 * (i >> 2) + 4 * n + (i & 3); }

struct Unit { int pm, pn; };
struct Gemm { const bf16_t* A; const bf16_t* A2; const bf16_t* Bt; int lda, ldb, K, ksplit; };

struct StaticOrder {
    int nM, nN, nwg, G, c;
    __host__ __device__ void init(int M, int N, int G_, int c_) { nM = M / BM; nN = N / BM; nwg = nM * nN; G = G_; c = c_; }
    __host__ __device__ bool next(int i, Unit& u) const {
        const long L = (long)i * G + c; if (L >= nwg) return false;
        int wgid = (int)L; { const int q = nwg / NXCD, r = nwg % NXCD, xcd = wgid % NXCD, off = wgid / NXCD; wgid = (xcd < r ? xcd * (q + 1) : r * (q + 1) + (xcd - r) * q) + off; }
        const int nig = WGM * nN, gid = wgid / nig, fm = gid * WGM, gsz = (nM - fm) < WGM ? (nM - fm) : WGM;
        u.pm = fm + ((wgid % nig) % gsz); u.pn = (wgid % nig) / gsz; return true;
    }
    __device__ __forceinline__ void a_ready(const Unit&) const {}
    __device__ __forceinline__ void done(const Unit&) const {}
};

typedef float f32x2_t __attribute__((ext_vector_type(2))); typedef __bf16 bf16x2_t __attribute__((ext_vector_type(2)));
__device__ __forceinline__ unsigned cvt_pk_bf16(float lo, float hi) { f32x2_t v = {lo, hi}; bf16x2_t b = __builtin_convertvector(v, bf16x2_t); return __builtin_bit_cast(unsigned, b); }
__device__ __forceinline__ float fast_sigmoid(float x) { return __builtin_amdgcn_rcpf(1.0f + __builtin_amdgcn_exp2f(-1.4426950408889634f * x)); }
__device__ __forceinline__ float rstd_of(float ssq) { return __builtin_amdgcn_rsqf(ssq * (1.0f / 1024.0f) + RMS_EPS); }

struct EpiSwiglu {
    static constexpr bool PERM = true, HAS_MID = false;
    bf16_t* O; int ldo; const float* ssq;
    __device__ __forceinline__ void operator()(const f32x4 (&acc)[2][2][4][2], const Unit& u, int wr, int wc, int fr, int fq) const {
        const int row0 = u.pm * BM + wr * 64 + fr, col0 = u.pn * HALF + wc * 32 + 8 * fq;
#pragma unroll
        for (int ai = 0; ai < 2; ++ai)
#pragma unroll
            for (int m = 0; m < 4; ++m) {
                const int r = row0 + ai * HALF + m * 16; const float rs = rstd_of(ssq[r]);
                float o[8];
#pragma unroll
                for (int n = 0; n < 2; ++n)
#pragma unroll
                    for (int j = 0; j < 4; ++j) { const float gv = acc[ai][0][m][n][j] * rs, uv = acc[ai][1][m][n][j] * rs; o[4 * n + j] = gv * fast_sigmoid(gv) * uv; }
                u32x4 w; w.x = cvt_pk_bf16(o[0], o[1]); w.y = cvt_pk_bf16(o[2], o[3]); w.z = cvt_pk_bf16(o[4], o[5]); w.w = cvt_pk_bf16(o[6], o[7]);
                *(u32x4*)(O + (size_t)r * ldo + col0) = w;
            }
    }
};
struct EpiRes {
    static constexpr bool PERM = false, HAS_MID = false;
    const float* R; float* X; bf16_t* Xb; float* ssq; float alpha;
    __device__ __forceinline__ void operator()(const f32x4 (&acc)[2][2][4][2], const Unit& u, int wr, int wc, int fr, int fq) const {
        const int row0 = u.pm * BM + wr * 64 + fr, col0 = u.pn * BM + wc * 32 + 4 * fq;
#pragma unroll
        for (int ai = 0; ai < 2; ++ai)
#pragma unroll
            for (int m = 0; m < 4; ++m) {
                const int r = row0 + ai * HALF + m * 16; float sq = 0.f;
#pragma unroll
                for (int bj = 0; bj < 2; ++bj)
#pragma unroll
                    for (int n = 0; n < 2; ++n) {
                        const size_t off = (size_t)r * 1024 + col0 + bj * HALF + n * 16;
                        const f32x4 x = *(const f32x4*)(R + off) + acc[ai][bj][m][n] * alpha;
                        *(f32x4*)(X + off) = x; sq += (x[0] * x[0] + x[1] * x[1]) + (x[2] * x[2] + x[3] * x[3]);
                        if (Xb) { u32x2 w; w.x = cvt_pk_bf16(x[0], x[1]); w.y = cvt_pk_bf16(x[2], x[3]); *(u32x2*)(Xb + off) = w; }
                    }
                sq += __shfl_xor(sq, 16); sq += __shfl_xor(sq, 32);
                if (fq == 0) atomicAdd(ssq + r, sq);
            }
    }
};
struct EpiWin {
    static constexpr bool PERM = true, HAS_MID = false;
    bf16_t* Z; int ldz; float* IF; const float* bias; const float* ssq;
    __device__ __forceinline__ void operator()(const f32x4 (&acc)[2][2][4][2], const Unit& u, int wr, int wc, int fr, int fq) const {
        const int row0 = u.pm * BM + wr * 64 + fr, cw = wc * 32 + 8 * fq;
        const bool ztile = u.pn < 18;
#pragma unroll
        for (int ai = 0; ai < 2; ++ai)
#pragma unroll
            for (int m = 0; m < 4; ++m) {
                const int r = row0 + ai * HALF + m * 16; const float rs = rstd_of(ssq[r]);
#pragma unroll
                for (int bj = 0; bj < 2; ++bj) {
                    const int c = u.pn * BM + bj * HALF + cw;
                    const f32x4 v0 = acc[ai][bj][m][0] * rs + *(const f32x4*)(bias + c), v1 = acc[ai][bj][m][1] * rs + *(const f32x4*)(bias + c + 4);
                    if (ztile) { u32x4 w; w.x = cvt_pk_bf16(v0[0], v0[1]); w.y = cvt_pk_bf16(v0[2], v0[3]); w.z = cvt_pk_bf16(v1[0], v1[1]); w.w = cvt_pk_bf16(v1[2], v1[3]);
                        *(u32x4*)(Z + (size_t)r * ldz + c) = w; }
                    else if (bj == 0 && cw < 16) { *(f32x4*)(IF + (size_t)r * 16 + cw) = v0; *(f32x4*)(IF + (size_t)r * 16 + cw + 4) = v1; }
                }
            }
    }
};
struct EpiGate {
    static constexpr bool PERM = true, HAS_MID = false;
    bf16_t* Z; int ldz, off0, off1; const float* bias; const float* ssq;
    __device__ __forceinline__ void operator()(const f32x4 (&acc)[2][2][4][2], const Unit& u, int wr, int wc, int fr, int fq) const {
        const int row0 = u.pm * BM + wr * 64 + fr, cw = wc * 32 + 8 * fq;
        const int cdst0 = (u.pn < 4 ? off0 : off1) + (u.pn & 3) * BM;
#pragma unroll
        for (int ai = 0; ai < 2; ++ai)
#pragma unroll
            for (int m = 0; m < 4; ++m) {
                const int r = row0 + ai * HALF + m * 16; const float rs = rstd_of(ssq[r]);
#pragma unroll
                for (int bj = 0; bj < 2; ++bj) {
                    const int c = u.pn * BM + bj * HALF + cw;
                    const f32x4 v0 = acc[ai][bj][m][0] * rs + *(const f32x4*)(bias + c), v1 = acc[ai][bj][m][1] * rs + *(const f32x4*)(bias + c + 4);
                    u32x4 w; w.x = cvt_pk_bf16(fast_sigmoid(v0[0]), fast_sigmoid(v0[1])); w.y = cvt_pk_bf16(fast_sigmoid(v0[2]), fast_sigmoid(v0[3]));
                    w.z = cvt_pk_bf16(fast_sigmoid(v1[0]), fast_sigmoid(v1[1])); w.w = cvt_pk_bf16(fast_sigmoid(v1[2]), fast_sigmoid(v1[3]));
                    *(u32x4*)(Z + (size_t)r * ldz + cdst0 + bj * HALF + cw) = w;
                }
            }
    }
};
struct EpiProj {
    static constexpr bool PERM = true, HAS_MID = true;
    const bf16_t* Z; int ldz, off0, off1; bf16_t* O;
    __device__ __forceinline__ static float bfl(unsigned w) { return __builtin_bit_cast(float, w << 16); }
    __device__ __forceinline__ static float bfh(unsigned w) { return __builtin_bit_cast(float, w & 0xffff0000u); }
    __device__ __forceinline__ void mid(f32x4 (&acc)[2][2][4][2], const Unit& u, int wr, int wc, int fr, int fq) const {
        unsigned base = (unsigned)((u.pm * BM + wr * 64 + fr) * ldz + u.pn * BM + wc * 32 + 8 * fq) * 2u; asm volatile("" : "+v"(base));
        const char* zb = (const char*)Z;
#pragma unroll
        for (int ai = 0; ai < 2; ++ai)
#pragma unroll
            for (int m = 0; m < 4; ++m) {
#pragma unroll
                for (int bj = 0; bj < 2; ++bj) {
                    const unsigned o = base + (unsigned)(((ai * HALF + m * 16) * ldz + bj * HALF) * 2);
                    const u32x4 a = *(const u32x4*)(zb + o + (unsigned)(off0 * 2)), b = *(const u32x4*)(zb + o + (unsigned)(off1 * 2));
#pragma unroll
                    for (int q = 0; q < 4; ++q) {
                        const float rl = bfl(a[q]) * __builtin_amdgcn_rcpf(fmaxf(bfl(b[q]), 1e-30f)), rh = bfh(a[q]) * __builtin_amdgcn_rcpf(fmaxf(bfh(b[q]), 1e-30f));
                        acc[ai][bj][m][q >> 1][(q & 1) * 2] *= rl; acc[ai][bj][m][q >> 1][(q & 1) * 2 + 1] *= rh;
                    }
                    asm volatile("" ::: "memory");
                }
            }
    }
    __device__ __forceinline__ void operator()(const f32x4 (&acc)[2][2][4][2], const Unit& u, int wr, int wc, int fr, int fq) const {
        const int row0 = u.pm * BM + wr * 64 + fr, cw = wc * 32 + 8 * fq;
#pragma unroll
        for (int ai = 0; ai < 2; ++ai)
#pragma unroll
            for (int m = 0; m < 4; ++m) {
                const int r = row0 + ai * HALF + m * 16;
#pragma unroll
                for (int bj = 0; bj < 2; ++bj) {
                    const int c = u.pn * BM + bj * HALF + cw;
                    const u32x4 b = *(const u32x4*)(Z + (size_t)r * ldz + off1 + c);
                    u32x4 w;
#pragma unroll
                    for (int q = 0; q < 4; ++q) w[q] = cvt_pk_bf16(acc[ai][bj][m][q >> 1][(q & 1) * 2] * fmaxf(bfl(b[q]), 1e-30f), acc[ai][bj][m][q >> 1][(q & 1) * 2 + 1] * fmaxf(bfh(b[q]), 1e-30f));
                    *(u32x4*)(O + (size_t)r * 1024 + c) = w;
                    asm volatile("" ::: "memory");
                }
            }
    }
};
template <class Epi, class Sched, bool ALIGN_EPI = false, bool SP2 = false>
__device__ __forceinline__ void gemm_phase(PG8_LAS unsigned char* lds, const Gemm g, const Sched& S, const Epi& E) {
    const int tid = threadIdx.x, wid = __builtin_amdgcn_readfirstlane(tid >> 6), lane = tid & 63, wr = wid >> 2, wc = wid & 3, fr = lane & 15, fq = lane >> 4;
    const int K = g.K, nt = K / BK;
    unsigned voffA[2], voffB[2];
#pragma unroll
    for (int i = 0; i < 2; ++i) { int R, C; stage_rc(tid * 16 + i * 8192, R, C); const int Rb = Epi::PERM ? ((R & ~31) + perm32(R & 31)) : R;
        voffA[i] = (unsigned)(R * g.lda + C) * 2u; voffB[i] = (unsigned)(Rb * g.ldb + C) * 2u; }
    const size_t kstep = (size_t)(BK * 2);
    const size_t hstepA = (size_t)HALF * g.lda * 2, hstepB = (size_t)HALF * g.ldb * 2;
    const size_t tstepA = 2 * hstepA, tstepB = 2 * hstepB;
    const unsigned ldsw = (unsigned)wid * 1024u;
    const int aoff = lds_byte(wr * 64 + fr, fq * 8), boff = lds_byte(wc * 32 + fr, fq * 8);
#define PG8_SA(b, h) (((b) * 2 + (h)) * HTB)
#define PG8_SB(b, h) ((4 + (b) * 2 + (h)) * HTB)
#define PG8_STAGE(bufoff, gbase, voff) do { _Pragma("unroll") for (int _i = 0; _i < 2; ++_i) \
        __builtin_amdgcn_global_load_lds((const unsigned*)((const char*)(gbase) + (voff)[_i]), (PG8_LAS unsigned*)(lds + (bufoff) + ldsw + _i * 8192), 16, 0, 0); } while (0)
#define PG8_LDA(dst, b, h) do { _Pragma("unroll") for (int m = 0; m < 4; ++m) _Pragma("unroll") for (int k = 0; k < 2; ++k) dst[m][k] = *(const PG8_LAS bf16x8*)(lds + PG8_SA(b, h) + aoff + m * 2048 + k * 1024); } while (0)
#define PG8_LDB(dst, b, h) do { _Pragma("unroll") for (int n = 0; n < 2; ++n) _Pragma("unroll") for (int k = 0; k < 2; ++k) dst[n][k] = *(const PG8_LAS bf16x8*)(lds + PG8_SB(b, h) + boff + n * 2048 + k * 1024); } while (0)
#define PG8_MMA(ai, bj, At, Bt) do { __builtin_amdgcn_s_setprio(1); _Pragma("unroll") for (int m = 0; m < 4; ++m) _Pragma("unroll") for (int n = 0; n < 2; ++n) _Pragma("unroll") for (int k = 0; k < 2; ++k) \
        acc[ai][bj][m][n] = __builtin_amdgcn_mfma_f32_16x16x32_bf16(Bt[n][k], At[m][k], acc[ai][bj][m][n], 0, 0, 0); __builtin_amdgcn_s_setprio(0); } while (0)
#define PG8_WAIT_V(n) asm volatile("s_waitcnt vmcnt(" #n ")" ::: "memory")
#define PG8_WAIT_L(n) asm volatile("s_waitcnt lgkmcnt(" #n ")" ::: "memory")
#define PG8_BAR __builtin_amdgcn_s_barrier()
#define PG8_SCHED __builtin_amdgcn_sched_barrier(0)
    Unit cur, nxt; int ui = 0;
    if (!S.next(0, cur)) return;
    f32x4 acc[2][2][4][2];
#pragma unroll
    for (int a = 0; a < 2; ++a)
#pragma unroll
        for (int b = 0; b < 2; ++b)
#pragma unroll
            for (int m = 0; m < 4; ++m)
#pragma unroll
                for (int n = 0; n < 2; ++n) acc[a][b][m][n] = (f32x4){0.f, 0.f, 0.f, 0.f};
    bf16x8 At[4][2], B0[2][2], B1[2][2];
    const char* cA = (const char*)g.A + (size_t)cur.pm * tstepA; const char* cA2 = (const char*)g.A2 + (size_t)cur.pm * tstepA; const char* cB = (const char*)g.Bt + (size_t)cur.pn * tstepB;
    S.a_ready(cur);
    if constexpr (SP2) {
        PG8_STAGE(PG8_SB(0, 0), cB, voffB); PG8_STAGE(PG8_SB(0, 1), cB + hstepB, voffB); PG8_STAGE(PG8_SA(0, 0), cA, voffA); PG8_STAGE(PG8_SA(0, 1), cA + hstepA, voffA);
        if (wr == 1) PG8_BAR;
        PG8_WAIT_V(2); PG8_BAR;
        PG8_STAGE(PG8_SB(1, 0), cB + kstep, voffB); PG8_STAGE(PG8_SA(1, 0), cA + kstep, voffA); PG8_STAGE(PG8_SB(1, 1), cB + hstepB + kstep, voffB);
        PG8_WAIT_V(6); PG8_BAR;
    } else {
        PG8_STAGE(PG8_SB(0, 0), cB, voffB); PG8_STAGE(PG8_SA(0, 0), cA, voffA); PG8_STAGE(PG8_SB(0, 1), cB + hstepB, voffB); PG8_STAGE(PG8_SA(0, 1), cA + hstepA, voffA);
        if (wr == 1) PG8_BAR;
        PG8_WAIT_V(4); PG8_BAR;
        PG8_STAGE(PG8_SB(1, 0), cB + kstep, voffB); PG8_STAGE(PG8_SA(1, 0), cA + kstep, voffA); PG8_STAGE(PG8_SB(1, 1), cB + hstepB + kstep, voffB);
        PG8_WAIT_V(6); PG8_BAR;
    }
    for (;;) {
        const bool has_next = S.next(ui + 1, nxt);
        const char* nA = has_next ? (const char*)g.A + (size_t)nxt.pm * tstepA : cA; const char* nA2 = has_next ? (const char*)g.A2 + (size_t)nxt.pm * tstepA : cA2; const char* nB = has_next ? (const char*)g.Bt + (size_t)nxt.pn * tstepB : cB;
        for (int t = 0; t < nt; t += 2) {
            const bool last = (t == nt - 2);
            if constexpr (Epi::HAS_MID) { if (t == g.ksplit) E.mid(acc, cur, wr, wc, fr, fq); }
            const char* a1 = ((t + 1) < g.ksplit ? cA : cA2) + (size_t)(t + 1) * kstep;
            const char* a2 = last ? nA : ((t + 2) < g.ksplit ? cA : cA2) + (size_t)(t + 2) * kstep; const char* b2 = last ? nB : cB + (size_t)(t + 2) * kstep;
            const char* a3 = a2 + kstep; const char* b3 = b2 + kstep;
            if (last && has_next) S.a_ready(nxt);
            if constexpr (SP2) {
            PG8_LDB(B0, 0, 0); PG8_LDB(B1, 0, 1); PG8_SCHED; PG8_LDA(At, 0, 0); PG8_STAGE(PG8_SA(1, 1), a1 + hstepA, voffA);
            PG8_WAIT_V(8); PG8_WAIT_L(0); PG8_BAR; PG8_MMA(0, 0, At, B0); PG8_MMA(0, 1, At, B1); PG8_BAR; PG8_SCHED;
            PG8_LDA(At, 0, 1); PG8_STAGE(PG8_SB(0, 0), b2, voffB); PG8_STAGE(PG8_SB(0, 1), b2 + hstepB, voffB); PG8_STAGE(PG8_SA(0, 0), a2, voffA);
            PG8_WAIT_V(8); PG8_WAIT_L(0); PG8_BAR; PG8_MMA(1, 0, At, B0); PG8_MMA(1, 1, At, B1); PG8_BAR; PG8_SCHED;
            PG8_LDB(B0, 1, 0); PG8_LDB(B1, 1, 1); PG8_SCHED; PG8_LDA(At, 1, 0); PG8_STAGE(PG8_SA(0, 1), a2 + hstepA, voffA);
            PG8_WAIT_V(8); PG8_WAIT_L(0); PG8_BAR; PG8_MMA(0, 0, At, B0); PG8_MMA(0, 1, At, B1); PG8_BAR; PG8_SCHED;
            PG8_LDA(At, 1, 1); PG8_STAGE(PG8_SB(1, 0), b3, voffB); PG8_STAGE(PG8_SB(1, 1), b3 + hstepB, voffB); PG8_STAGE(PG8_SA(1, 0), a3, voffA);
            PG8_WAIT_V(8); PG8_WAIT_L(0); PG8_BAR; PG8_MMA(1, 0, At, B0); PG8_MMA(1, 1, At, B1); PG8_BAR; PG8_SCHED;
            } else {
            PG8_LDB(B0, 0, 0); PG8_SCHED; PG8_LDA(At, 0, 0); PG8_STAGE(PG8_SA(1, 1), a1 + hstepA, voffA);
            PG8_WAIT_L(8); PG8_BAR; PG8_WAIT_L(0); PG8_MMA(0, 0, At, B0); PG8_BAR; PG8_SCHED;
            PG8_LDB(B1, 0, 1); PG8_STAGE(PG8_SB(0, 0), b2, voffB);
            PG8_BAR; PG8_WAIT_L(0); PG8_MMA(0, 1, At, B1); PG8_BAR;
            PG8_LDA(At, 0, 1); PG8_STAGE(PG8_SA(0, 0), a2, voffA);
            PG8_BAR; PG8_WAIT_L(0); PG8_MMA(1, 0, At, B0); PG8_BAR; PG8_SCHED;
            PG8_STAGE(PG8_SB(0, 1), b2 + hstepB, voffB);
            PG8_WAIT_V(6); PG8_BAR; PG8_MMA(1, 1, At, B1); PG8_BAR;
            PG8_LDB(B0, 1, 0); PG8_SCHED; PG8_LDA(At, 1, 0); PG8_STAGE(PG8_SA(0, 1), a2 + hstepA, voffA);
            PG8_WAIT_L(8); PG8_BAR; PG8_WAIT_L(0); PG8_MMA(0, 0, At, B0); PG8_BAR; PG8_SCHED;
            PG8_LDB(B1, 1, 1); PG8_STAGE(PG8_SB(1, 0), b3, voffB);
            PG8_BAR; PG8_WAIT_L(0); PG8_MMA(0, 1, At, B1); PG8_BAR;
            PG8_LDA(At, 1, 1); PG8_STAGE(PG8_SA(1, 0), a3, voffA);
            PG8_BAR; PG8_WAIT_L(0); PG8_MMA(1, 0, At, B0); PG8_BAR; PG8_SCHED;
            PG8_STAGE(PG8_SB(1, 1), b3 + hstepB, voffB);
            PG8_WAIT_V(6); PG8_BAR; PG8_MMA(1, 1, At, B1); PG8_BAR;
            }
        }
        if constexpr (ALIGN_EPI) { if (wr == 0) PG8_BAR; }
        E(acc, cur, wr, wc, fr, fq); S.done(cur);
        if (!has_next) break;
#pragma unroll
        for (int a = 0; a < 2; ++a)
#pragma unroll
            for (int b = 0; b < 2; ++b)
#pragma unroll
                for (int m = 0; m < 4; ++m)
#pragma unroll
                    for (int n = 0; n < 2; ++n) acc[a][b][m][n] = (f32x4){0.f, 0.f, 0.f, 0.f};
        cur = nxt; cA = nA; cA2 = nA2; cB = nB; ++ui;
        if constexpr (ALIGN_EPI) { if (wr == 1) PG8_BAR; }
    }
    PG8_WAIT_V(0);
    if constexpr (!ALIGN_EPI) { if (wr == 0) PG8_BAR; }
    PG8_BAR;

#undef PG8_SA
#undef PG8_SB
#undef PG8_STAGE
#undef PG8_LDA
#undef PG8_LDB
#undef PG8_MMA
#undef PG8_WAIT_V
#undef PG8_WAIT_L
#undef PG8_BAR
#undef PG8_SCHED
}
}

constexpr int NWAVES = 8;
constexpr int BATCH = 4, SEQ = 4096, DM = 1024, M = BATCH * SEQ, FF = 2816, INW = 6672;
constexpr int NGU = 2 * FF;
constexpr int ZP = 4608;
constexpr int NWIN = 4864;
constexpr int NZREAL = 4624;
constexpr size_t MiB = 1u << 20;
constexpr size_t WS_CTL = 0, CTL_ZERO_BYTES = 1 * MiB;
constexpr size_t WS_BIN = 1 * MiB, WS_BG = WS_BIN + 32768;
constexpr size_t WS_WG = 2 * MiB, WS_WPROJ = 6 * MiB, WS_WOUT = 10 * MiB, WS_WGU2 = 12 * MiB, WS_WD2 = 23 * MiB;
constexpr size_t WS_ST = 29 * MiB;
constexpr size_t WS_WGU1 = 29 * MiB, WS_WD1 = 40 * MiB, WS_WIN = WS_WD1 + 5767168;
constexpr size_t WS_XB = 61 * MiB;
constexpr size_t WS_BIG = 93 * MiB;
constexpr size_t WS_IF = 237 * MiB;
constexpr size_t WS_END = 240 * MiB;
static_assert(WS_WIN + (size_t)NWIN * 1024 * 2 <= WS_XB && WS_ST + 32 * MiB <= WS_XB && WS_WD2 + (size_t)1024 * FF * 2 <= WS_ST, "ws map");
constexpr int CW_BAR = 4096;
constexpr size_t CTL_SSQ = 512 * 1024;
constexpr int RING_OFF = 0, RING_BYTES = 131072;
constexpr int LDSCTL_OFF = 151552, MISC_OFF = LDSCTL_OFF + 320;
constexpr int LDS_BYTES = 155648;

#define GAS __attribute__((address_space(1)))
#define LAS __attribute__((address_space(3)))
typedef unsigned short bf16;
typedef unsigned v4u __attribute__((ext_vector_type(4)));
typedef unsigned v2u __attribute__((ext_vector_type(2)));
typedef float f32x4 __attribute__((ext_vector_type(4)));
typedef short bf16x8 __attribute__((ext_vector_type(8)));
typedef GAS unsigned gu32;
#define RLX_AGENT __ATOMIC_RELAXED, __HIP_MEMORY_SCOPE_AGENT
#define LDS_WAIT() asm volatile("s_waitcnt lgkmcnt(0)" ::: "memory")
#define VM_WAIT() asm volatile("s_waitcnt vmcnt(0)" ::: "memory")
__device__ __forceinline__ unsigned f2bf(float f) { unsigned u = __builtin_bit_cast(unsigned, f); return (u + 0x7fffu + ((u >> 16) & 1u)) >> 16; }
__device__ __forceinline__ unsigned pk2(float lo, float hi) { return f2bf(lo) | (f2bf(hi) << 16); }
__device__ __forceinline__ float bf2f(unsigned short b) { return __builtin_bit_cast(float, (unsigned)b << 16); }

#define XB_TMO      128
#define XB_XCNT(j)  (256  + 64 * (j))
#define XB_XSUB(j)  (1280 + 64 * (j))
#define XB_XGEN(j)  (2304 + 64 * (j))
#define XB_TOP      3328
#define XB_TOPGEN   3392
#define XCD_BAR_WORDS 3456
#define XB_SPIN_CAP (1u << 23)
__device__ __forceinline__ unsigned xb_ld(unsigned* p)              { return __hip_atomic_load(p, __ATOMIC_RELAXED, __HIP_MEMORY_SCOPE_AGENT); }
__device__ __forceinline__ unsigned xb_add(unsigned* p, unsigned v) { return __hip_atomic_fetch_add(p, v, __ATOMIC_RELAXED, __HIP_MEMORY_SCOPE_AGENT); }
__device__ __forceinline__ unsigned xb_xcc_id() { return (unsigned)__builtin_amdgcn_s_getreg((3 << 11) | 20) & 0xFu; }
#define XB_SPIN(cond, bar) do { unsigned _sp = 0; while (cond) { __builtin_amdgcn_s_sleep(1); \
    if ((++_sp & 255u) == 0u) { if (xb_ld(&(bar)[XB_TMO])) break; if (_sp > XB_SPIN_CAP) { atomicAdd(&(bar)[XB_TMO], 1u); break; } } } } while (0)
struct XcdBarrier { unsigned* bar; unsigned x; volatile LAS unsigned* st; };
__device__ __forceinline__ XcdBarrier xcd_barrier_post(unsigned* bar, volatile LAS unsigned* st) {
    XcdBarrier b; b.bar = bar; b.x = xb_xcc_id(); b.st = st;
    if (threadIdx.x == 0) (void)xb_add(&bar[XB_XCNT(b.x)], 1u);
    return b;
}
__device__ __forceinline__ void xcd_barrier_complete(unsigned* bar, unsigned x, unsigned& nloc, unsigned& nx) {
    const unsigned G = gridDim.x * gridDim.y * gridDim.z;
    unsigned sum, cnt, mine, sp = 0u;
    for (;;) {
        sum = 0u; cnt = 0u; mine = 0u;
#pragma unroll
        for (unsigned j = 0; j < 16; ++j) { const unsigned c = xb_ld(&bar[XB_XCNT(j)]); sum += c; cnt += (c > 0u) ? 1u : 0u; mine = (j == x) ? c : mine; }
        if (sum == G) break;
        __builtin_amdgcn_s_sleep(1);
        if ((++sp & 255u) == 0u) { if (xb_ld(&bar[XB_TMO])) break; if (sp > XB_SPIN_CAP) { atomicAdd(&bar[XB_TMO], 1u); break; } }
    }
    nloc = mine > 0u ? mine : 1u; nx = cnt > 0u ? cnt : 1u;
}
__device__ __forceinline__ void xcd_barrier(const XcdBarrier& b) {
    asm volatile("s_waitcnt vmcnt(0)" ::: "memory");
    __syncthreads();
    if (threadIdx.x == 0) {
        unsigned* bar = b.bar;
        __builtin_amdgcn_s_waitcnt(0);
        unsigned nloc = b.st[0], nx = b.st[1];
        if (nloc == 0u) { xcd_barrier_complete(bar, b.x, nloc, nx); b.st[0] = nloc; b.st[1] = nx; }
        const unsigned old = xb_add(&bar[XB_XSUB(b.x)], 1u);
        const unsigned gen = old / nloc;
        if (old + 1u == (gen + 1u) * nloc) {
            __builtin_amdgcn_fence(__ATOMIC_RELEASE, "agent");
            asm volatile("s_waitcnt vmcnt(0)" ::: "memory");
            const unsigned og = xb_add(&bar[XB_TOP], 1u);
            const unsigned tg = og / nx;
            if (og + 1u == (tg + 1u) * nx) xb_add(&bar[XB_TOPGEN], 1u);
            else XB_SPIN(xb_ld(&bar[XB_TOPGEN]) == tg, bar);
            __builtin_amdgcn_fence(__ATOMIC_ACQUIRE, "agent");
            xb_add(&bar[XB_XGEN(b.x)], 1u);
            asm volatile("s_waitcnt vmcnt(0)" ::: "memory");
        } else {
            XB_SPIN(xb_ld(&bar[XB_XGEN(b.x)]) == gen, bar);
            __builtin_amdgcn_fence(__ATOMIC_ACQUIRE, "agent");
            asm volatile("s_waitcnt vmcnt(0)" ::: "memory");
        }
    }
    __syncthreads();
}

__device__ __forceinline__ float wave_sum(float v) {
#pragma unroll
    for (int o = 1; o < 64; o <<= 1) v += __shfl_xor(v, o);
    return v;
}
template <class RowMap>
__device__ __forceinline__ void transpose_item(const float* W, int N, const float* g, LAS float* scr, int item, int lane, const RowMap& rm) {
    const int nblk = (N + 31) / 32, kb = item / nblk, nb = item % nblk, k0 = 64 * kb, n0 = 32 * nb;
    const int nl = lane & 31, nsrc = n0 + nl;
#pragma unroll 8
    for (int i = 0; i < 32; ++i) { const int kk = 2 * i + (lane >> 5); float v = nsrc < N ? W[(size_t)(k0 + kk) * N + nsrc] : 0.f; if (g) v *= g[k0 + kk]; scr[kk * 33 + nl] = v; }
    LDS_WAIT(); asm volatile("" ::: "memory");
    const int c = lane & 7;
#pragma unroll
    for (int j = 0; j < 4; ++j) { const int n = (lane >> 3) + 8 * j; const LAS float* s = scr + (8 * c) * 33 + n;
        v4u o; o.x = pk2(s[0 * 33], s[1 * 33]); o.y = pk2(s[2 * 33], s[3 * 33]); o.z = pk2(s[4 * 33], s[5 * 33]); o.w = pk2(s[6 * 33], s[7 * 33]);
        if (n0 + n < N) *(GAS v4u*)(rm(n0 + n) + k0 + 8 * c) = o; }
    LDS_WAIT(); asm volatile("" ::: "memory");
}
struct RmGate { bf16* W; __device__ __forceinline__ bf16* operator()(int n) const { return W + (size_t)(256 * (n >> 7) + (n & 127)) * 1024; } };
struct RmUp   { bf16* W; __device__ __forceinline__ bf16* operator()(int n) const { return W + (size_t)(256 * (n >> 7) + 128 + (n & 127)) * 1024; } };
struct RmLin  { bf16* W; int ld, koff; __device__ __forceinline__ bf16* operator()(int n) const { return W + (size_t)n * ld + koff; } };
struct RmWin  { bf16* Win; bf16* Wg; __device__ __forceinline__ bf16* operator()(int n) const { return n < NZREAL ? Win + (size_t)n * 1024 : Wg + (size_t)(n - NZREAL) * 1024; } };


namespace nv {
constexpr int S = 4096, AH = 16, AKV = 4, HD = 64, WIN_ = 128, MH = 8, CH = 64;
constexpr float EPS = 1e-6f, CAP = 15.0f;
__device__ __forceinline__ float sigmoidf_(float x) { return 1.0f / (1.0f + expf(-x)); }
__device__ __forceinline__ float siluf_(float x) { return x / (1.0f + expf(-x)); }
__device__ __forceinline__ float ld(const bf16* p) { return bf2f(*p); }
__device__ __forceinline__ void st(bf16* p, float v) { *p = (bf16)f2bf(v); }
__device__ __forceinline__ void attn_item(bf16* Z, const float* sinks, int w, int lane) {
    const int r = w / AH, hq = w % AH, hk = hq / (AH / AKV), t = r % S, rb = r - t;
    const float q = ld(Z + (size_t)r * ZP + hq * HD + lane);
    float m = sinks[hq], l = 1.0f, acc = 0.f;
    const int j0 = t - (WIN_ - 1) < 0 ? 0 : t - (WIN_ - 1);
    for (int j = j0; j <= t; ++j) {
        const float kv = ld(Z + (size_t)(rb + j) * ZP + 1024 + hk * HD + lane);
        const float s = wave_sum(q * kv) * 0.125f;
        const float mn = fmaxf(m, s), f = expf(m - mn), p = expf(s - mn);
        l = l * f + p; acc = acc * f + p * ld(Z + (size_t)(rb + j) * ZP + 1280 + hk * HD + lane); m = mn;
    }
    st(Z + (size_t)r * ZP + hq * HD + lane, acc / l);
}
__device__ __forceinline__ void conv_item(const bf16* Z, const float* cw, bf16* qk, int idx) {
    const int r = idx >> 10, c = idx & 1023, t = r % S;
    float a = 0.f;
#pragma unroll
    for (int j = 0; j < 4; ++j) { const int tt = t - 3 + j; if (tt >= 0) a += ld(Z + (size_t)(r - 3 + j) * ZP + 1536 + c) * cw[j * 1024 + c]; }
    a = siluf_(a); if (c >= 512) a *= 0.125f;
    st(qk + (size_t)r * 1024 + c, a);
}
constexpr int MLSTM_LDS = (64 * 128 * 3 + 64 * 65 * 3 + 64 * 6 + 8 + 64) * 4;
__device__ __forceinline__ void mlstm_seq(bf16* Z, const float* IF, const bf16* qk, const float* hnorm, int bh, LAS float* sm) {
    LAS float* Cs = sm; LAS float* qs = Cs + 64 * 128; LAS float* ks = qs + 64 * 65; LAS float* vs = ks + 64 * 65; LAS float* Ss = vs + 64 * 128; LAS float* ns = Ss + 64 * 65;
    LAS float* ig = ns + 64; LAS float* cum = ig + 64; LAS float* mt = cum + 64; LAS float* wint = mt + 64; LAS float* wk = wint + 64; LAS float* hs = wk + 64; LAS float* sc = hs + 64 * 128; LAS float* den = sc + 8;
    const int h = bh % MH, b = bh / MH, tid = threadIdx.x;
    for (int i = tid; i < 64 * 128; i += 512) Cs[i] = 0.f;
    if (tid < 64) ns[tid] = 0.f;
    if (tid == 0) sc[0] = 0.f;
    __syncthreads();
    for (int c = 0; c < S / CH; ++c) {
        const size_t r0 = (size_t)b * S + c * CH;
        for (int i = tid; i < 64 * 64; i += 512) { const int t = i >> 6, d = i & 63; qs[t * 65 + d] = ld(qk + (r0 + t) * 1024 + h * 64 + d); ks[t * 65 + d] = ld(qk + (r0 + t) * 1024 + 512 + h * 64 + d); }
        for (int i = tid; i < 64 * 128; i += 512) { const int t = i >> 7, v = i & 127; vs[i] = ld(Z + (r0 + t) * ZP + 2560 + h * 128 + v); }
        if (tid < 64) {
            const float ip = IF[(r0 + tid) * 16 + h], fp = IF[(r0 + tid) * 16 + 8 + h];
            ig[tid] = CAP * tanhf(ip / CAP);
            const float fc = CAP * tanhf(fp / CAP);
            cum[tid] = fc >= 0.f ? -log1pf(expf(-fc)) : fc - log1pf(expf(fc));
        }
        __syncthreads();
        if (tid == 0) { float a = 0.f; for (int t = 0; t < 64; ++t) { a += cum[t]; cum[t] = a; } }
        __syncthreads();
        const float m_prev = sc[0];
        if (tid < 64) {
            float mx = -INFINITY;
            for (int s = 0; s <= tid; ++s) mx = fmaxf(mx, cum[tid] - cum[s] + ig[s]);
            const float li = cum[tid] + m_prev, m = fmaxf(li, mx);
            mt[tid] = m; wint[tid] = expf(li - m);
        }
        if (tid == 64) {
            const float total = cum[63]; float mx = -INFINITY;
            for (int s = 0; s < 64; ++s) mx = fmaxf(mx, total - cum[s] + ig[s]);
            const float mn = fmaxf(total + m_prev, mx);
            sc[1] = mn; sc[2] = expf(total + m_prev - mn);
        }
        __syncthreads();
        if (tid < 64) wk[tid] = expf(cum[63] - cum[tid] + ig[tid] - sc[1]);
        for (int i = tid; i < 64 * 64; i += 512) {
            const int t = i >> 6, s = i & 63; float v = 0.f;
            if (s <= t) { float d = 0.f; for (int k = 0; k < 64; ++k) d = fmaf(qs[t * 65 + k], ks[s * 65 + k], d); v = d * expf(cum[t] - cum[s] + ig[s] - mt[t]); }
            Ss[t * 65 + s] = v;
        }
        __syncthreads();
        if (tid < 64) { float d = 0.f; for (int s = 0; s < 64; ++s) d += Ss[tid * 65 + s]; float qn = 0.f; for (int k = 0; k < 64; ++k) qn = fmaf(qs[tid * 65 + k], ns[k], qn);
            d += wint[tid] * qn; den[tid] = fmaxf(fabsf(d), expf(-mt[tid])); }
        __syncthreads();
        for (int i = tid; i < 64 * 128; i += 512) {
            const int t = i >> 7, v = i & 127; float a = 0.f, bq = 0.f;
            for (int s = 0; s <= t; ++s) a = fmaf(Ss[t * 65 + s], vs[s * 128 + v], a);
            for (int k = 0; k < 64; ++k) bq = fmaf(qs[t * 65 + k], Cs[k * 128 + v], bq);
            hs[i] = (a + wint[t] * bq) / den[t];
        }
        __syncthreads();
        for (int i = tid; i < 64 * 128; i += 512) {
            const int d = i >> 7, v = i & 127; float a = 0.f;
            for (int s = 0; s < 64; ++s) a = fmaf(wk[s] * ks[s * 65 + d], vs[s * 128 + v], a);
            Cs[i] = sc[2] * Cs[i] + a;
        }
        if (tid < 64) { float a = 0.f; for (int s = 0; s < 64; ++s) a = fmaf(wk[s], ks[s * 65 + tid], a); ns[tid] = sc[2] * ns[tid] + a; }
        {
            const int wv = tid >> 6, lane = tid & 63;
            for (int t = wv; t < 64; t += 8) {
                const float a = hs[t * 128 + lane], bb = hs[t * 128 + 64 + lane];
                const float rr = rsqrtf(wave_sum(a * a + bb * bb) * (1.0f / 128.0f) + EPS);
                bf16* zr = Z + (r0 + t) * ZP;
                st(zr + 2560 + h * 128 + lane, sigmoidf_(ld(zr + 3584 + h * 128 + lane)) * a * rr * hnorm[h * 128 + lane]);
                st(zr + 2560 + h * 128 + 64 + lane, sigmoidf_(ld(zr + 3584 + h * 128 + 64 + lane)) * bb * rr * hnorm[h * 128 + 64 + lane]);
            }
        }
        __syncthreads();
        if (tid == 0) sc[0] = sc[1];
        __syncthreads();
    }
}
}

namespace att {
typedef float f32x16 __attribute__((ext_vector_type(16)));
typedef short s16x4 __attribute__((ext_vector_type(4)));
constexpr int KSTR = 144, VSTR = 192, STG_STR = 144;
constexpr int LDS_K = 0, LDS_V = 256 * KSTR, LDS_STG = LDS_V + 256 * VSTR, LDS_END = LDS_STG + 8 * 32 * STG_STR;
__device__ __forceinline__ s16x4 tr_read(LAS const unsigned char* p) { return __builtin_bit_cast(s16x4, __builtin_amdgcn_ds_read_tr16_b64_v4i16((LAS s16x4*)p)); }
__device__ __forceinline__ unsigned pk_bf16(float lo, float hi) { return pg8::cvt_pk_bf16(lo, hi); }

__device__ __forceinline__ void attn_unit(bf16* Z, const float* sinks, int b, int hkv, int qb, LAS unsigned char* lds) {
    const int tid = threadIdx.x, lane = tid & 63, wave = __builtin_amdgcn_readfirstlane(tid >> 6), c = lane & 31, hi = lane >> 5;
    const int q0 = qb * 128; const size_t rowbase = (size_t)b * SEQ;
#pragma unroll
    for (int i = 0; i < 4; ++i) {
        const int idx = tid + 512 * i, kk = idx >> 3, ch = idx & 7, pos = q0 - 128 + kk;
        v4u kv = (v4u){0u, 0u, 0u, 0u}, vv = (v4u){0u, 0u, 0u, 0u};
        if (pos >= 0) { const bf16* zr = Z + (rowbase + pos) * ZP + hkv * 64 + ch * 8; kv = *(const v4u*)(zr + 1024); vv = *(const v4u*)(zr + 1280); }
        *(LAS v4u*)(lds + LDS_K + kk * KSTR + ch * 16) = kv;
        *(LAS v4u*)(lds + LDS_V + kk * VSTR + ch * 16) = vv;
    }
    __syncthreads();
    const int hq = hkv * 4 + (wave >> 1);
    const float sink8 = sinks[hq] * 8.0f;
    const float cs = 0.125f * 1.4426950408889634f;
#pragma unroll 1
    for (int blk = 0; blk < 2; ++blk) {
        const int i32 = 2 * (wave & 1) + blk, qs = q0 + 32 * i32;
        bf16* qrow = Z + (rowbase + qs + c) * ZP + hq * 64;
        bf16x8 qf[4];
#pragma unroll
        for (int s = 0; s < 4; ++s) qf[s] = *(const bf16x8*)(qrow + 16 * s + 8 * hi);
        f32x16 st[5];
#pragma unroll
        for (int j = 0; j < 5; ++j) {
            LAS const unsigned char* kb = lds + LDS_K + (32 * i32 + 32 * j + c) * KSTR + hi * 16;
            f32x16 acc = {};
#pragma unroll
            for (int s = 0; s < 4; ++s) { const bf16x8 kf = *(LAS const bf16x8*)(kb + s * 32); acc = __builtin_amdgcn_mfma_f32_32x32x16_bf16(kf, qf[s], acc, 0, 0, 0); }
            st[j] = acc;
        }
#pragma unroll
        for (int r = 0; r < 16; ++r) {
            const int rr = (r & 3) + 8 * (r >> 2) + 4 * hi;
            if (!(rr > c)) st[0][r] = -INFINITY;
            if (!(rr <= c)) st[4][r] = -INFINITY;
        }
        if (qb == 0) {
#pragma unroll
            for (int j = 0; j < 5; ++j)
#pragma unroll
                for (int r = 0; r < 16; ++r) { const int rr = (r & 3) + 8 * (r >> 2) + 4 * hi; if (32 * i32 + 32 * j + rr < 128) st[j][r] = -INFINITY; }
        }
        float m = sink8;
#pragma unroll
        for (int j = 0; j < 5; ++j)
#pragma unroll
            for (int r = 0; r < 16; ++r) m = fmaxf(m, st[j][r]);
        m = fmaxf(m, __shfl_xor(m, 32));
        const float mb = m * cs; float sum = 0.f;
        bf16x8 pf[5][2];
#pragma unroll
        for (int j = 0; j < 5; ++j) {
            float p[16];
#pragma unroll
            for (int r = 0; r < 16; ++r) { p[r] = __builtin_amdgcn_exp2f(st[j][r] * cs - mb); sum += p[r]; }
#pragma unroll
            for (int s = 0; s < 2; ++s) { v4u w; w.x = pk_bf16(p[8 * s], p[8 * s + 1]); w.y = pk_bf16(p[8 * s + 2], p[8 * s + 3]); w.z = pk_bf16(p[8 * s + 4], p[8 * s + 5]); w.w = pk_bf16(p[8 * s + 6], p[8 * s + 7]);
                pf[j][s] = __builtin_bit_cast(bf16x8, w); }
        }
        sum += __shfl_xor(sum, 32);
        sum += __builtin_amdgcn_exp2f(sink8 * cs - mb);
        f32x16 ot[2] = {};
        const int g16 = (lane >> 4) & 1, q4 = (lane & 15) >> 2, p4 = lane & 3;
        LAS const unsigned char* vb = lds + LDS_V + (32 * i32 + 4 * hi + q4) * VSTR + (16 * g16 + 4 * p4) * 2;
#pragma unroll
        for (int j = 0; j < 5; ++j)
#pragma unroll
            for (int s = 0; s < 2; ++s)
#pragma unroll
                for (int db = 0; db < 2; ++db) {
                    const s16x4 lo = tr_read(vb + (32 * j + 16 * s) * VSTR + db * 64), hh = tr_read(vb + (32 * j + 16 * s + 8) * VSTR + db * 64);
                    const bf16x8 vf = (bf16x8){lo[0], lo[1], lo[2], lo[3], hh[0], hh[1], hh[2], hh[3]};
                    ot[db] = __builtin_amdgcn_mfma_f32_32x32x16_bf16(vf, pf[j][s], ot[db], 0, 0, 0);
                }
        const float inv = __builtin_amdgcn_rcpf(sum);
        LAS unsigned char* stg = lds + LDS_STG + wave * (32 * STG_STR);
#pragma unroll
        for (int db = 0; db < 2; ++db)
#pragma unroll
            for (int g = 0; g < 4; ++g) {
                v2u w; w.x = pk_bf16(ot[db][4 * g] * inv, ot[db][4 * g + 1] * inv); w.y = pk_bf16(ot[db][4 * g + 2] * inv, ot[db][4 * g + 3] * inv);
                *(LAS v2u*)(stg + c * STG_STR + (32 * db + 8 * g + 4 * hi) * 2) = w;
            }
        LDS_WAIT(); asm volatile("" ::: "memory");
#pragma unroll
        for (int it = 0; it < 4; ++it) {
            const int row = it * 8 + (lane >> 3), chn = lane & 7;
            const v4u v = *(LAS const v4u*)(stg + row * STG_STR + chn * 16);
            *(v4u*)(Z + (rowbase + qs + row) * ZP + hq * 64 + chn * 8) = v;
        }
        LDS_WAIT(); asm volatile("" ::: "memory");
    }
    __syncthreads();
}
}

namespace ml {
using att::f32x16; using att::s16x4; using att::tr_read; using att::pk_bf16;
constexpr int QSTR = 144, KWSTR = 192, VSTR = 320, CSTR = 144, HSTR = 528;
constexpr float LOG2E = 1.4426950408889634f;
__device__ __forceinline__ float logsig(float x) { return x >= 0.f ? -log1pf(expf(-x)) : x - log1pf(expf(x)); }
__device__ __forceinline__ float fexp(float x) { return __builtin_amdgcn_exp2f(x * LOG2E); }
__device__ __forceinline__ float bflo(unsigned w) { return __builtin_bit_cast(float, w << 16); }
__device__ __forceinline__ float bfhi(unsigned w) { return __builtin_bit_cast(float, w & 0xffff0000u); }
__device__ __forceinline__ void gates(const float* IF, size_t r0, int h, int lane, float& cum, float& g, float& pm) {
    const float zi = IF[(r0 + lane) * 16 + h], zf = IF[(r0 + lane) * 16 + 8 + h];
    const float ig = 15.0f * tanhf(zi * (1.0f / 15.0f)), fc = 15.0f * tanhf(zf * (1.0f / 15.0f));
    float cs = logsig(fc);
#pragma unroll
    for (int o = 1; o < 64; o <<= 1) { const float t = __shfl_up(cs, o); if (lane >= o) cs += t; }
    cum = cs; g = ig - cs; float p = g;
#pragma unroll
    for (int o = 1; o < 64; o <<= 1) { const float t = __shfl_up(p, o); if (lane >= o) p = fmaxf(p, t); }
    pm = p;
}
__device__ __forceinline__ void conv8(const bf16* Z, size_t row, int tpos, int col, const float* cw, int cwc, float (&o)[8]) {
    float a[8];
#pragma unroll
    for (int e = 0; e < 8; ++e) a[e] = 0.f;
#pragma unroll
    for (int j = 0; j < 4; ++j) {
        if (tpos - 3 + j >= 0) {
            const v4u x = *(const v4u*)(Z + (row - 3 + j) * ZP + col);
            const f32x4 w0 = *(const f32x4*)(cw + j * 1024 + cwc), w1 = *(const f32x4*)(cw + j * 1024 + cwc + 4);
            a[0] += bflo(x.x) * w0[0]; a[1] += bfhi(x.x) * w0[1]; a[2] += bflo(x.y) * w0[2]; a[3] += bfhi(x.y) * w0[3];
            a[4] += bflo(x.z) * w1[0]; a[5] += bfhi(x.z) * w1[1]; a[6] += bflo(x.w) * w1[2]; a[7] += bfhi(x.w) * w1[3];
        }
    }
#pragma unroll
    for (int e = 0; e < 8; ++e) o[e] = a[e] * pg8::fast_sigmoid(a[e]);
}
__device__ __forceinline__ v4u pack8(const float (&o)[8]) { v4u w; w.x = pk_bf16(o[0], o[1]); w.y = pk_bf16(o[2], o[3]); w.z = pk_bf16(o[4], o[5]); w.w = pk_bf16(o[6], o[7]); return w; }

constexpr int A_KW = 0, A_V = 64 * KWSTR, A_END = A_V + 64 * VSTR;
__device__ __forceinline__ void phaseA_unit(const bf16* Z, const float* IF, const float* cw, bf16* CT, float* NL, float* SCAL, int u, LAS unsigned char* lds) {
    const int tid = threadIdx.x, lane = tid & 63, wave = __builtin_amdgcn_readfirstlane(tid >> 6), c = lane & 31, hi = lane >> 5;
    const int h = (u >> 6) & 7, b = u >> 9, cc = u & 63; const size_t r0 = (size_t)b * SEQ + cc * 64;
    float cum, g, pm; gates(IF, r0, h, lane, cum, g, pm);
    const float P = __shfl(pm, 63), total = __shfl(cum, 63);
    const float wkv = fexp(g - P);
    if (tid == 0) { SCAL[u * 4] = total; SCAL[u * 4 + 1] = P; }
    {
        const int t = tid >> 3, ch8 = tid & 7; const float wk_t = __shfl(wkv, wave * 8 + (lane >> 3)) * 0.125f;
        float kf[8]; conv8(Z, r0 + t, cc * 64 + t, 2048 + h * 64 + ch8 * 8, cw, 512 + h * 64 + ch8 * 8, kf);
#pragma unroll
        for (int e = 0; e < 8; ++e) kf[e] *= wk_t;
        *(LAS v4u*)(lds + A_KW + t * KWSTR + ch8 * 16) = pack8(kf);
    }
#pragma unroll
    for (int i = 0; i < 2; ++i) { const int idx = tid + 512 * i, tt = idx >> 4, chv = idx & 15;
        *(LAS v4u*)(lds + A_V + tt * VSTR + chv * 16) = *(const v4u*)(Z + (r0 + tt) * ZP + 2560 + h * 128 + chv * 8); }
    __syncthreads();
    const int db = wave >> 2, vb = wave & 3, g16 = (lane >> 4) & 1, q4 = (lane & 15) >> 2, p4 = lane & 3;
    f32x16 acc = {};
    LAS const unsigned char* ka = lds + A_KW + (8 * hi + q4) * KWSTR + (32 * db + 16 * g16 + 4 * p4) * 2;
    LAS const unsigned char* va = lds + A_V + (8 * hi + q4) * VSTR + (32 * vb + 16 * g16 + 4 * p4) * 2;
#pragma unroll
    for (int ks = 0; ks < 4; ++ks) {
        const s16x4 a0 = tr_read(ka + (16 * ks) * KWSTR), a1 = tr_read(ka + (16 * ks + 4) * KWSTR);
        const s16x4 b0 = tr_read(va + (16 * ks) * VSTR), b1 = tr_read(va + (16 * ks + 4) * VSTR);
        acc = __builtin_amdgcn_mfma_f32_32x32x16_bf16((bf16x8){a0[0], a0[1], a0[2], a0[3], a1[0], a1[1], a1[2], a1[3]}, (bf16x8){b0[0], b0[1], b0[2], b0[3], b1[0], b1[1], b1[2], b1[3]}, acc, 0, 0, 0);
    }
    bf16* crow = CT + ((size_t)u * 128 + 32 * vb + c) * 64 + 32 * db + 4 * hi;
#pragma unroll
    for (int gq = 0; gq < 4; ++gq) { v2u w; w.x = pk_bf16(acc[4 * gq], acc[4 * gq + 1]); w.y = pk_bf16(acc[4 * gq + 2], acc[4 * gq + 3]); *(v2u*)(crow + 8 * gq) = w; }
    if (tid < 64) { float s = 0.f;
#pragma unroll 8
        for (int sidx = 0; sidx < 64; ++sidx) s += bf2f(*(LAS const unsigned short*)(lds + A_KW + sidx * KWSTR + tid * 2));
        NL[u * 64 + tid] = s; }
    __syncthreads();
}

__device__ __forceinline__ void scan_phase(bf16* CT, float* NL, float* SCAL, int bx, int G, int tid) {
    for (int gid = bx * 512 + tid; gid < 32 * 4096; gid += G * 512) {
        const int bh = gid >> 12, e2 = gid & 4095, u0 = bh * 64;
        unsigned* p = (unsigned*)CT + (size_t)u0 * 4096 + e2;
        float s0 = 0.f, s1 = 0.f, sn = 0.f, m = 0.f;
#pragma unroll 8
        for (int cidx = 0; cidx < 64; ++cidx) {
            const unsigned w = p[(size_t)cidx * 4096];
            const float tot = SCAL[(u0 + cidx) * 4], P = SCAL[(u0 + cidx) * 4 + 1];
            const float Mx = fmaxf(m, P), dec = fexp(m - Mx), ee = fexp(P - Mx);
            p[(size_t)cidx * 4096] = pk_bf16(s0, s1);
            s0 = dec * s0 + ee * bflo(w); s1 = dec * s1 + ee * bfhi(w);
            if (e2 < 64) { float* np = NL + (u0 + cidx) * 64 + e2; const float nl = *np; *np = sn; sn = dec * sn + ee * nl; }
            if (e2 == 0) SCAL[(u0 + cidx) * 4 + 2] = m;
            m = tot + Mx;
        }
    }
}

constexpr int C_Q = 0, C_K = C_Q + 64 * QSTR, C_V = C_K + 64 * QSTR, C_C = C_V + 64 * VSTR, C_H = C_C + 128 * CSTR, C_G = C_H + 64 * HSTR, C_N = C_G + 256, C_RED = C_N + 256, C_END = C_RED + 1024;
__device__ __forceinline__ void phaseC_unit(bf16* Z, const float* IF, const float* cw, const bf16* CT, const float* NL, const float* SCAL, const float* gn, int u, LAS unsigned char* lds) {
    const int tid = threadIdx.x, lane = tid & 63, wave = __builtin_amdgcn_readfirstlane(tid >> 6), c = lane & 31, hi = lane >> 5;
    const int h = (u >> 6) & 7, b = u >> 9, cc = u & 63; const size_t r0 = (size_t)b * SEQ + cc * 64;
    float cum, g, pm; gates(IF, r0, h, lane, cum, g, pm);
    const float m_prev = SCAL[u * 4 + 2];
    const float Mt = fmaxf(m_prev, pm), wint = fexp(m_prev - Mt), flo = fexp(-(cum + Mt));
    if (wave == 0) *(LAS float*)(lds + C_G + lane * 4) = g;
    {
        const int t = tid >> 3, ch8 = tid & 7; float f[8];
        conv8(Z, r0 + t, cc * 64 + t, 1536 + h * 64 + ch8 * 8, cw, h * 64 + ch8 * 8, f);
        *(LAS v4u*)(lds + C_Q + t * QSTR + ch8 * 16) = pack8(f);
        conv8(Z, r0 + t, cc * 64 + t, 2048 + h * 64 + ch8 * 8, cw, 512 + h * 64 + ch8 * 8, f);
#pragma unroll
        for (int e = 0; e < 8; ++e) f[e] *= 0.125f;
        *(LAS v4u*)(lds + C_K + t * QSTR + ch8 * 16) = pack8(f);
    }
#pragma unroll
    for (int i = 0; i < 2; ++i) { const int idx = tid + 512 * i, tt = idx >> 4, chv = idx & 15;
        *(LAS v4u*)(lds + C_V + tt * VSTR + chv * 16) = *(const v4u*)(Z + (r0 + tt) * ZP + 2560 + h * 128 + chv * 8); }
#pragma unroll
    for (int i = 0; i < 2; ++i) { const int idx = tid + 512 * i, vv = idx >> 3, ch = idx & 7;
        *(LAS v4u*)(lds + C_C + vv * CSTR + ch * 16) = *(const v4u*)(CT + ((size_t)u * 128 + vv) * 64 + ch * 8); }
    if (tid < 64) *(LAS float*)(lds + C_N + tid * 4) = NL[u * 64 + tid];
    __syncthreads();
    const int tb = wave >> 2, vb = wave & 3, g16 = (lane >> 4) & 1, q4 = (lane & 15) >> 2, p4 = lane & 3;
    const float Mt_c = __shfl(Mt, 32 * tb + c), wint_c = __shfl(wint, 32 * tb + c), flo_c = __shfl(flo, 32 * tb + c);
    bf16x8 qf[4];
#pragma unroll
    for (int ks = 0; ks < 4; ++ks) qf[ks] = *(LAS const bf16x8*)(lds + C_Q + (32 * tb + c) * QSTR + (16 * ks + 8 * hi) * 2);
    f32x16 X[2]; float dsum = 0.f;
#pragma unroll
    for (int j = 0; j < 2; ++j) {
        X[j] = (f32x16){};
        if (j <= tb) {
            LAS const unsigned char* kb = lds + C_K + (32 * j + c) * QSTR + hi * 16;
#pragma unroll
            for (int ks = 0; ks < 4; ++ks) X[j] = __builtin_amdgcn_mfma_f32_32x32x16_bf16(*(LAS const bf16x8*)(kb + ks * 32), qf[ks], X[j], 0, 0, 0);
#pragma unroll
            for (int r = 0; r < 16; ++r) {
                const int s = 32 * j + (r & 3) + 8 * (r >> 2) + 4 * hi;
                const float gs = *(LAS const float*)(lds + C_G + s * 4);
                const float w = (s <= 32 * tb + c) ? fexp(gs - Mt_c) : 0.f;
                X[j][r] *= w; dsum += X[j][r];
            }
        }
    }
    dsum += __shfl_xor(dsum, 32);
    float qn = 0.f;
    {   LAS const unsigned char* qr = lds + C_Q + (32 * tb + c) * QSTR + hi * 64; LAS const float* nr = (LAS const float*)(lds + C_N) + 32 * hi;
#pragma unroll
        for (int k4 = 0; k4 < 4; ++k4) { const v4u x = *(LAS const v4u*)(qr + k4 * 16);
            qn += bflo(x.x) * nr[8 * k4] + bfhi(x.x) * nr[8 * k4 + 1] + bflo(x.y) * nr[8 * k4 + 2] + bfhi(x.y) * nr[8 * k4 + 3] + bflo(x.z) * nr[8 * k4 + 4] + bfhi(x.z) * nr[8 * k4 + 5] + bflo(x.w) * nr[8 * k4 + 6] + bfhi(x.w) * nr[8 * k4 + 7]; }
    }
    qn += __shfl_xor(qn, 32);
    const float den = dsum + wint_c * qn, inv = __builtin_amdgcn_rcpf(fmaxf(fabsf(den), flo_c));
    f32x16 acc = {};
#pragma unroll
    for (int ks = 0; ks < 4; ++ks) acc = __builtin_amdgcn_mfma_f32_32x32x16_bf16(*(LAS const bf16x8*)(lds + C_C + (32 * vb + c) * CSTR + (16 * ks + 8 * hi) * 2), qf[ks], acc, 0, 0, 0);
#pragma unroll
    for (int r = 0; r < 16; ++r) acc[r] *= wint_c;
    LAS const unsigned char* va = lds + C_V + (4 * hi + q4) * VSTR + (32 * vb + 16 * g16 + 4 * p4) * 2;
#pragma unroll
    for (int j = 0; j < 2; ++j) {
        if (j <= tb) {
#pragma unroll
            for (int s2 = 0; s2 < 2; ++s2) {
                const s16x4 a0 = tr_read(va + (32 * j + 16 * s2) * VSTR), a1 = tr_read(va + (32 * j + 16 * s2 + 8) * VSTR);
                v4u w; w.x = pk_bf16(X[j][8 * s2], X[j][8 * s2 + 1]); w.y = pk_bf16(X[j][8 * s2 + 2], X[j][8 * s2 + 3]); w.z = pk_bf16(X[j][8 * s2 + 4], X[j][8 * s2 + 5]); w.w = pk_bf16(X[j][8 * s2 + 6], X[j][8 * s2 + 7]);
                acc = __builtin_amdgcn_mfma_f32_32x32x16_bf16((bf16x8){a0[0], a0[1], a0[2], a0[3], a1[0], a1[1], a1[2], a1[3]}, __builtin_bit_cast(bf16x8, w), acc, 0, 0, 0);
            }
        }
    }
    float ss = 0.f;
#pragma unroll
    for (int r = 0; r < 16; ++r) { acc[r] *= inv; ss += acc[r] * acc[r]; }
    ss += __shfl_xor(ss, 32);
    if (hi == 0) *(LAS float*)(lds + C_RED + (vb * 64 + 32 * tb + c) * 4) = ss;
#pragma unroll
    for (int gq = 0; gq < 4; ++gq) *(LAS f32x4*)(lds + C_H + (32 * tb + c) * HSTR + (32 * vb + 8 * gq + 4 * hi) * 4) = (f32x4){acc[4 * gq], acc[4 * gq + 1], acc[4 * gq + 2], acc[4 * gq + 3]};
    __syncthreads();
#pragma unroll
    for (int i = 0; i < 2; ++i) {
        const int idx = tid + 512 * i, t = idx >> 4, ch = idx & 15;
        LAS const float* red = (LAS const float*)(lds + C_RED);
        const float tot = (red[t] + red[64 + t]) + (red[128 + t] + red[192 + t]);
        const float rs = __builtin_amdgcn_rsqf(tot * (1.0f / 128.0f) + 1e-6f);
        const f32x4 h0 = *(LAS const f32x4*)(lds + C_H + t * HSTR + ch * 32), h1 = *(LAS const f32x4*)(lds + C_H + t * HSTR + ch * 32 + 16);
        bf16* zr = Z + (r0 + t) * ZP + h * 128 + ch * 8;
        const v4u o = *(const v4u*)(zr + 3584);
        const f32x4 g0 = *(const f32x4*)(gn + h * 128 + ch * 8), g1 = *(const f32x4*)(gn + h * 128 + ch * 8 + 4);
        float f[8];
        f[0] = pg8::fast_sigmoid(bflo(o.x)) * h0[0] * rs * g0[0]; f[1] = pg8::fast_sigmoid(bfhi(o.x)) * h0[1] * rs * g0[1];
        f[2] = pg8::fast_sigmoid(bflo(o.y)) * h0[2] * rs * g0[2]; f[3] = pg8::fast_sigmoid(bfhi(o.y)) * h0[3] * rs * g0[3];
        f[4] = pg8::fast_sigmoid(bflo(o.z)) * h1[0] * rs * g1[0]; f[5] = pg8::fast_sigmoid(bfhi(o.z)) * h1[1] * rs * g1[1];
        f[6] = pg8::fast_sigmoid(bflo(o.w)) * h1[2] * rs * g1[2]; f[7] = pg8::fast_sigmoid(bfhi(o.w)) * h1[3] * rs * g1[3];
        *(v4u*)(zr + 2560) = pack8(f);
    }
    __syncthreads();
}
}

struct Args { const float* in[19]; float* out; unsigned char* ws; int ph_lo, ph_hi, use_bar, pad; };

__global__ void __launch_bounds__(NWAVES * 64, 2) mk_fwd(Args args) {
    extern __shared__ __attribute__((aligned(16))) unsigned char lds_raw[];
    LAS unsigned char* lds = (LAS unsigned char*)lds_raw;
    volatile LAS unsigned* MISC = (volatile LAS unsigned*)(lds + MISC_OFF);
    const int tid = threadIdx.x, lane = tid & 63, wave = __builtin_amdgcn_readfirstlane(tid >> 6);
    const int G = gridDim.x, bx = blockIdx.x, vcu = (G % 8 == 0) ? (bx % 8) * (G / 8) + bx / 8 : bx;
    unsigned char* ws = args.ws;
    gu32* ctl = (gu32*)(ws + WS_CTL);
    float* SSQ = (float*)(ws + WS_CTL + CTL_SSQ);
    const float* x = args.in[0];
    bf16 *WGU1 = (bf16*)(ws + WS_WGU1), *WD1 = (bf16*)(ws + WS_WD1), *WIN = (bf16*)(ws + WS_WIN), *WG = (bf16*)(ws + WS_WG), *WPROJ = (bf16*)(ws + WS_WPROJ),
         *WOUT = (bf16*)(ws + WS_WOUT), *WGU2 = (bf16*)(ws + WS_WGU2), *WD2 = (bf16*)(ws + WS_WD2);
    bf16 *XB = (bf16*)(ws + WS_XB), *BIG = (bf16*)(ws + WS_BIG);
    float *BIN = (float*)(ws + WS_BIN), *BG = (float*)(ws + WS_BG), *IFB = (float*)(ws + WS_IF);
    bf16* MG = (bf16*)(ws + WS_ST);
    float *NLB = (float*)(ws + WS_IF + 1 * MiB), *SCB = (float*)(ws + WS_IF + 1 * MiB + 524288);
    for (int u = tid; u < (LDS_BYTES - LDSCTL_OFF) / 4; u += NWAVES * 64) ((LAS unsigned*)(lds + LDSCTL_OFF))[u] = 0u;
    __syncthreads();
    XcdBarrier bar; bar.bar = (unsigned*)(ctl + CW_BAR); bar.x = 0; bar.st = nullptr;
    if (args.use_bar) bar = xcd_barrier_post((unsigned*)(ctl + CW_BAR), MISC + 8);
    const int lo = args.ph_lo, hi = args.ph_hi;
#define IN(k) (lo <= (k) && (k) < hi)
#define SEAM(k) do { if (IN(k) && IN((k) + 1)) xcd_barrier(bar); } while (0)

    if (IN(0)) {
        LAS float* scr = (LAS float*)(lds + RING_OFF + wave * 16384);
        const int gw = vcu * NWAVES + wave, NGW = G * NWAVES;
        constexpr int I_GU = 16 * (FF / 32), I_D = (FF / 64) * 32, I_WIN = 16 * ((INW + 31) / 32), I_SQ = 16 * 32;
        constexpr int NITEMS = 4 * I_GU + 2 * I_D + I_WIN + 3 * I_SQ;
        for (int it = gw; it < NITEMS; it += NGW) {
            int r = it;
            if (r < I_GU) { transpose_item(args.in[2], FF, args.in[1], scr, r, lane, RmGate{WGU1}); continue; } r -= I_GU;
            if (r < I_GU) { transpose_item(args.in[3], FF, args.in[1], scr, r, lane, RmUp{WGU1}); continue; } r -= I_GU;
            if (r < I_D) { transpose_item(args.in[4], DM, nullptr, scr, r, lane, RmLin{WD1, FF, 0}); continue; } r -= I_D;
            if (r < I_WIN) { transpose_item(args.in[6], INW, args.in[5], scr, r, lane, RmWin{WIN, WG}); continue; } r -= I_WIN;
            if (r < I_SQ) { transpose_item(args.in[11], DM, nullptr, scr, r, lane, RmLin{WPROJ, 2048, 0}); continue; } r -= I_SQ;
            if (r < I_SQ) { transpose_item(args.in[12], DM, nullptr, scr, r, lane, RmLin{WPROJ, 2048, 1024}); continue; } r -= I_SQ;
            if (r < I_SQ) { transpose_item(args.in[13], DM, nullptr, scr, r, lane, RmLin{WOUT, 1024, 0}); continue; } r -= I_SQ;
            if (r < I_GU) { transpose_item(args.in[15], FF, args.in[14], scr, r, lane, RmGate{WGU2}); continue; } r -= I_GU;
            if (r < I_GU) { transpose_item(args.in[16], FF, args.in[14], scr, r, lane, RmUp{WGU2}); continue; } r -= I_GU;
            transpose_item(args.in[17], DM, nullptr, scr, r, lane, RmLin{WD2, FF, 0});
        }
        { const int gt = vcu * (NWAVES * 64) + tid, NGT = G * NWAVES * 64;
          GAS v4u* z = (GAS v4u*)(WIN + (size_t)NZREAL * 1024);
          for (int i = gt; i < (NWIN - NZREAL) * 1024 * 2 / 16; i += NGT) z[i] = (v4u){0u, 0u, 0u, 0u};
          for (int i = gt; i < NWIN; i += NGT) BIN[i] = i < NZREAL ? args.in[7][i] : 0.f;
          for (int i = gt; i < 2048; i += NGT) BG[i] = args.in[7][NZREAL + i]; }
        for (int m = gw; m < M; m += NGW) {
            const GAS f32x4* xr = (const GAS f32x4*)(x + (size_t)m * DM) + lane;
            f32x4 v[4]; float s = 0.f;
#pragma unroll
            for (int j = 0; j < 4; ++j) { v[j] = xr[64 * j]; s += (v[j].x * v[j].x + v[j].y * v[j].y) + (v[j].z * v[j].z + v[j].w * v[j].w); }
            s = wave_sum(s);
            GAS v2u* o8 = (GAS v2u*)(XB + (size_t)m * DM) + lane;
#pragma unroll
            for (int j = 0; j < 4; ++j) o8[64 * j] = (v2u){pk2(v[j].x, v[j].y), pk2(v[j].z, v[j].w)};
            if (lane == 0) SSQ[m] = s;
        }
        SEAM(0);
    }
    if (IN(1)) {
        pg8::Gemm g{XB, XB, WGU1, 1024, 1024, 1024, 1 << 30}; pg8::StaticOrder S; S.init(M, NGU, G, bx);
        pg8::EpiSwiglu E{BIG, FF, SSQ};
        pg8::gemm_phase<pg8::EpiSwiglu, pg8::StaticOrder, true, true>(lds + RING_OFF, g, S, E);
        SEAM(1);
    }
    if (IN(2)) {
        pg8::Gemm g{BIG, BIG, WD1, FF, FF, FF, 1 << 30}; pg8::StaticOrder S; S.init(M, DM, G, bx);
        pg8::EpiRes E{x, args.out, XB, SSQ + M, 0.5f};
        pg8::gemm_phase<pg8::EpiRes, pg8::StaticOrder, true, true>(lds + RING_OFF, g, S, E);
        SEAM(2);
    }

    if (IN(3)) {
        pg8::Gemm g{XB, XB, WIN, 1024, 1024, 1024, 1 << 30}; pg8::StaticOrder S; S.init(M, NWIN, G, bx);
        pg8::EpiWin E{BIG, ZP, IFB, BIN, SSQ + M};
        pg8::gemm_phase<pg8::EpiWin, pg8::StaticOrder, true, true>(lds + RING_OFF, g, S, E);
        SEAM(3);
    }

    if (IN(4)) {
        for (int u = bx; u < BATCH * 4 * 32; u += G) att::attn_unit(BIG, args.in[8], u >> 7, (u >> 5) & 3, u & 31, lds + RING_OFF);
        for (int u = bx; u < 2048; u += G) ml::phaseA_unit(BIG, IFB, args.in[9], MG, NLB, SCB, u, lds + RING_OFF);
        SEAM(4);
    }
    if (IN(5)) {
        ml::scan_phase(MG, NLB, SCB, bx, G, tid);
        SEAM(5);
    }
    if (IN(6)) {
        for (int u = bx; u < 2048; u += G) ml::phaseC_unit(BIG, IFB, args.in[9], MG, NLB, SCB, args.in[10], u, lds + RING_OFF);
        SEAM(6);
    }
    if (IN(7)) {
        pg8::Gemm g{XB, XB, WG, 1024, 1024, 1024, 1 << 30}; pg8::StaticOrder S; S.init(M, 2048, G, bx);
        pg8::EpiGate E{BIG, ZP, 1536, 3584, BG, SSQ + M};
        pg8::gemm_phase<pg8::EpiGate, pg8::StaticOrder, true, true>(lds + RING_OFF, g, S, E);
        SEAM(7);
    }
    if (IN(8)) {
        pg8::Gemm g{BIG, BIG + 2560 - 1024, WPROJ, ZP, 2048, 2048, 16}; pg8::StaticOrder S; S.init(M, DM, G, bx);
        pg8::EpiProj E{BIG, ZP, 1536, 3584, MG};
        pg8::gemm_phase<pg8::EpiProj, pg8::StaticOrder, true, true>(lds + RING_OFF, g, S, E);
        SEAM(8);
    }
    if (IN(9)) {
        pg8::Gemm g{MG, MG, WOUT, 1024, 1024, 1024, 1 << 30}; pg8::StaticOrder S; S.init(M, DM, G, bx);
        pg8::EpiRes E{args.out, args.out, XB, SSQ + 2 * M, 1.0f};
        pg8::gemm_phase<pg8::EpiRes, pg8::StaticOrder, true, true>(lds + RING_OFF, g, S, E);
        SEAM(9);
    }
    if (IN(10)) {
        pg8::Gemm g{XB, XB, WGU2, 1024, 1024, 1024, 1 << 30}; pg8::StaticOrder S; S.init(M, NGU, G, bx);
        pg8::EpiSwiglu E{BIG, FF, SSQ + 2 * M};
        pg8::gemm_phase<pg8::EpiSwiglu, pg8::StaticOrder, true, true>(lds + RING_OFF, g, S, E);
        SEAM(10);
    }
    if (IN(11)) {
        pg8::Gemm g{BIG, BIG, WD2, FF, FF, FF, 1 << 30}; pg8::StaticOrder S; S.init(M, DM, G, bx);
        pg8::EpiRes E{args.out, args.out, nullptr, SSQ + 3 * M, 0.5f};
        pg8::gemm_phase<pg8::EpiRes, pg8::StaticOrder, true, true>(lds + RING_OFF, g, S, E);
        SEAM(11);
    }
    if (IN(12)) {
        const int gw = vcu * NWAVES + wave, NGW = G * NWAVES; const float* gf = args.in[18];
        for (int m = gw; m < M; m += NGW) {
            GAS f32x4* xr = (GAS f32x4*)(args.out + (size_t)m * DM) + lane;
            const float rs = pg8::rstd_of(SSQ[3 * M + m]);
#pragma unroll
            for (int j = 0; j < 4; ++j) { const f32x4 gv = *((const f32x4*)gf + lane + 64 * j); f32x4 v = xr[64 * j]; xr[64 * j] = v * rs * gv; }
        }
    }
#undef IN
#undef SEAM
}

extern "C" void kernel_launch(void* const* d_in, const int* in_sizes, int n_in, void* d_out, int out_size, void* d_ws, size_t ws_size, hipStream_t stream) {
    static int grid = 0;
    if (grid == 0) {
        int dev = 0, cus = 0, per_cu = 0;
        if (n_in != 19 || out_size != M * DM || ws_size < WS_END) { fprintf(stderr, "kernel_launch: unexpected problem shape (n_in %d out %d ws %zu)\n", n_in, out_size, ws_size); grid = -1; return; }
        if (hipGetDevice(&dev) != hipSuccess || hipDeviceGetAttribute(&cus, hipDeviceAttributeMultiprocessorCount, dev) != hipSuccess) { grid = -1; return; }
        if (hipFuncSetAttribute((const void*)mk_fwd, hipFuncAttributeMaxDynamicSharedMemorySize, LDS_BYTES) != hipSuccess) { fprintf(stderr, "kernel_launch: hipFuncSetAttribute failed\n"); grid = -1; return; }
        if (hipOccupancyMaxActiveBlocksPerMultiprocessor(&per_cu, (const void*)mk_fwd, NWAVES * 64, LDS_BYTES) != hipSuccess || per_cu < 1) { fprintf(stderr, "kernel_launch: occupancy query says %d blocks per CU\n", per_cu); grid = -1; return; }
        (void)hipGetLastError();
        grid = cus;
    }
    if (grid < 0) return;
    (void)hipMemsetAsync((char*)d_ws + WS_CTL, 0, CTL_ZERO_BYTES, stream);
    Args a{};
    for (int i = 0; i < 19; ++i) a.in[i] = (const float*)d_in[i];
    a.out = (float*)d_out; a.ws = (unsigned char*)d_ws; a.use_bar = 1; a.ph_lo = 0; a.ph_hi = 13;
    hipLaunchKernelGGL(mk_fwd, dim3(grid), dim3(NWAVES * 64), LDS_BYTES, stream, a);
}
```

```cpp
#include <hip/hip_runtime.h>
#include <cstdio>
#include <cstdint>
namespace pg8 {
#define PG8_LAS __attribute__((address_space(3)))
typedef unsigned short bf16_t;
typedef short bf16x8 __attribute__((ext_vector_type(8)));
typedef float f32x4 __attribute__((ext_vector_type(4)));
typedef unsigned u32x4 __attribute__((ext_vector_type(4)));
typedef unsigned u32x2 __attribute__((ext_vector_type(2)));
constexpr int BM = 256, BK = 64, HALF = 128, HTB = HALF * BK * 2  , STAGE_BYTES = 8 * HTB, NXCD = 8, WGM = 8;
constexpr float RMS_EPS = 1e-6f;

__host__ __device__ __forceinline__ int lds_byte(int r, int c) { const int st = (r >> 4) * 2 + (c >> 5), rr = r & 15, cc = c & 31, ob = rr * 64 + cc * 2; return st * 1024 + (ob ^ (((ob >> 9) & 1) << 5)); }
__host__ __device__ __forceinline__ void stage_rc(int b, int& R, int& C) { const int st = b / 1024, sb = b % 1024, swz = sb ^ (((sb >> 9) & 1) << 5); R = (st >> 1) * 16 + swz / 64; C = (st & 1) * 32 + (swz % 64) / 2; }
__host__ __device__ __forceinline__ int perm32(int rho) { const int n = rho >> 4, i = rho & 15; return 8 * (i >> 2) + 4 * n + (i & 3); }

struct Unit { int pm, pn; };
struct Gemm { const bf16_t* A; const bf16_t* A2; const bf16_t* Bt; int lda, ldb, K, ksplit; };

struct StaticOrder {
    int nM, nN, nwg, G, c;
    __host__ __device__ void init(int M, int N, int G_, int c_) { nM = M / BM; nN = N / BM; nwg = nM * nN; G = G_; c = c_; }
    __host__ __device__ bool next(int i, Unit& u) const {
        const long L = (long)i * G + c; if (L >= nwg) return false;
        int wgid = (int)L; { const int q = nwg / NXCD, r = nwg % NXCD, xcd = wgid % NXCD, off = wgid / NXCD; wgid = (xcd < r ? xcd * (q + 1) : r * (q + 1) + (xcd - r) * q) + off; }
        const int nig = WGM * nN, gid = wgid / nig, fm = gid * WGM, gsz = (nM - fm) < WGM ? (nM - fm) : WGM;
        u.pm = fm + ((wgid % nig) % gsz); u.pn = (wgid % nig) / gsz; return true;
    }
    __device__ __forceinline__ void a_ready(const Unit&) const {}
    __device__ __forceinline__ void done(const Unit&) const {}
};

typedef float f32x2_t __attribute__((ext_vector_type(2))); typedef __bf16 bf16x2_t __attribute__((ext_vector_type(2)));
__device__ __forceinline__ unsigned cvt_pk_bf16(float lo, float hi) { f32x2_t v = {lo, hi}; bf16x2_t b = __builtin_convertvector(v, bf16x2_t); return __builtin_bit_cast(unsigned, b); }
__device__ __forceinline__ float fast_sigmoid(float x) { return __builtin_amdgcn_rcpf(1.0f + __builtin_amdgcn_exp2f(-1.4426950408889634f * x)); }
__device__ __forceinline__ float rstd_of(float ssq) { return __builtin_amdgcn_rsqf(ssq * (1.0f / 1024.0f) + RMS_EPS); }

struct EpiSwiglu {
    static constexpr bool PERM = true, HAS_MID = false;
    bf16_t* O; int ldo; const float* ssq;
    __device__ __forceinline__ void operator()(const f32x4 (&acc)[2][2][4][2], const Unit& u, int wr, int wc, int fr, int fq) const {
        const int row0 = u.pm * BM + wr * 64 + fr, col0 = u.pn * HALF + wc * 32 + 8 * fq;
#pragma unroll
        for (int ai = 0; ai < 2; ++ai)
#pragma unroll
            for (int m = 0; m < 4; ++m) {
                const int r = row0 + ai * HALF + m * 16; const float rs = rstd_of(ssq[r]);
                float o[8];
#pragma unroll
                for (int n = 0; n < 2; ++n)
#pragma unroll
                    for (int j = 0; j < 4; ++j) { const float gv = acc[ai][0][m][n][j] * rs, uv = acc[ai][1][m][n][j] * rs; o[4 * n + j] = gv * fast_sigmoid(gv) * uv; }
                u32x4 w; w.x = cvt_pk_bf16(o[0], o[1]); w.y = cvt_pk_bf16(o[2], o[3]); w.z = cvt_pk_bf16(o[4], o[5]); w.w = cvt_pk_bf16(o[6], o[7]);
                *(u32x4*)(O + (size_t)r * ldo + col0) = w;
            }
    }
};
struct EpiRes {
    static constexpr bool PERM = false, HAS_MID = false;
    const float* R; float* X; bf16_t* Xb; float* ssq; float alpha;
    __device__ __forceinline__ void operator()(const f32x4 (&acc)[2][2][4][2], const Unit& u, int wr, int wc, int fr, int fq) const {
        const int row0 = u.pm * BM + wr * 64 + fr, col0 = u.pn * BM + wc * 32 + 4 * fq;
#pragma unroll
        for (int ai = 0; ai < 2; ++ai)
#pragma unroll
            for (int m = 0; m < 4; ++m) {
                const int r = row0 + ai * HALF + m * 16; float sq = 0.f;
#pragma unroll
                for (int bj = 0; bj < 2; ++bj)
#pragma unroll
                    for (int n = 0; n < 2; ++n) {
                        const size_t off = (size_t)r * 1024 + col0 + bj * HALF + n * 16;
                        const f32x4 x = *(const f32x4*)(R + off) + acc[ai][bj][m][n] * alpha;
                        *(f32x4*)(X + off) = x; sq += (x[0] * x[0] + x[1] * x[1]) + (x[2] * x[2] + x[3] * x[3]);
                        if (Xb) { u32x2 w; w.x = cvt_pk_bf16(x[0], x[1]); w.y = cvt_pk_bf16(x[2], x[3]); *(u32x2*)(Xb + off) = w; }
                    }
                sq += __shfl_xor(sq, 16); sq += __shfl_xor(sq, 32);
                if (fq == 0) atomicAdd(ssq + r, sq);
            }
    }
};
struct EpiWin {
    static constexpr bool PERM = true, HAS_MID = false;
    bf16_t* Z; int ldz; float* IF; const float* bias; const float* ssq;
    __device__ __forceinline__ void operator()(const f32x4 (&acc)[2][2][4][2], const Unit& u, int wr, int wc, int fr, int fq) const {
        const int row0 = u.pm * BM + wr * 64 + fr, cw = wc * 32 + 8 * fq;
        const bool ztile = u.pn < 18;
#pragma unroll
        for (int ai = 0; ai < 2; ++ai)
#pragma unroll
            for (int m = 0; m < 4; ++m) {
                const int r = row0 + ai * HALF + m * 16; const float rs = rstd_of(ssq[r]);
#pragma unroll
                for (int bj = 0; bj < 2; ++bj) {
                    const int c = u.pn * BM + bj * HALF + cw;
                    const f32x4 v0 = acc[ai][bj][m][0] * rs + *(const f32x4*)(bias + c), v1 = acc[ai][bj][m][1] * rs + *(const f32x4*)(bias + c + 4);
                    if (ztile) { u32x4 w; w.x = cvt_pk_bf16(v0[0], v0[1]); w.y = cvt_pk_bf16(v0[2], v0[3]); w.z = cvt_pk_bf16(v1[0], v1[1]); w.w = cvt_pk_bf16(v1[2], v1[3]);
                        *(u32x4*)(Z + (size_t)r * ldz + c) = w; }
                    else if (bj == 0 && cw < 16) { *(f32x4*)(IF + (size_t)r * 16 + cw) = v0; *(f32x4*)(IF + (size_t)r * 16 + cw + 4) = v1; }
                }
            }
    }
};
struct EpiGate {
    static constexpr bool PERM = true, HAS_MID = false;
    bf16_t* Z; int ldz, off0, off1; const float* bias; const float* ssq;
    __device__ __forceinline__ void operator()(const f32x4 (&acc)[2][2][4][2], const Unit& u, int wr, int wc, int fr, int fq) const {
        const int row0 = u.pm * BM + wr * 64 + fr, cw = wc * 32 + 8 * fq;
        const int cdst0 = (u.pn < 4 ? off0 : off1) + (u.pn & 3) * BM;
#pragma unroll
        for (int ai = 0; ai < 2; ++ai)
#pragma unroll
            for (int m = 0; m < 4; ++m) {
                const int r = row0 + ai * HALF + m * 16; const float rs = rstd_of(ssq[r]);
#pragma unroll
                for (int bj = 0; bj < 2; ++bj) {
                    const int c = u.pn * BM + bj * HALF + cw;
                    const f32x4 v0 = acc[ai][bj][m][0] * rs + *(const f32x4*)(bias + c), v1 = acc[ai][bj][m][1] * rs + *(const f32x4*)(bias + c + 4);
                    u32x4 w; w.x = cvt_pk_bf16(fast_sigmoid(v0[0]), fast_sigmoid(v0[1])); w.y = cvt_pk_bf16(fast_sigmoid(v0[2]), fast_sigmoid(v0[3]));
                    w.z = cvt_pk_bf16(fast_sigmoid(v1[0]), fast_sigmoid(v1[1])); w.w = cvt_pk_bf16(fast_sigmoid(v1[2]), fast_sigmoid(v1[3]));
                    *(u32x4*)(Z + (size_t)r * ldz + cdst0 + bj * HALF + cw) = w;
                }
            }
    }
};
struct EpiProj {
    static constexpr bool PERM = true, HAS_MID = true;
    const bf16_t* Z; int ldz, off0, off1; bf16_t* O;
    __device__ __forceinline__ static float bfl(unsigned w) { return __builtin_bit_cast(float, w << 16); }
    __device__ __forceinline__ static float bfh(unsigned w) { return __builtin_bit_cast(float, w & 0xffff0000u); }
    __device__ __forceinline__ void mid(f32x4 (&acc)[2][2][4][2], const Unit& u, int wr, int wc, int fr, int fq) const {
        unsigned base = (unsigned)((u.pm * BM + wr * 64 + fr) * ldz + u.pn * BM + wc * 32 + 8 * fq) * 2u; asm volatile("" : "+v"(base));
        const char* zb = (const char*)Z;
#pragma unroll
        for (int ai = 0; ai < 2; ++ai)
#pragma unroll
            for (int m = 0; m < 4; ++m) {
#pragma unroll
                for (int bj = 0; bj < 2; ++bj) {
                    const unsigned o = base + (unsigned)(((ai * HALF + m * 16) * ldz + bj * HALF) * 2);
                    const u32x4 a = *(const u32x4*)(zb + o + (unsigned)(off0 * 2)), b = *(const u32x4*)(zb + o + (unsigned)(off1 * 2));
#pragma unroll
                    for (int q = 0; q < 4; ++q) {
                        const float rl = bfl(a[q]) * __builtin_amdgcn_rcpf(fmaxf(bfl(b[q]), 1e-30f)), rh = bfh(a[q]) * __builtin_amdgcn_rcpf(fmaxf(bfh(b[q]), 1e-30f));
                        acc[ai][bj][m][q >> 1][(q & 1) * 2] *= rl; acc[ai][bj][m][q >> 1][(q & 1) * 2 + 1] *= rh;
                    }
                    asm volatile("" ::: "memory");
                }
            }
    }
    __device__ __forceinline__ void operator()(const f32x4 (&acc)[2][2][4][2], const Unit& u, int wr, int wc, int fr, int fq) const {
        const int row0 = u.pm * BM + wr * 64 + fr, cw = wc * 32 + 8 * fq;
#pragma unroll
        for (int ai = 0; ai < 2; ++ai)
#pragma unroll
            for (int m = 0; m < 4; ++m) {
                const int r = row0 + ai * HALF + m * 16;
#pragma unroll
                for (int bj = 0; bj < 2; ++bj) {
                    const int c = u.pn * BM + bj * HALF + cw;
                    const u32x4 b = *(const u32x4*)(Z + (size_t)r * ldz + off1 + c);
                    u32x4 w;
#pragma unroll
                    for (int q = 0; q < 4; ++q) w[q] = cvt_pk_bf16(acc[ai][bj][m][q >> 1][(q & 1) * 2] * fmaxf(bfl(b[q]), 1e-30f), acc[ai][bj][m][q >> 1][(q & 1) * 2 + 1] * fmaxf(bfh(b[q]), 1e-30f));
                    *(u32x4*)(O + (size_t)r * 1024 + c) = w;
                    asm volatile("" ::: "memory");
                }
            }
    }
};
template <class Epi, class Sched, bool ALIGN_EPI = false, bool SP2 = false>
__device__ __forceinline__ void gemm_phase(PG8_LAS unsigned char* lds, const Gemm g, const Sched& S, const Epi& E) {
    const int tid = threadIdx.x, wid = __builtin_amdgcn_readfirstlane(tid >> 6), lane = tid & 63, wr = wid >> 2, wc = wid & 3, fr = lane & 15, fq = lane >> 4;
    const int K = g.K, nt = K / BK;
    unsigned voffA[2], voffB[2];
#pragma unroll
    for (int i = 0; i < 2; ++i) { int R, C; stage_rc(tid * 16 + i * 8192, R, C); const int Rb = Epi::PERM ? ((R & ~31) + perm32(R & 31)) : R;
        voffA[i] = (unsigned)(R * g.lda + C) * 2u; voffB[i] = (unsigned)(Rb * g.ldb + C) * 2u; }
    const size_t kstep = (size_t)(BK * 2);
    const size_t hstepA = (size_t)HALF * g.lda * 2, hstepB = (size_t)HALF * g.ldb * 2;
    const size_t tstepA = 2 * hstepA, tstepB = 2 * hstepB;
    const unsigned ldsw = (unsigned)wid * 1024u;
    const int aoff = lds_byte(wr * 64 + fr, fq * 8), boff = lds_byte(wc * 32 + fr, fq * 8);
#define PG8_SA(b, h) (((b) * 2 + (h)) * HTB)
#define PG8_SB(b, h) ((4 + (b) * 2 + (h)) * HTB)
#define PG8_STAGE(bufoff, gbase, voff) do { _Pragma("unroll") for (int _i = 0; _i < 2; ++_i) \
        __builtin_amdgcn_global_load_lds((const unsigned*)((const char*)(gbase) + (voff)[_i]), (PG8_LAS unsigned*)(lds + (bufoff) + ldsw + _i * 8192), 16, 0, 0); } while (0)
#define PG8_LDA(dst, b, h) do { _Pragma("unroll") for (int m = 0; m < 4; ++m) _Pragma("unroll") for (int k = 0; k < 2; ++k) dst[m][k] = *(const PG8_LAS bf16x8*)(lds + PG8_SA(b, h) + aoff + m * 2048 + k * 1024); } while (0)
#define PG8_LDB(dst, b, h) do { _Pragma("unroll") for (int n = 0; n < 2; ++n) _Pragma("unroll") for (int k = 0; k < 2; ++k) dst[n][k] = *(const PG8_LAS bf16x8*)(lds + PG8_SB(b, h) + boff + n * 2048 + k * 1024); } while (0)
#define PG8_MMA(ai, bj, At, Bt) do { __builtin_amdgcn_s_setprio(1); _Pragma("unroll") for (int m = 0; m < 4; ++m) _Pragma("unroll") for (int n = 0; n < 2; ++n) _Pragma("unroll") for (int k = 0; k < 2; ++k) \
        acc[ai][bj][m][n] = __builtin_amdgcn_mfma_f32_16x16x32_bf16(Bt[n][k], At[m][k], acc[ai][bj][m][n], 0, 0, 0); __builtin_amdgcn_s_setprio(0); } while (0)
#define PG8_WAIT_V(n) asm volatile("s_waitcnt vmcnt(" #n ")" ::: "memory")
#define PG8_WAIT_L(n) asm volatile("s_waitcnt lgkmcnt(" #n ")" ::: "memory")
#define PG8_BAR __builtin_amdgcn_s_barrier()
#define PG8_SCHED __builtin_amdgcn_sched_barrier(0)
    Unit cur, nxt; int ui = 0;
    if (!S.next(0, cur)) return;
    f32x4 acc[2][2][4][2];
#pragma unroll
    for (int a = 0; a < 2; ++a)
#pragma unroll
        for (int b = 0; b < 2; ++b)
#pragma unroll
            for (int m = 0; m < 4; ++m)
#pragma unroll
                for (int n = 0; n < 2; ++n) acc[a][b][m][n] = (f32x4){0.f, 0.f, 0.f, 0.f};
    bf16x8 At[4][2], B0[2][2], B1[2][2];
    const char* cA = (const char*)g.A + (size_t)cur.pm * tstepA; const char* cA2 = (const char*)g.A2 + (size_t)cur.pm * tstepA; const char* cB = (const char*)g.Bt + (size_t)cur.pn * tstepB;
    S.a_ready(cur);
    if constexpr (SP2) {
        PG8_STAGE(PG8_SB(0, 0), cB, voffB); PG8_STAGE(PG8_SB(0, 1), cB + hstepB, voffB); PG8_STAGE(PG8_SA(0, 0), cA, voffA); PG8_STAGE(PG8_SA(0, 1), cA + hstepA, voffA);
        if (wr == 1) PG8_BAR;
        PG8_WAIT_V(2); PG8_BAR;
        PG8_STAGE(PG8_SB(1, 0), cB + kstep, voffB); PG8_STAGE(PG8_SA(1, 0), cA + kstep, voffA); PG8_STAGE(PG8_SB(1, 1), cB + hstepB + kstep, voffB);
        PG8_WAIT_V(6); PG8_BAR;
    } else {
        PG8_STAGE(PG8_SB(0, 0), cB, voffB); PG8_STAGE(PG8_SA(0, 0), cA, voffA); PG8_STAGE(PG8_SB(0, 1), cB + hstepB, voffB); PG8_STAGE(PG8_SA(0, 1), cA + hstepA, voffA);
        if (wr == 1) PG8_BAR;
        PG8_WAIT_V(4); PG8_BAR;
        PG8_STAGE(PG8_SB(1, 0), cB + kstep, voffB); PG8_STAGE(PG8_SA(1, 0), cA + kstep, voffA); PG8_STAGE(PG8_SB(1, 1), cB + hstepB + kstep, voffB);
        PG8_WAIT_V(6); PG8_BAR;
    }
    for (;;) {
        const bool has_next = S.next(ui + 1, nxt);
        const char* nA = has_next ? (const char*)g.A + (size_t)nxt.pm * tstepA : cA; const char* nA2 = has_next ? (const char*)g.A2 + (size_t)nxt.pm * tstepA : cA2; const char* nB = has_next ? (const char*)g.Bt + (size_t)nxt.pn * tstepB : cB;
        for (int t = 0; t < nt; t += 2) {
            const bool last = (t == nt - 2);
            if constexpr (Epi::HAS_MID) { if (t == g.ksplit) E.mid(acc, cur, wr, wc, fr, fq); }
            const char* a1 = ((t + 1) < g.ksplit ? cA : cA2) + (size_t)(t + 1) * kstep;
            const char* a2 = last ? nA : ((t + 2) < g.ksplit ? cA : cA2) + (size_t)(t + 2) * kstep; const char* b2 = last ? nB : cB + (size_t)(t + 2) * kstep;
            const char* a3 = a2 + kstep; const char* b3 = b2 + kstep;
            if (last && has_next) S.a_ready(nxt);
            if constexpr (SP2) {
            PG8_LDB(B0, 0, 0); PG8_LDB(B1, 0, 1); PG8_SCHED; PG8_LDA(At, 0, 0); PG8_STAGE(PG8_SA(1, 1), a1 + hstepA, voffA);
            PG8_WAIT_V(8); PG8_WAIT_L(0); PG8_BAR; PG8_MMA(0, 0, At, B0); PG8_MMA(0, 1, At, B1); PG8_BAR; PG8_SCHED;
            PG8_LDA(At, 0, 1); PG8_STAGE(PG8_SB(0, 0), b2, voffB); PG8_STAGE(PG8_SB(0, 1), b2 + hstepB, voffB); PG8_STAGE(PG8_SA(0, 0), a2, voffA);
            PG8_WAIT_V(8); PG8_WAIT_L(0); PG8_BAR; PG8_MMA(1, 0, At, B0); PG8_MMA(1, 1, At, B1); PG8_BAR; PG8_SCHED;
            PG8_LDB(B0, 1, 0); PG8_LDB(B1, 1, 1); PG8_SCHED; PG8_LDA(At, 1, 0); PG8_STAGE(PG8_SA(0, 1), a2 + hstepA, voffA);
            PG8_WAIT_V(8); PG8_WAIT_L(0); PG8_BAR; PG8_MMA(0, 0, At, B0); PG8_MMA(0, 1, At, B1); PG8_BAR; PG8_SCHED;
            PG8_LDA(At, 1, 1); PG8_STAGE(PG8_SB(1, 0), b3, voffB); PG8_STAGE(PG8_SB(1, 1), b3 + hstepB, voffB); PG8_STAGE(PG8_SA(1, 0), a3, voffA);
            PG8_WAIT_V(8); PG8_WAIT_L(0); PG8_BAR; PG8_MMA(1, 0, At, B0); PG8_MMA(1, 1, At, B1); PG8_BAR; PG8_SCHED;
            } else {
            PG8_LDB(B0, 0, 0); PG8_SCHED; PG8_LDA(At, 0, 0); PG8_STAGE(PG8_SA(1, 1), a1 + hstepA, voffA);
            PG8_WAIT_L(8); PG8_BAR; PG8_WAIT_L(0); PG8_MMA(0, 0, At, B0); PG8_BAR; PG8_SCHED;
            PG8_LDB(B1, 0, 1); PG8_STAGE(PG8_SB(0, 0), b2, voffB);
            PG8_BAR; PG8_WAIT_L(0); PG8_MMA(0, 1, At, B1); PG8_BAR;
            PG8_LDA(At, 0, 1); PG8_STAGE(PG8_SA(0, 0), a2, voffA);
            PG8_BAR; PG8_WAIT_L(0); PG8_MMA(1, 0, At, B0); PG8_BAR; PG8_SCHED;
            PG8_STAGE(PG8_SB(0, 1), b2 + hstepB, voffB);
            PG8_WAIT_V(6); PG8_BAR; PG8_MMA(1, 1, At, B1); PG8_BAR;
            PG8_LDB(B0, 1, 0); PG8_SCHED; PG8_LDA(At, 1, 0); PG8_STAGE(PG8_SA(0, 1), a2 + hstepA, voffA);
            PG8_WAIT_L(8); PG8_BAR; PG8_WAIT_L(0); PG8_MMA(0, 0, At, B0); PG8_BAR; PG8_SCHED;
            PG8_LDB(B1, 1, 1); PG8_STAGE(PG8_SB(1, 0), b3, voffB);
            PG8_BAR; PG8_WAIT_L(0); PG8_MMA(0, 1, At, B1); PG8_BAR;
            PG8_LDA(At, 1, 1); PG8_STAGE(PG8_SA(1, 0), a3, voffA);
            PG8_BAR; PG8_WAIT_L(0); PG8_MMA(1, 0, At, B0); PG8_BAR; PG8_SCHED;
            PG8_STAGE(PG8_SB(1, 1), b3 + hstepB, voffB);
            PG8_WAIT_V(6); PG8_BAR; PG8_MMA(1, 1, At, B1); PG8_BAR;
            }
        }
        if constexpr (ALIGN_EPI) { if (wr == 0) PG8_BAR; }
        E(acc, cur, wr, wc, fr, fq); S.done(cur);
        if (!has_next) break;
#pragma unroll
        for (int a = 0; a < 2; ++a)
#pragma unroll
            for (int b = 0; b < 2; ++b)
#pragma unroll
                for (int m = 0; m < 4; ++m)
#pragma unroll
                    for (int n = 0; n < 2; ++n) acc[a][b][m][n] = (f32x4){0.f, 0.f, 0.f, 0.f};
        cur = nxt; cA = nA; cA2 = nA2; cB = nB; ++ui;
        if constexpr (ALIGN_EPI) { if (wr == 1) PG8_BAR; }
    }
    PG8_WAIT_V(0);
    if constexpr (!ALIGN_EPI) { if (wr == 0) PG8_BAR; }
    PG8_BAR;

#undef PG8_SA
#undef PG8_SB
#undef PG8_STAGE
#undef PG8_LDA
#undef PG8_LDB
#undef PG8_MMA
#undef PG8_WAIT_V
#undef PG8_WAIT_L
#undef PG8_BAR
#undef PG8_SCHED
}
}

constexpr int NWAVES = 8;
constexpr int BATCH = 4, SEQ = 4096, DM = 1024, M = BATCH * SEQ, FF = 2816, INW = 6672;
constexpr int NGU = 2 * FF;
constexpr int ZP = 4608;
constexpr int NWIN = 4864;
constexpr int NZREAL = 4624;
constexpr size_t MiB = 1u << 20;
constexpr size_t WS_CTL = 0, CTL_ZERO_BYTES = 1 * MiB;
constexpr size_t WS_BIN = 1 * MiB, WS_BG = WS_BIN + 32768;
constexpr size_t WS_WG = 2 * MiB, WS_WPROJ = 6 * MiB, WS_WOUT = 10 * MiB, WS_WGU2 = 12 * MiB, WS_WD2 = 23 * MiB;
constexpr size_t WS_ST = 29 * MiB;
constexpr size_t WS_WGU1 = 29 * MiB, WS_WD1 = 40 * MiB, WS_WIN = WS_WD1 + 5767168;
constexpr size_t WS_XB = 61 * MiB;
constexpr size_t WS_BIG = 93 * MiB;
constexpr size_t WS_IF = 237 * MiB;
constexpr size_t WS_END = 240 * MiB;
static_assert(WS_WIN + (size_t)NWIN * 1024 * 2 <= WS_XB && WS_ST + 32 * MiB <= WS_XB && WS_WD2 + (size_t)1024 * FF * 2 <= WS_ST, "ws map");
constexpr int CW_BAR = 4096;
constexpr size_t CTL_SSQ = 512 * 1024;
constexpr int RING_OFF = 0, RING_BYTES = 131072;
constexpr int LDSCTL_OFF = 151552, MISC_OFF = LDSCTL_OFF + 320;
constexpr int LDS_BYTES = 155648;

#define GAS __attribute__((address_space(1)))
#define LAS __attribute__((address_space(3)))
typedef unsigned short bf16;
typedef unsigned v4u __attribute__((ext_vector_type(4)));
typedef unsigned v2u __attribute__((ext_vector_type(2)));
typedef float f32x4 __attribute__((ext_vector_type(4)));
typedef short bf16x8 __attribute__((ext_vector_type(8)));
typedef GAS unsigned gu32;
#define RLX_AGENT __ATOMIC_RELAXED, __HIP_MEMORY_SCOPE_AGENT
#define LDS_WAIT() asm volatile("s_waitcnt lgkmcnt(0)" ::: "memory")
#define VM_WAIT() asm volatile("s_waitcnt vmcnt(0)" ::: "memory")
__device__ __forceinline__ unsigned f2bf(float f) { unsigned u = __builtin_bit_cast(unsigned, f); return (u + 0x7fffu + ((u >> 16) & 1u)) >> 16; }
__device__ __forceinline__ unsigned pk2(float lo, float hi) { return f2bf(lo) | (f2bf(hi) << 16); }
__device__ __forceinline__ float bf2f(unsigned short b) { return __builtin_bit_cast(float, (unsigned)b << 16); }

#define XB_TMO      128
#define XB_XCNT(j)  (256  + 64 * (j))
#define XB_XSUB(j)  (1280 + 64 * (j))
#define XB_XGEN(j)  (2304 + 64 * (j))
#define XB_TOP      3328
#define XB_TOPGEN   3392
#define XCD_BAR_WORDS 3456
#define XB_SPIN_CAP (1u << 23)
__device__ __forceinline__ unsigned xb_ld(unsigned* p)              { return __hip_atomic_load(p, __ATOMIC_RELAXED, __HIP_MEMORY_SCOPE_AGENT); }
__device__ __forceinline__ unsigned xb_add(unsigned* p, unsigned v) { return __hip_atomic_fetch_add(p, v, __ATOMIC_RELAXED, __HIP_MEMORY_SCOPE_AGENT); }
__device__ __forceinline__ unsigned xb_xcc_id() { return (unsigned)__builtin_amdgcn_s_getreg((3 << 11) | 20) & 0xFu; }
#define XB_SPIN(cond, bar) do { unsigned _sp = 0; while (cond) { __builtin_amdgcn_s_sleep(1); \
    if ((++_sp & 255u) == 0u) { if (xb_ld(&(bar)[XB_TMO])) break; if (_sp > XB_SPIN_CAP) { atomicAdd(&(bar)[XB_TMO], 1u); break; } } } } while (0)
struct XcdBarrier { unsigned* bar; unsigned x; volatile LAS unsigned* st; };
__device__ __forceinline__ XcdBarrier xcd_barrier_post(unsigned* bar, volatile LAS unsigned* st) {
    XcdBarrier b; b.bar = bar; b.x = xb_xcc_id(); b.st = st;
    if (threadIdx.x == 0) (void)xb_add(&bar[XB_XCNT(b.x)], 1u);
    return b;
}
__device__ __forceinline__ void xcd_barrier_complete(unsigned* bar, unsigned x, unsigned& nloc, unsigned& nx) {
    const unsigned G = gridDim.x * gridDim.y * gridDim.z;
    unsigned sum, cnt, mine, sp = 0u;
    for (;;) {
        sum = 0u; cnt = 0u; mine = 0u;
#pragma unroll
        for (unsigned j = 0; j < 16; ++j) { const unsigned c = xb_ld(&bar[XB_XCNT(j)]); sum += c; cnt += (c > 0u) ? 1u : 0u; mine = (j == x) ? c : mine; }
        if (sum == G) break;
        __builtin_amdgcn_s_sleep(1);
        if ((++sp & 255u) == 0u) { if (xb_ld(&bar[XB_TMO])) break; if (sp > XB_SPIN_CAP) { atomicAdd(&bar[XB_TMO], 1u); break; } }
    }
    nloc = mine > 0u ? mine : 1u; nx = cnt > 0u ? cnt : 1u;
}
__device__ __forceinline__ void xcd_barrier(const XcdBarrier& b) {
    asm volatile("s_waitcnt vmcnt(0)" ::: "memory");
    __syncthreads();
    if (threadIdx.x == 0) {
        unsigned* bar = b.bar;
        __builtin_amdgcn_s_waitcnt(0);
        unsigned nloc = b.st[0], nx = b.st[1];
        if (nloc == 0u) { xcd_barrier_complete(bar, b.x, nloc, nx); b.st[0] = nloc; b.st[1] = nx; }
        const unsigned old = xb_add(&bar[XB_XSUB(b.x)], 1u);
        const unsigned gen = old / nloc;
        if (old + 1u == (gen + 1u) * nloc) {
            __builtin_amdgcn_fence(__ATOMIC_RELEASE, "agent");
            asm volatile("s_waitcnt vmcnt(0)" ::: "memory");
            const unsigned og = xb_add(&bar[XB_TOP], 1u);
            const unsigned tg = og / nx;
            if (og + 1u == (tg + 1u) * nx) xb_add(&bar[XB_TOPGEN], 1u);
            else XB_SPIN(xb_ld(&bar[XB_TOPGEN]) == tg, bar);
            __builtin_amdgcn_fence(__ATOMIC_ACQUIRE, "agent");
            xb_add(&bar[XB_XGEN(b.x)], 1u);
            asm volatile("s_waitcnt vmcnt(0)" ::: "memory");
        } else {
            XB_SPIN(xb_ld(&bar[XB_XGEN(b.x)]) == gen, bar);
            __builtin_amdgcn_fence(__ATOMIC_ACQUIRE, "agent");
            asm volatile("s_waitcnt vmcnt(0)" ::: "memory");
        }
    }
    __syncthreads();
}

__device__ __forceinline__ float wave_sum(float v) {
#pragma unroll
    for (int o = 1; o < 64; o <<= 1) v += __shfl_xor(v, o);
    return v;
}
template <class RowMap>
__device__ __forceinline__ void transpose_item(const float* W, int N, const float* g, LAS float* scr, int item, int lane, const RowMap& rm) {
    const int nblk = (N + 31) / 32, kb = item / nblk, nb = item % nblk, k0 = 64 * kb, n0 = 32 * nb;
    const int nl = lane & 31, nsrc = n0 + nl;
#pragma unroll 8
    for (int i = 0; i < 32; ++i) { const int kk = 2 * i + (lane >> 5); float v = nsrc < N ? W[(size_t)(k0 + kk) * N + nsrc] : 0.f; if (g) v *= g[k0 + kk]; scr[kk * 33 + nl] = v; }
    LDS_WAIT(); asm volatile("" ::: "memory");
    const int c = lane & 7;
#pragma unroll
    for (int j = 0; j < 4; ++j) { const int n = (lane >> 3) + 8 * j; const LAS float* s = scr + (8 * c) * 33 + n;
        v4u o; o.x = pk2(s[0 * 33], s[1 * 33]); o.y = pk2(s[2 * 33], s[3 * 33]); o.z = pk2(s[4 * 33], s[5 * 33]); o.w = pk2(s[6 * 33], s[7 * 33]);
        if (n0 + n < N) *(GAS v4u*)(rm(n0 + n) + k0 + 8 * c) = o; }
    LDS_WAIT(); asm volatile("" ::: "memory");
}
struct RmGate { bf16* W; __device__ __forceinline__ bf16* operator()(int n) const { return W + (size_t)(256 * (n >> 7) + (n & 127)) * 1024; } };
struct RmUp   { bf16* W; __device__ __forceinline__ bf16* operator()(int n) const { return W + (size_t)(256 * (n >> 7) + 128 + (n & 127)) * 1024; } };
struct RmLin  { bf16* W; int ld, koff; __device__ __forceinline__ bf16* operator()(int n) const { return W + (size_t)n * ld + koff; } };
struct RmWin  { bf16* Win; bf16* Wg; __device__ __forceinline__ bf16* operator()(int n) const { return n < NZREAL ? Win + (size_t)n * 1024 : Wg + (size_t)(n - NZREAL) * 1024; } };


namespace att {
typedef float f32x16 __attribute__((ext_vector_type(16)));
typedef short s16x4 __attribute__((ext_vector_type(4)));
constexpr int KSTR = 144, VSTR = 192, STG_STR = 144;
constexpr int LDS_K = 0, LDS_V = 256 * KSTR, LDS_STG = LDS_V + 256 * VSTR, LDS_END = LDS_STG + 8 * 32 * STG_STR;
__device__ __forceinline__ s16x4 tr_read(LAS const unsigned char* p) { return __builtin_bit_cast(s16x4, __builtin_amdgcn_ds_read_tr16_b64_v4i16((LAS s16x4*)p)); }
__device__ __forceinline__ unsigned pk_bf16(float lo, float hi) { return pg8::cvt_pk_bf16(lo, hi); }

__device__ __forceinline__ void attn_unit(bf16* Z, const float* sinks, int b, int hkv, int qb, LAS unsigned char* lds) {
    int tid_ = threadIdx.x; asm volatile("" : "+v"(tid_));
    const int tid = tid_, lane = tid & 63, wave = __builtin_amdgcn_readfirstlane(tid >> 6), c = lane & 31, hi = lane >> 5;
    const int q0 = qb * 128; const size_t rowbase = (size_t)b * SEQ;
#pragma unroll
    for (int i = 0; i < 4; ++i) {
        const int idx = tid + 512 * i, kk = idx >> 3, ch = idx & 7, pos = q0 - 128 + kk;
        v4u kv = (v4u){0u, 0u, 0u, 0u}, vv = (v4u){0u, 0u, 0u, 0u};
        if (pos >= 0) { const bf16* zr = Z + (rowbase + pos) * ZP + hkv * 64 + ch * 8; kv = *(const v4u*)(zr + 1024); vv = *(const v4u*)(zr + 1280); }
        *(LAS v4u*)(lds + LDS_K + kk * KSTR + ch * 16) = kv;
        *(LAS v4u*)(lds + LDS_V + kk * VSTR + ch * 16) = vv;
    }
    __syncthreads();
    const int hq = hkv * 4 + (wave >> 1);
    const float sink8 = sinks[hq] * 8.0f;
    const float cs = 0.125f * 1.4426950408889634f;
#pragma unroll 1
    for (int blk = 0; blk < 2; ++blk) {
        const int i32 = 2 * (wave & 1) + blk, qs = q0 + 32 * i32;
        bf16* qrow = Z + (rowbase + qs + c) * ZP + hq * 64;
        bf16x8 qf[4];
#pragma unroll
        for (int s = 0; s < 4; ++s) qf[s] = *(const bf16x8*)(qrow + 16 * s + 8 * hi);
        f32x16 st[5];
#pragma unroll
        for (int j = 0; j < 5; ++j) {
            LAS const unsigned char* kb = lds + LDS_K + (32 * i32 + 32 * j + c) * KSTR + hi * 16;
            f32x16 acc = {};
#pragma unroll
            for (int s = 0; s < 4; ++s) { const bf16x8 kf = *(LAS const bf16x8*)(kb + s * 32); acc = __builtin_amdgcn_mfma_f32_32x32x16_bf16(kf, qf[s], acc, 0, 0, 0); }
            st[j] = acc;
        }
#pragma unroll
        for (int r = 0; r < 16; ++r) {
            const int rr = (r & 3) + 8 * (r >> 2) + 4 * hi;
            if (!(rr > c)) st[0][r] = -INFINITY;
            if (!(rr <= c)) st[4][r] = -INFINITY;
        }
        if (qb == 0) {
#pragma unroll
            for (int j = 0; j < 5; ++j)
#pragma unroll
                for (int r = 0; r < 16; ++r) { const int rr = (r & 3) + 8 * (r >> 2) + 4 * hi; if (32 * i32 + 32 * j + rr < 128) st[j][r] = -INFINITY; }
        }
        float m = sink8;
#pragma unroll
        for (int j = 0; j < 5; ++j)
#pragma unroll
            for (int r = 0; r < 16; ++r) m = fmaxf(m, st[j][r]);
        m = fmaxf(m, __shfl_xor(m, 32));
        const float mb = m * cs; float sum = 0.f;
        bf16x8 pf[5][2];
#pragma unroll
        for (int j = 0; j < 5; ++j) {
            float p[16];
#pragma unroll
            for (int r = 0; r < 16; ++r) { p[r] = __builtin_amdgcn_exp2f(st[j][r] * cs - mb); sum += p[r]; }
#pragma unroll
            for (int s = 0; s < 2; ++s) { v4u w; w.x = pk_bf16(p[8 * s], p[8 * s + 1]); w.y = pk_bf16(p[8 * s + 2], p[8 * s + 3]); w.z = pk_bf16(p[8 * s + 4], p[8 * s + 5]); w.w = pk_bf16(p[8 * s + 6], p[8 * s + 7]);
                pf[j][s] = __builtin_bit_cast(bf16x8, w); }
        }
        sum += __shfl_xor(sum, 32);
        sum += __builtin_amdgcn_exp2f(sink8 * cs - mb);
        f32x16 ot[2] = {};
        const int g16 = (lane >> 4) & 1, q4 = (lane & 15) >> 2, p4 = lane & 3;
        LAS const unsigned char* vb = lds + LDS_V + (32 * i32 + 4 * hi + q4) * VSTR + (16 * g16 + 4 * p4) * 2;
#pragma unroll
        for (int j = 0; j < 5; ++j)
#pragma unroll
            for (int s = 0; s < 2; ++s)
#pragma unroll
                for (int db = 0; db < 2; ++db) {
                    const s16x4 lo = tr_read(vb + (32 * j + 16 * s) * VSTR + db * 64), hh = tr_read(vb + (32 * j + 16 * s + 8) * VSTR + db * 64);
                    const bf16x8 vf = (bf16x8){lo[0], lo[1], lo[2], lo[3], hh[0], hh[1], hh[2], hh[3]};
                    ot[db] = __builtin_amdgcn_mfma_f32_32x32x16_bf16(vf, pf[j][s], ot[db], 0, 0, 0);
                }
        const float inv = __builtin_amdgcn_rcpf(sum);
        LAS unsigned char* stg = lds + LDS_STG + wave * (32 * STG_STR);
#pragma unroll
        for (int db = 0; db < 2; ++db)
#pragma unroll
            for (int g = 0; g < 4; ++g) {
                v2u w; w.x = pk_bf16(ot[db][4 * g] * inv, ot[db][4 * g + 1] * inv); w.y = pk_bf16(ot[db][4 * g + 2] * inv, ot[db][4 * g + 3] * inv);
                *(LAS v2u*)(stg + c * STG_STR + (32 * db + 8 * g + 4 * hi) * 2) = w;
            }
        LDS_WAIT(); asm volatile("" ::: "memory");
#pragma unroll
        for (int it = 0; it < 4; ++it) {
            const int row = it * 8 + (lane >> 3), chn = lane & 7;
            const v4u v = *(LAS const v4u*)(stg + row * STG_STR + chn * 16);
            *(v4u*)(Z + (rowbase + qs + row) * ZP + hq * 64 + chn * 8) = v;
        }
        LDS_WAIT(); asm volatile("" ::: "memory");
    }
    __syncthreads();
}
}

namespace ml {
using att::f32x16; using att::s16x4; using att::tr_read; using att::pk_bf16;
constexpr int QSTR = 144, KWSTR = 192, VSTR = 320, CSTR = 144, HSTR = 528;
constexpr float LOG2E = 1.4426950408889634f;
__device__ __forceinline__ float fexp(float x) { return __builtin_amdgcn_exp2f(x * LOG2E); }
__device__ __forceinline__ float bflo(unsigned w) { return __builtin_bit_cast(float, w << 16); }
__device__ __forceinline__ float bfhi(unsigned w) { return __builtin_bit_cast(float, w & 0xffff0000u); }
__device__ __forceinline__ void gates(float zi, float zf, int lane, float& cum, float& g, float& pm) {
    const float ig = 15.0f - 30.0f * __builtin_amdgcn_rcpf(1.0f + __builtin_amdgcn_exp2f(zi * (2.0f / 15.0f * LOG2E)));
    const float fc = 15.0f - 30.0f * __builtin_amdgcn_rcpf(1.0f + __builtin_amdgcn_exp2f(zf * (2.0f / 15.0f * LOG2E)));
    const float lf = fminf(fc, 0.f) - 0.6931471805599453f * __builtin_amdgcn_logf(1.0f + __builtin_amdgcn_exp2f(-fabsf(fc) * LOG2E));
    float cs = lf;
#pragma unroll
    for (int o = 1; o < 64; o <<= 1) { const float t = __shfl_up(cs, o); if (lane >= o) cs += t; }
    cum = cs; g = ig - cs; float p = g;
#pragma unroll
    for (int o = 1; o < 64; o <<= 1) { const float t = __shfl_up(p, o); if (lane >= o) p = fmaxf(p, t); }
    pm = p;
}
__device__ __forceinline__ void load_cwt(LAS float* cwt, const float* cw, int h, int tid) {
    const int j = tid >> 6, d = tid & 63;
    cwt[j * 64 + d] = cw[(j & 3) * 1024 + (j >> 2) * 512 + h * 64 + d];
}
__device__ __forceinline__ void conv8(const v4u (&x)[4], float m0, float m1, float m2, LAS const float* w, int ch8, float (&o)[8]) {
    float a[8];
#pragma unroll
    for (int e = 0; e < 8; ++e) a[e] = 0.f;
#pragma unroll
    for (int j = 0; j < 4; ++j) {
        const float mk = j == 0 ? m0 : (j == 1 ? m1 : (j == 2 ? m2 : 1.0f));
        const f32x4 w0 = *(LAS const f32x4*)(w + j * 64 + ch8 * 8) * mk, w1 = *(LAS const f32x4*)(w + j * 64 + ch8 * 8 + 4) * mk;
        a[0] += bflo(x[j].x) * w0[0]; a[1] += bfhi(x[j].x) * w0[1]; a[2] += bflo(x[j].y) * w0[2]; a[3] += bfhi(x[j].y) * w0[3];
        a[4] += bflo(x[j].z) * w1[0]; a[5] += bfhi(x[j].z) * w1[1]; a[6] += bflo(x[j].w) * w1[2]; a[7] += bfhi(x[j].w) * w1[3];
    }
#pragma unroll
    for (int e = 0; e < 8; ++e) o[e] = a[e] * pg8::fast_sigmoid(a[e]);
}
__device__ __forceinline__ v4u pack8(const float (&o)[8]) { v4u w; w.x = pk_bf16(o[0], o[1]); w.y = pk_bf16(o[2], o[3]); w.z = pk_bf16(o[4], o[5]); w.w = pk_bf16(o[6], o[7]); return w; }
__device__ __forceinline__ int unit_of(int bx, int i) { return (bx >> 3) * 64 + (bx & 7) + 8 * i; }

constexpr int A_KW = 0, A_V = 64 * KWSTR, A_CWT = A_V + 64 * VSTR, A_END = A_CWT + 2048;
struct ALoad { v4u k[4]; v4u v[2]; float gi, gf; };
__device__ __forceinline__ void phaseA_issue(ALoad& L, const bf16* Z, const float* IF, int u, int tid, int lane) {
    const int h = (u >> 6) & 7, b = u >> 9, cc = u & 63; const size_t r0 = (size_t)b * SEQ + cc * 64;
    const int t = tid >> 3, ch8 = tid & 7;
#pragma unroll
    for (int j = 0; j < 4; ++j) { const int dt = (cc * 64 + t - 3 + j) < 0 ? 0 : (t - 3 + j); L.k[j] = *(const v4u*)(Z + (r0 + dt) * ZP + 2048 + h * 64 + ch8 * 8); }
#pragma unroll
    for (int i = 0; i < 2; ++i) { const int idx = tid + 512 * i, tt = idx >> 4, chv = idx & 15; L.v[i] = *(const v4u*)(Z + (r0 + tt) * ZP + 2560 + h * 128 + chv * 8); }
    L.gi = IF[(r0 + lane) * 16 + h]; L.gf = IF[(r0 + lane) * 16 + 8 + h];
}
__device__ __forceinline__ void phaseA_all(const bf16* Z, const float* IF, const float* cw, bf16* CT, float* NL, float* SCAL, int bx, LAS unsigned char* lds) {
    int tid_ = threadIdx.x; asm volatile("" : "+v"(tid_));
    const int tid = tid_, lane = tid & 63, wave = __builtin_amdgcn_readfirstlane(tid >> 6), c = lane & 31, hi = lane >> 5;
    const int h = (bx >> 3) & 7;
    load_cwt((LAS float*)(lds + A_CWT), cw, h, tid);
    ALoad L; phaseA_issue(L, Z, IF, unit_of(bx, 0), tid, lane);
    __syncthreads();
#pragma unroll 1
    for (int i = 0; i < 8; ++i) {
        const int u = unit_of(bx, i), cc = u & 63;
        float cum, g, pm; gates(L.gi, L.gf, lane, cum, g, pm);
        const float P = __shfl(pm, 63), total = __shfl(cum, 63);
        const float wkv = fexp(g - P);
        if (tid == 0) { SCAL[u * 4] = total; SCAL[u * 4 + 1] = P; }
        {   const int t = tid >> 3, ch8 = tid & 7; const float wk_t = __shfl(wkv, wave * 8 + (lane >> 3)) * 0.125f;
            const int tp = cc * 64 + t; float kf[8];
            conv8(L.k, tp - 3 >= 0 ? 1.f : 0.f, tp - 2 >= 0 ? 1.f : 0.f, tp - 1 >= 0 ? 1.f : 0.f, (LAS const float*)(lds + A_CWT) + 256, ch8, kf);
#pragma unroll
            for (int e = 0; e < 8; ++e) kf[e] *= wk_t;
            *(LAS v4u*)(lds + A_KW + t * KWSTR + ch8 * 16) = pack8(kf);
        }
#pragma unroll
        for (int q = 0; q < 2; ++q) { const int idx = tid + 512 * q, tt = idx >> 4, chv = idx & 15; *(LAS v4u*)(lds + A_V + tt * VSTR + chv * 16) = L.v[q]; }
        __syncthreads();
        if (i + 1 < 8) phaseA_issue(L, Z, IF, unit_of(bx, i + 1), tid, lane);
        const int db = wave >> 2, vb = wave & 3, g16 = (lane >> 4) & 1, q4 = (lane & 15) >> 2, p4 = lane & 3;
        f32x16 acc = {};
        LAS const unsigned char* ka = lds + A_KW + (8 * hi + q4) * KWSTR + (32 * db + 16 * g16 + 4 * p4) * 2;
        LAS const unsigned char* va = lds + A_V + (8 * hi + q4) * VSTR + (32 * vb + 16 * g16 + 4 * p4) * 2;
#pragma unroll
        for (int ks = 0; ks < 4; ++ks) {
            const s16x4 a0 = tr_read(ka + (16 * ks) * KWSTR), a1 = tr_read(ka + (16 * ks + 4) * KWSTR);
            const s16x4 b0 = tr_read(va + (16 * ks) * VSTR), b1 = tr_read(va + (16 * ks + 4) * VSTR);
            acc = __builtin_amdgcn_mfma_f32_32x32x16_bf16((bf16x8){a0[0], a0[1], a0[2], a0[3], a1[0], a1[1], a1[2], a1[3]}, (bf16x8){b0[0], b0[1], b0[2], b0[3], b1[0], b1[1], b1[2], b1[3]}, acc, 0, 0, 0);
        }
        bf16* crow = CT + ((size_t)u * 128 + 32 * vb + c) * 64 + 32 * db + 4 * hi;
#pragma unroll
        for (int gq = 0; gq < 4; ++gq) { v2u w; w.x = pk_bf16(acc[4 * gq], acc[4 * gq + 1]); w.y = pk_bf16(acc[4 * gq + 2], acc[4 * gq + 3]); *(v2u*)(crow + 8 * gq) = w; }
        if (tid < 64) { float s = 0.f;
#pragma unroll 8
            for (int sidx = 0; sidx < 64; ++sidx) s += bf2f(*(LAS const unsigned short*)(lds + A_KW + sidx * KWSTR + tid * 2));
            NL[u * 64 + tid] = s; }
        __syncthreads();
    }
}

__device__ __forceinline__ void scan_phase(bf16* CT, float* NL, float* SCAL, int bx, int tid_in) {
    int tid = tid_in; asm volatile("" : "+v"(tid));
    const int bh = bx >> 3, sub = bx & 7, u0 = bh * 64;
    if (tid < 128) {
        v4u* p = (v4u*)CT + (size_t)u0 * 1024 + sub * 128 + tid;
        float s[8]; float m = 0.f;
#pragma unroll
        for (int e = 0; e < 8; ++e) s[e] = 0.f;
#pragma unroll 8
        for (int cidx = 0; cidx < 64; ++cidx) {
            const v4u w = p[(size_t)cidx * 1024];
            const float tot = SCAL[(u0 + cidx) * 4], P = SCAL[(u0 + cidx) * 4 + 1];
            const float Mx = fmaxf(m, P), dec = fexp(m - Mx), ee = fexp(P - Mx);
            v4u o; o.x = pk_bf16(s[0], s[1]); o.y = pk_bf16(s[2], s[3]); o.z = pk_bf16(s[4], s[5]); o.w = pk_bf16(s[6], s[7]);
            p[(size_t)cidx * 1024] = o;
            s[0] = dec * s[0] + ee * bflo(w.x); s[1] = dec * s[1] + ee * bfhi(w.x); s[2] = dec * s[2] + ee * bflo(w.y); s[3] = dec * s[3] + ee * bfhi(w.y);
            s[4] = dec * s[4] + ee * bflo(w.z); s[5] = dec * s[5] + ee * bfhi(w.z); s[6] = dec * s[6] + ee * bflo(w.w); s[7] = dec * s[7] + ee * bfhi(w.w);
            m = tot + Mx;
        }
    } else if (sub == 0 && tid < 192) {
        const int d = tid - 128; float sn = 0.f, m = 0.f;
#pragma unroll 8
        for (int cidx = 0; cidx < 64; ++cidx) {
            const float tot = SCAL[(u0 + cidx) * 4], P = SCAL[(u0 + cidx) * 4 + 1];
            const float Mx = fmaxf(m, P), dec = fexp(m - Mx), ee = fexp(P - Mx);
            float* np = NL + (u0 + cidx) * 64 + d; const float nl = *np; *np = sn; sn = dec * sn + ee * nl;
            if (d == 0) SCAL[(u0 + cidx) * 4 + 2] = m;
            m = tot + Mx;
        }
    }
}

constexpr int C_Q = 0, C_K = C_Q + 64 * QSTR, C_V = C_K + 64 * QSTR, C_C = C_V + 64 * VSTR, C_H = C_C + 128 * CSTR, C_G = C_H + 64 * HSTR, C_N = C_G + 256, C_RED = C_N + 256, C_CWT = C_RED + 1024, C_GN = C_CWT + 2048, C_END = C_GN + 512;
struct CLoad { v4u q[4], k[4], v[2], ct[2]; float gi, gf, np, mprev; };
__device__ __forceinline__ void phaseC_issue(CLoad& L, const bf16* Z, const float* IF, const bf16* CT, const float* NL, const float* SCAL, int u, int tid, int lane) {
    const int h = (u >> 6) & 7, b = u >> 9, cc = u & 63; const size_t r0 = (size_t)b * SEQ + cc * 64;
    const int t = tid >> 3, ch8 = tid & 7;
#pragma unroll
    for (int j = 0; j < 4; ++j) { const int dt = (cc * 64 + t - 3 + j) < 0 ? 0 : (t - 3 + j); const bf16* zr = Z + (r0 + dt) * ZP + h * 64 + ch8 * 8; L.q[j] = *(const v4u*)(zr + 1536); L.k[j] = *(const v4u*)(zr + 2048); }
#pragma unroll
    for (int i = 0; i < 2; ++i) { const int idx = tid + 512 * i, tt = idx >> 4, chv = idx & 15; L.v[i] = *(const v4u*)(Z + (r0 + tt) * ZP + 2560 + h * 128 + chv * 8); }
#pragma unroll
    for (int i = 0; i < 2; ++i) { const int idx = tid + 512 * i, vv = idx >> 3, ch = idx & 7; L.ct[i] = *(const v4u*)(CT + ((size_t)u * 128 + vv) * 64 + ch * 8); }
    L.gi = IF[(r0 + lane) * 16 + h]; L.gf = IF[(r0 + lane) * 16 + 8 + h];
    L.np = NL[u * 64 + lane]; L.mprev = SCAL[u * 4 + 2];
}
__device__ __forceinline__ void phaseC_all(bf16* Z, const float* IF, const float* cw, const bf16* CT, const float* NL, const float* SCAL, const float* gn, int bx, LAS unsigned char* lds) {
    int tid_ = threadIdx.x; asm volatile("" : "+v"(tid_));
    const int tid = tid_, lane = tid & 63, wave = __builtin_amdgcn_readfirstlane(tid >> 6), c = lane & 31, hi = lane >> 5;
    const int h = (bx >> 3) & 7;
    load_cwt((LAS float*)(lds + C_CWT), cw, h, tid);
    if (tid < 128) *(LAS float*)(lds + C_GN + tid * 4) = gn[h * 128 + tid];
    CLoad L; phaseC_issue(L, Z, IF, CT, NL, SCAL, unit_of(bx, 0), tid, lane);
    __syncthreads();
#pragma unroll 1
    for (int i = 0; i < 8; ++i) {
        const int u = unit_of(bx, i), b = u >> 9, cc = u & 63; const size_t r0 = (size_t)b * SEQ + cc * 64;
        float cum, g, pm; gates(L.gi, L.gf, lane, cum, g, pm);
        const float m_prev = L.mprev;
        const float Mt = fmaxf(m_prev, pm), wint = fexp(m_prev - Mt), flo = fexp(-(cum + Mt));
        if (wave == 0) { *(LAS float*)(lds + C_G + lane * 4) = g; *(LAS float*)(lds + C_N + lane * 4) = L.np; }
        {   const int t = tid >> 3, ch8 = tid & 7, tp = cc * 64 + t; float f[8];
            const float m0 = tp - 3 >= 0 ? 1.f : 0.f, m1 = tp - 2 >= 0 ? 1.f : 0.f, m2 = tp - 1 >= 0 ? 1.f : 0.f;
            conv8(L.q, m0, m1, m2, (LAS const float*)(lds + C_CWT), ch8, f);
            *(LAS v4u*)(lds + C_Q + t * QSTR + ch8 * 16) = pack8(f);
            conv8(L.k, m0, m1, m2, (LAS const float*)(lds + C_CWT) + 256, ch8, f);
#pragma unroll
            for (int e = 0; e < 8; ++e) f[e] *= 0.125f;
            *(LAS v4u*)(lds + C_K + t * QSTR + ch8 * 16) = pack8(f);
        }
#pragma unroll
        for (int q = 0; q < 2; ++q) { const int idx = tid + 512 * q, tt = idx >> 4, chv = idx & 15; *(LAS v4u*)(lds + C_V + tt * VSTR + chv * 16) = L.v[q]; }
#pragma unroll
        for (int q = 0; q < 2; ++q) { const int idx = tid + 512 * q, vv = idx >> 3, ch = idx & 7; *(LAS v4u*)(lds + C_C + vv * CSTR + ch * 16) = L.ct[q]; }
        __syncthreads();
        v4u og[2];
#pragma unroll
        for (int q = 0; q < 2; ++q) { const int idx = tid + 512 * q; og[q] = *(const v4u*)(Z + (r0 + (idx >> 4)) * ZP + 3584 + h * 128 + (idx & 15) * 8); }
        if (i + 1 < 8) phaseC_issue(L, Z, IF, CT, NL, SCAL, unit_of(bx, i + 1), tid, lane);
        const int tb = wave >> 2, vb = wave & 3, g16 = (lane >> 4) & 1, q4 = (lane & 15) >> 2, p4 = lane & 3;
        const float Mt_c = __shfl(Mt, 32 * tb + c), wint_c = __shfl(wint, 32 * tb + c), flo_c = __shfl(flo, 32 * tb + c);
        bf16x8 qf[4];
#pragma unroll
        for (int ks = 0; ks < 4; ++ks) qf[ks] = *(LAS const bf16x8*)(lds + C_Q + (32 * tb + c) * QSTR + (16 * ks + 8 * hi) * 2);
        f32x16 X[2]; float dsum = 0.f;
#pragma unroll
        for (int j = 0; j < 2; ++j) {
            X[j] = (f32x16){};
            if (j <= tb) {
                LAS const unsigned char* kb = lds + C_K + (32 * j + c) * QSTR + hi * 16;
#pragma unroll
                for (int ks = 0; ks < 4; ++ks) X[j] = __builtin_amdgcn_mfma_f32_32x32x16_bf16(*(LAS const bf16x8*)(kb + ks * 32), qf[ks], X[j], 0, 0, 0);
#pragma unroll
                for (int r = 0; r < 16; ++r) {
                    const int s = 32 * j + (r & 3) + 8 * (r >> 2) + 4 * hi;
                    const float gs = *(LAS const float*)(lds + C_G + s * 4);
                    const float w = (s <= 32 * tb + c) ? fexp(gs - Mt_c) : 0.f;
                    X[j][r] *= w; dsum += X[j][r];
                }
            }
        }
        dsum += __shfl_xor(dsum, 32);
        float qn = 0.f;
        {   LAS const unsigned char* qr = lds + C_Q + (32 * tb + c) * QSTR + hi * 64; LAS const float* nr = (LAS const float*)(lds + C_N) + 32 * hi;
#pragma unroll
            for (int k4 = 0; k4 < 4; ++k4) { const v4u x = *(LAS const v4u*)(qr + k4 * 16);
                qn += bflo(x.x) * nr[8 * k4] + bfhi(x.x) * nr[8 * k4 + 1] + bflo(x.y) * nr[8 * k4 + 2] + bfhi(x.y) * nr[8 * k4 + 3] + bflo(x.z) * nr[8 * k4 + 4] + bfhi(x.z) * nr[8 * k4 + 5] + bflo(x.w) * nr[8 * k4 + 6] + bfhi(x.w) * nr[8 * k4 + 7]; }
        }
        qn += __shfl_xor(qn, 32);
        const float den = dsum + wint_c * qn, inv = __builtin_amdgcn_rcpf(fmaxf(fabsf(den), flo_c));
        f32x16 acc = {};
#pragma unroll
        for (int ks = 0; ks < 4; ++ks) acc = __builtin_amdgcn_mfma_f32_32x32x16_bf16(*(LAS const bf16x8*)(lds + C_C + (32 * vb + c) * CSTR + (16 * ks + 8 * hi) * 2), qf[ks], acc, 0, 0, 0);
#pragma unroll
        for (int r = 0; r < 16; ++r) acc[r] *= wint_c;
        LAS const unsigned char* va = lds + C_V + (4 * hi + q4) * VSTR + (32 * vb + 16 * g16 + 4 * p4) * 2;
#pragma unroll
        for (int j = 0; j < 2; ++j) {
            if (j <= tb) {
#pragma unroll
                for (int s2 = 0; s2 < 2; ++s2) {
                    const s16x4 a0 = tr_read(va + (32 * j + 16 * s2) * VSTR), a1 = tr_read(va + (32 * j + 16 * s2 + 8) * VSTR);
                    v4u w; w.x = pk_bf16(X[j][8 * s2], X[j][8 * s2 + 1]); w.y = pk_bf16(X[j][8 * s2 + 2], X[j][8 * s2 + 3]); w.z = pk_bf16(X[j][8 * s2 + 4], X[j][8 * s2 + 5]); w.w = pk_bf16(X[j][8 * s2 + 6], X[j][8 * s2 + 7]);
                    acc = __builtin_amdgcn_mfma_f32_32x32x16_bf16((bf16x8){a0[0], a0[1], a0[2], a0[3], a1[0], a1[1], a1[2], a1[3]}, __builtin_bit_cast(bf16x8, w), acc, 0, 0, 0);
                }
            }
        }
        float ss = 0.f;
#pragma unroll
        for (int r = 0; r < 16; ++r) { acc[r] *= inv; ss += acc[r] * acc[r]; }
        ss += __shfl_xor(ss, 32);
        if (hi == 0) *(LAS float*)(lds + C_RED + (vb * 64 + 32 * tb + c) * 4) = ss;
#pragma unroll
        for (int gq = 0; gq < 4; ++gq) *(LAS f32x4*)(lds + C_H + (32 * tb + c) * HSTR + (32 * vb + 8 * gq + 4 * hi) * 4) = (f32x4){acc[4 * gq], acc[4 * gq + 1], acc[4 * gq + 2], acc[4 * gq + 3]};
        __syncthreads();
#pragma unroll
        for (int q = 0; q < 2; ++q) {
            const int idx = tid + 512 * q, t = idx >> 4, ch = idx & 15; const v4u o = og[q];
            const f32x4 gn0 = *(LAS const f32x4*)(lds + C_GN + ch * 32), gn1 = *(LAS const f32x4*)(lds + C_GN + ch * 32 + 16);
            LAS const float* red = (LAS const float*)(lds + C_RED);
            const float tot = (red[t] + red[64 + t]) + (red[128 + t] + red[192 + t]);
            const float rs = __builtin_amdgcn_rsqf(tot * (1.0f / 128.0f) + 1e-6f);
            const f32x4 h0 = *(LAS const f32x4*)(lds + C_H + t * HSTR + ch * 32), h1 = *(LAS const f32x4*)(lds + C_H + t * HSTR + ch * 32 + 16);
            float f[8];
            f[0] = pg8::fast_sigmoid(bflo(o.x)) * h0[0] * rs * gn0[0]; f[1] = pg8::fast_sigmoid(bfhi(o.x)) * h0[1] * rs * gn0[1];
            f[2] = pg8::fast_sigmoid(bflo(o.y)) * h0[2] * rs * gn0[2]; f[3] = pg8::fast_sigmoid(bfhi(o.y)) * h0[3] * rs * gn0[3];
            f[4] = pg8::fast_sigmoid(bflo(o.z)) * h1[0] * rs * gn1[0]; f[5] = pg8::fast_sigmoid(bfhi(o.z)) * h1[1] * rs * gn1[1];
            f[6] = pg8::fast_sigmoid(bflo(o.w)) * h1[2] * rs * gn1[2]; f[7] = pg8::fast_sigmoid(bfhi(o.w)) * h1[3] * rs * gn1[3];
            *(v4u*)(Z + (r0 + t) * ZP + 2560 + h * 128 + ch * 8) = pack8(f);
        }
        __syncthreads();
    }
}
}

struct Args { const float* in[19]; float* out; unsigned char* ws; int ph_lo, ph_hi, use_bar, pad; };

__global__ void __launch_bounds__(NWAVES * 64, 2) mk_fwd(Args args) {
    extern __shared__ __attribute__((aligned(16))) unsigned char lds_raw[];
    LAS unsigned char* lds = (LAS unsigned char*)lds_raw;
    volatile LAS unsigned* MISC = (volatile LAS unsigned*)(lds + MISC_OFF);
    const int tid = threadIdx.x, lane = tid & 63, wave = __builtin_amdgcn_readfirstlane(tid >> 6);
    const int G = gridDim.x, bx = blockIdx.x, vcu = (G % 8 == 0) ? (bx % 8) * (G / 8) + bx / 8 : bx;
    unsigned char* ws = args.ws;
    gu32* ctl = (gu32*)(ws + WS_CTL);
    float* SSQ = (float*)(ws + WS_CTL + CTL_SSQ);
    const float* x = args.in[0];
    bf16 *WGU1 = (bf16*)(ws + WS_WGU1), *WD1 = (bf16*)(ws + WS_WD1), *WIN = (bf16*)(ws + WS_WIN), *WG = (bf16*)(ws + WS_WG), *WPROJ = (bf16*)(ws + WS_WPROJ),
         *WOUT = (bf16*)(ws + WS_WOUT), *WGU2 = (bf16*)(ws + WS_WGU2), *WD2 = (bf16*)(ws + WS_WD2);
    bf16 *XB = (bf16*)(ws + WS_XB), *BIG = (bf16*)(ws + WS_BIG);
    float *BIN = (float*)(ws + WS_BIN), *BG = (float*)(ws + WS_BG), *IFB = (float*)(ws + WS_IF);
    bf16* MG = (bf16*)(ws + WS_ST);
    float *NLB = (float*)(ws + WS_IF + 1 * MiB), *SCB = (float*)(ws + WS_IF + 1 * MiB + 524288);
    for (int u = tid; u < (LDS_BYTES - LDSCTL_OFF) / 4; u += NWAVES * 64) ((LAS unsigned*)(lds + LDSCTL_OFF))[u] = 0u;
    __syncthreads();
    XcdBarrier bar; bar.bar = (unsigned*)(ctl + CW_BAR); bar.x = 0; bar.st = nullptr;
    if (args.use_bar) bar = xcd_barrier_post((unsigned*)(ctl + CW_BAR), MISC + 8);
    const int lo = args.ph_lo, hi = args.ph_hi;
#define IN(k) (lo <= (k) && (k) < hi)
#define SEAM(k) do { if (IN(k) && IN((k) + 1)) xcd_barrier(bar); } while (0)

    if (IN(0)) {
        LAS float* scr = (LAS float*)(lds + RING_OFF + wave * 16384);
        const int gw = vcu * NWAVES + wave, NGW = G * NWAVES;
        constexpr int I_GU = 16 * (FF / 32), I_D = (FF / 64) * 32, I_WIN = 16 * ((INW + 31) / 32), I_SQ = 16 * 32;
        constexpr int NITEMS = 4 * I_GU + 2 * I_D + I_WIN + 3 * I_SQ;
        for (int it = gw; it < NITEMS; it += NGW) {
            int r = it;
            if (r < I_GU) { transpose_item(args.in[2], FF, args.in[1], scr, r, lane, RmGate{WGU1}); continue; } r -= I_GU;
            if (r < I_GU) { transpose_item(args.in[3], FF, args.in[1], scr, r, lane, RmUp{WGU1}); continue; } r -= I_GU;
            if (r < I_D) { transpose_item(args.in[4], DM, nullptr, scr, r, lane, RmLin{WD1, FF, 0}); continue; } r -= I_D;
            if (r < I_WIN) { transpose_item(args.in[6], INW, args.in[5], scr, r, lane, RmWin{WIN, WG}); continue; } r -= I_WIN;
            if (r < I_SQ) { transpose_item(args.in[11], DM, nullptr, scr, r, lane, RmLin{WPROJ, 2048, 0}); continue; } r -= I_SQ;
            if (r < I_SQ) { transpose_item(args.in[12], DM, nullptr, scr, r, lane, RmLin{WPROJ, 2048, 1024}); continue; } r -= I_SQ;
            if (r < I_SQ) { transpose_item(args.in[13], DM, nullptr, scr, r, lane, RmLin{WOUT, 1024, 0}); continue; } r -= I_SQ;
            if (r < I_GU) { transpose_item(args.in[15], FF, args.in[14], scr, r, lane, RmGate{WGU2}); continue; } r -= I_GU;
            if (r < I_GU) { transpose_item(args.in[16], FF, args.in[14], scr, r, lane, RmUp{WGU2}); continue; } r -= I_GU;
            transpose_item(args.in[17], DM, nullptr, scr, r, lane, RmLin{WD2, FF, 0});
        }
        { const int gt = vcu * (NWAVES * 64) + tid, NGT = G * NWAVES * 64;
          GAS v4u* z = (GAS v4u*)(WIN + (size_t)NZREAL * 1024);
          for (int i = gt; i < (NWIN - NZREAL) * 1024 * 2 / 16; i += NGT) z[i] = (v4u){0u, 0u, 0u, 0u};
          for (int i = gt; i < NWIN; i += NGT) BIN[i] = i < NZREAL ? args.in[7][i] : 0.f;
          for (int i = gt; i < 2048; i += NGT) BG[i] = args.in[7][NZREAL + i]; }
        for (int m = gw; m < M; m += NGW) {
            const GAS f32x4* xr = (const GAS f32x4*)(x + (size_t)m * DM) + lane;
            f32x4 v[4]; float s = 0.f;
#pragma unroll
            for (int j = 0; j < 4; ++j) { v[j] = xr[64 * j]; s += (v[j].x * v[j].x + v[j].y * v[j].y) + (v[j].z * v[j].z + v[j].w * v[j].w); }
            s = wave_sum(s);
            GAS v2u* o8 = (GAS v2u*)(XB + (size_t)m * DM) + lane;
#pragma unroll
            for (int j = 0; j < 4; ++j) o8[64 * j] = (v2u){pk2(v[j].x, v[j].y), pk2(v[j].z, v[j].w)};
            if (lane == 0) SSQ[m] = s;
        }
        SEAM(0);
    }
    if (IN(1)) {
        pg8::Gemm g{XB, XB, WGU1, 1024, 1024, 1024, 1 << 30}; pg8::StaticOrder S; S.init(M, NGU, G, bx);
        pg8::EpiSwiglu E{BIG, FF, SSQ};
        pg8::gemm_phase<pg8::EpiSwiglu, pg8::StaticOrder, true, true>(lds + RING_OFF, g, S, E);
        SEAM(1);
    }
    if (IN(2)) {
        pg8::Gemm g{BIG, BIG, WD1, FF, FF, FF, 1 << 30}; pg8::StaticOrder S; S.init(M, DM, G, bx);
        pg8::EpiRes E{x, args.out, XB, SSQ + M, 0.5f};
        pg8::gemm_phase<pg8::EpiRes, pg8::StaticOrder, true, true>(lds + RING_OFF, g, S, E);
        SEAM(2);
    }

    if (IN(3)) {
        pg8::Gemm g{XB, XB, WIN, 1024, 1024, 1024, 1 << 30}; pg8::StaticOrder S; S.init(M, NWIN, G, bx);
        pg8::EpiWin E{BIG, ZP, IFB, BIN, SSQ + M};
        pg8::gemm_phase<pg8::EpiWin, pg8::StaticOrder, true, true>(lds + RING_OFF, g, S, E);
        SEAM(3);
    }

    if (IN(4)) {
        for (int u = bx; u < BATCH * 4 * 32; u += G) att::attn_unit(BIG, args.in[8], u >> 7, (u >> 5) & 3, u & 31, lds + RING_OFF);
        for (int v = bx; v < 256; v += G) ml::phaseA_all(BIG, IFB, args.in[9], MG, NLB, SCB, v, lds + RING_OFF);
        SEAM(4);
    }
    if (IN(5)) {
        for (int v = bx; v < 256; v += G) ml::scan_phase(MG, NLB, SCB, v, tid);
        SEAM(5);
    }
    if (IN(6)) {
        for (int v = bx; v < 256; v += G) ml::phaseC_all(BIG, IFB, args.in[9], MG, NLB, SCB, args.in[10], v, lds + RING_OFF);
        SEAM(6);
    }
    if (IN(7)) {
        pg8::Gemm g{XB, XB, WG, 1024, 1024, 1024, 1 << 30}; pg8::StaticOrder S; S.init(M, 2048, G, bx);
        pg8::EpiGate E{BIG, ZP, 1536, 3584, BG, SSQ + M};
        pg8::gemm_phase<pg8::EpiGate, pg8::StaticOrder, true, true>(lds + RING_OFF, g, S, E);
        SEAM(7);
    }
    if (IN(8)) {
        pg8::Gemm g{BIG, BIG + 2560 - 1024, WPROJ, ZP, 2048, 2048, 16}; pg8::StaticOrder S; S.init(M, DM, G, bx);
        pg8::EpiProj E{BIG, ZP, 1536, 3584, MG};
        pg8::gemm_phase<pg8::EpiProj, pg8::StaticOrder, true, true>(lds + RING_OFF, g, S, E);
        SEAM(8);
    }
    if (IN(9)) {
        pg8::Gemm g{MG, MG, WOUT, 1024, 1024, 1024, 1 << 30}; pg8::StaticOrder S; S.init(M, DM, G, bx);
        pg8::EpiRes E{args.out, args.out, XB, SSQ + 2 * M, 1.0f};
        pg8::gemm_phase<pg8::EpiRes, pg8::StaticOrder, true, true>(lds + RING_OFF, g, S, E);
        SEAM(9);
    }
    if (IN(10)) {
        pg8::Gemm g{XB, XB, WGU2, 1024, 1024, 1024, 1 << 30}; pg8::StaticOrder S; S.init(M, NGU, G, bx);
        pg8::EpiSwiglu E{BIG, FF, SSQ + 2 * M};
        pg8::gemm_phase<pg8::EpiSwiglu, pg8::StaticOrder, true, true>(lds + RING_OFF, g, S, E);
        SEAM(10);
    }
    if (IN(11)) {
        pg8::Gemm g{BIG, BIG, WD2, FF, FF, FF, 1 << 30}; pg8::StaticOrder S; S.init(M, DM, G, bx);
        pg8::EpiRes E{args.out, args.out, nullptr, SSQ + 3 * M, 0.5f};
        pg8::gemm_phase<pg8::EpiRes, pg8::StaticOrder, true, true>(lds + RING_OFF, g, S, E);
        SEAM(11);
    }
    if (IN(12)) {
        const int gw = vcu * NWAVES + wave, NGW = G * NWAVES; const float* gf = args.in[18];
        for (int m = gw; m < M; m += NGW) {
            GAS f32x4* xr = (GAS f32x4*)(args.out + (size_t)m * DM) + lane;
            const float rs = pg8::rstd_of(SSQ[3 * M + m]);
#pragma unroll
            for (int j = 0; j < 4; ++j) { const f32x4 gv = *((const f32x4*)gf + lane + 64 * j); f32x4 v = xr[64 * j]; xr[64 * j] = v * rs * gv; }
        }
    }
#undef IN
#undef SEAM
}

extern "C" void kernel_launch(void* const* d_in, const int* in_sizes, int n_in, void* d_out, int out_size, void* d_ws, size_t ws_size, hipStream_t stream) {
    static int grid = 0;
    if (grid == 0) {
        int dev = 0, cus = 0, per_cu = 0;
        if (n_in != 19 || out_size != M * DM || ws_size < WS_END) { fprintf(stderr, "kernel_launch: unexpected problem shape (n_in %d out %d ws %zu)\n", n_in, out_size, ws_size); grid = -1; return; }
        if (hipGetDevice(&dev) != hipSuccess || hipDeviceGetAttribute(&cus, hipDeviceAttributeMultiprocessorCount, dev) != hipSuccess) { grid = -1; return; }
        if (hipFuncSetAttribute((const void*)mk_fwd, hipFuncAttributeMaxDynamicSharedMemorySize, LDS_BYTES) != hipSuccess) { fprintf(stderr, "kernel_launch: hipFuncSetAttribute failed\n"); grid = -1; return; }
        if (hipOccupancyMaxActiveBlocksPerMultiprocessor(&per_cu, (const void*)mk_fwd, NWAVES * 64, LDS_BYTES) != hipSuccess || per_cu < 1) { fprintf(stderr, "kernel_launch: occupancy query says %d blocks per CU\n", per_cu); grid = -1; return; }
        (void)hipGetLastError();
        grid = cus;
    }
    if (grid < 0) return;
    (void)hipMemsetAsync((char*)d_ws + WS_CTL, 0, CTL_ZERO_BYTES, stream);
    Args a{};
    for (int i = 0; i < 19; ++i) a.in[i] = (const float*)d_in[i];
    a.out = (float*)d_out; a.ws = (unsigned char*)d_ws; a.use_bar = 1; a.ph_lo = 0; a.ph_hi = 13;
    hipLaunchKernelGGL(mk_fwd, dim3(grid), dim3(NWAVES * 64), LDS_BYTES, stream, a);
}
```

```cpp
#include <hip/hip_runtime.h>
#include <cstdio>
#include <cstdint>
namespace pg8 {
#define PG8_LAS __attribute__((address_space(3)))
typedef unsigned short bf16_t;
typedef short bf16x8 __attribute__((ext_vector_type(8)));
typedef float f32x4 __attribute__((ext_vector_type(4)));
typedef unsigned u32x4 __attribute__((ext_vector_type(4)));
typedef unsigned u32x2 __attribute__((ext_vector_type(2)));
constexpr int BM = 256, BK = 64, HALF = 128, HTB = HALF * BK * 2  , STAGE_BYTES = 8 * HTB, NXCD = 8, WGM = 8;
constexpr float RMS_EPS = 1e-6f;

__host__ __device__ __forceinline__ int lds_byte(int r, int c) { const int st = (r >> 4) * 2 + (c >> 5), rr = r & 15, cc = c & 31, ob = rr * 64 + cc * 2; return st * 1024 + (ob ^ (((ob >> 9) & 1) << 5)); }
__host__ __device__ __forceinline__ void stage_rc(int b, int& R, int& C) { const int st = b / 1024, sb = b % 1024, swz = sb ^ (((sb >> 9) & 1) << 5); R = (st >> 1) * 16 + swz / 64; C = (st & 1) * 32 + (swz % 64) / 2; }
__host__ __device__ __forceinline__ int perm32(int rho) { const int n = rho >> 4, i = rho & 15; return 8 * (i >> 2) + 4 * n + (i & 3); }

struct Unit { int pm, pn; };
struct Gemm { const bf16_t* A; const bf16_t* A2; const bf16_t* Bt; int lda, ldb, K, ksplit; };

struct StaticOrder {
    int nM, nN, nwg, G, c;
    __host__ __device__ void init(int M, int N, int G_, int c_) { nM = M / BM; nN = N / BM; nwg = nM * nN; G = G_; c = c_; }
    __host__ __device__ bool next(int i, Unit& u) const {
        const long L = (long)i * G + c; if (L >= nwg) return false;
        int wgid = (int)L; { const int q = nwg / NXCD, r = nwg % NXCD, xcd = wgid % NXCD, off = wgid / NXCD; wgid = (xcd < r ? xcd * (q + 1) : r * (q + 1) + (xcd - r) * q) + off; }
        const int nig = WGM * nN, gid = wgid / nig, fm = gid * WGM, gsz = (nM - fm) < WGM ? (nM - fm) : WGM;
        u.pm = fm + ((wgid % nig) % gsz); u.pn = (wgid % nig) / gsz; return true;
    }
    __device__ __forceinline__ void a_ready(const Unit&) const {}
    __device__ __forceinline__ void done(const Unit&) const {}
};

typedef float f32x2_t __attribute__((ext_vector_type(2))); typedef __bf16 bf16x2_t __attribute__((ext_vector_type(2)));
__device__ __forceinline__ unsigned cvt_pk_bf16(float lo, float hi) { f32x2_t v = {lo, hi}; bf16x2_t b = __builtin_convertvector(v, bf16x2_t); return __builtin_bit_cast(unsigned, b); }
__device__ __forceinline__ float fast_sigmoid(float x) { return __builtin_amdgcn_rcpf(1.0f + __builtin_amdgcn_exp2f(-1.4426950408889634f * x)); }
__device__ __forceinline__ float rstd_of(float ssq) { return __builtin_amdgcn_rsqf(ssq * (1.0f / 1024.0f) + RMS_EPS); }

struct EpiSwiglu {
    static constexpr bool PERM = true, HAS_MID = false;
    bf16_t* O; int ldo; const float* ssq;
    __device__ __forceinline__ void operator()(const f32x4 (&acc)[2][2][4][2], const Unit& u, int wr, int wc, int fr, int fq) const {
        const int row0 = u.pm * BM + wr * 64 + fr, col0 = u.pn * HALF + wc * 32 + 8 * fq;
#pragma unroll
        for (int ai = 0; ai < 2; ++ai)
#pragma unroll
            for (int m = 0; m < 4; ++m) {
                const int r = row0 + ai * HALF + m * 16; const float rs = rstd_of(ssq[r]);
                float o[8];
#pragma unroll
                for (int n = 0; n < 2; ++n)
#pragma unroll
                    for (int j = 0; j < 4; ++j) { const float gv = acc[ai][0][m][n][j] * rs, uv = acc[ai][1][m][n][j] * rs; o[4 * n + j] = gv * fast_sigmoid(gv) * uv; }
                u32x4 w; w.x = cvt_pk_bf16(o[0], o[1]); w.y = cvt_pk_bf16(o[2], o[3]); w.z = cvt_pk_bf16(o[4], o[5]); w.w = cvt_pk_bf16(o[6], o[7]);
                *(u32x4*)(O + (size_t)r * ldo + col0) = w;
            }
    }
};
struct EpiRes {
    static constexpr bool PERM = false, HAS_MID = false;
    const float* R; float* X; bf16_t* Xb; float* ssq; float alpha;
    __device__ __forceinline__ void operator()(const f32x4 (&acc)[2][2][4][2], const Unit& u, int wr, int wc, int fr, int fq) const {
        const int row0 = u.pm * BM + wr * 64 + fr, col0 = u.pn * BM + wc * 32 + 4 * fq;
#pragma unroll
        for (int ai = 0; ai < 2; ++ai)
#pragma unroll
            for (int m = 0; m < 4; ++m) {
                const int r = row0 + ai * HALF + m * 16; float sq = 0.f;
#pragma unroll
                for (int bj = 0; bj < 2; ++bj)
#pragma unroll
                    for (int n = 0; n < 2; ++n) {
                        const size_t off = (size_t)r * 1024 + col0 + bj * HALF + n * 16;
                        const f32x4 x = *(const f32x4*)(R + off) + acc[ai][bj][m][n] * alpha;
                        *(f32x4*)(X + off) = x; sq += (x[0] * x[0] + x[1] * x[1]) + (x[2] * x[2] + x[3] * x[3]);
                        if (Xb) { u32x2 w; w.x = cvt_pk_bf16(x[0], x[1]); w.y = cvt_pk_bf16(x[2], x[3]); *(u32x2*)(Xb + off) = w; }
                    }
                sq += __shfl_xor(sq, 16); sq += __shfl_xor(sq, 32);
                if (fq == 0) atomicAdd(ssq + r, sq);
            }
    }
};
struct EpiWin {
    static constexpr bool PERM = true, HAS_MID = false;
    bf16_t* Z; int ldz; float* IF; const float* bias; const float* ssq;
    __device__ __forceinline__ void operator()(const f32x4 (&acc)[2][2][4][2], const Unit& u, int wr, int wc, int fr, int fq) const {
        const int row0 = u.pm * BM + wr * 64 + fr, cw = wc * 32 + 8 * fq;
        const bool ztile = u.pn < 18;
#pragma unroll
        for (int ai = 0; ai < 2; ++ai)
#pragma unroll
            for (int m = 0; m < 4; ++m) {
                const int r = row0 + ai * HALF + m * 16; const float rs = rstd_of(ssq[r]);
#pragma unroll
                for (int bj = 0; bj < 2; ++bj) {
                    const int c = u.pn * BM + bj * HALF + cw;
                    const f32x4 v0 = acc[ai][bj][m][0] * rs + *(const f32x4*)(bias + c), v1 = acc[ai][bj][m][1] * rs + *(const f32x4*)(bias + c + 4);
                    if (ztile) { u32x4 w; w.x = cvt_pk_bf16(v0[0], v0[1]); w.y = cvt_pk_bf16(v0[2], v0[3]); w.z = cvt_pk_bf16(v1[0], v1[1]); w.w = cvt_pk_bf16(v1[2], v1[3]);
                        *(u32x4*)(Z + (size_t)r * ldz + c) = w; }
                    else if (bj == 0 && cw < 16) { *(f32x4*)(IF + (size_t)r * 16 + cw) = v0; *(f32x4*)(IF + (size_t)r * 16 + cw + 4) = v1; }
                }
            }
    }
};
struct EpiGate {
    static constexpr bool PERM = true, HAS_MID = false;
    bf16_t* Z; int ldz, off0, off1; const float* bias; const float* ssq;
    __device__ __forceinline__ void operator()(const f32x4 (&acc)[2][2][4][2], const Unit& u, int wr, int wc, int fr, int fq) const {
        const int row0 = u.pm * BM + wr * 64 + fr, cw = wc * 32 + 8 * fq;
        const int cdst0 = (u.pn < 4 ? off0 : off1) + (u.pn & 3) * BM;
#pragma unroll
        for (int ai = 0; ai < 2; ++ai)
#pragma unroll
            for (int m = 0; m < 4; ++m) {
                const int r = row0 + ai * HALF + m * 16; const float rs = rstd_of(ssq[r]);
#pragma unroll
                for (int bj = 0; bj < 2; ++bj) {
                    const int c = u.pn * BM + bj * HALF + cw;
                    const f32x4 v0 = acc[ai][bj][m][0] * rs + *(const f32x4*)(bias + c), v1 = acc[ai][bj][m][1] * rs + *(const f32x4*)(bias + c + 4);
                    u32x4 w; w.x = cvt_pk_bf16(fast_sigmoid(v0[0]), fast_sigmoid(v0[1])); w.y = cvt_pk_bf16(fast_sigmoid(v0[2]), fast_sigmoid(v0[3]));
                    w.z = cvt_pk_bf16(fast_sigmoid(v1[0]), fast_sigmoid(v1[1])); w.w = cvt_pk_bf16(fast_sigmoid(v1[2]), fast_sigmoid(v1[3]));
                    *(u32x4*)(Z + (size_t)r * ldz + cdst0 + bj * HALF + cw) = w;
                }
            }
    }
};
struct EpiProj {
    static constexpr bool PERM = true, HAS_MID = true;
    const bf16_t* Z; int ldz, off0, off1; bf16_t* O;
    __device__ __forceinline__ static float bfl(unsigned w) { return __builtin_bit_cast(float, w << 16); }
    __device__ __forceinline__ static float bfh(unsigned w) { return __builtin_bit_cast(float, w & 0xffff0000u); }
    __device__ __forceinline__ void mid(f32x4 (&acc)[2][2][4][2], const Unit& u, int wr, int wc, int fr, int fq) const {
        unsigned base = (unsigned)((u.pm * BM + wr * 64 + fr) * ldz + u.pn * BM + wc * 32 + 8 * fq) * 2u; asm volatile("" : "+v"(base));
        const char* zb = (const char*)Z;
#pragma unroll
        for (int ai = 0; ai < 2; ++ai)
#pragma unroll
            for (int m = 0; m < 4; ++m) {
#pragma unroll
                for (int bj = 0; bj < 2; ++bj) {
                    const unsigned o = base + (unsigned)(((ai * HALF + m * 16) * ldz + bj * HALF) * 2);
                    const u32x4 a = *(const u32x4*)(zb + o + (unsigned)(off0 * 2)), b = *(const u32x4*)(zb + o + (unsigned)(off1 * 2));
#pragma unroll
                    for (int q = 0; q < 4; ++q) {
                        const float rl = bfl(a[q]) * __builtin_amdgcn_rcpf(fmaxf(bfl(b[q]), 1e-30f)), rh = bfh(a[q]) * __builtin_amdgcn_rcpf(fmaxf(bfh(b[q]), 1e-30f));
                        acc[ai][bj][m][q >> 1][(q & 1) * 2] *= rl; acc[ai][bj][m][q >> 1][(q & 1) * 2 + 1] *= rh;
                    }
                    asm volatile("" ::: "memory");
                }
            }
    }
    __device__ __forceinline__ void operator()(const f32x4 (&acc)[2][2][4][2], const Unit& u, int wr, int wc, int fr, int fq) const {
        const int row0 = u.pm * BM + wr * 64 + fr, cw = wc * 32 + 8 * fq;
#pragma unroll
        for (int ai = 0; ai < 2; ++ai)
#pragma unroll
            for (int m = 0; m < 4; ++m) {
                const int r = row0 + ai * HALF + m * 16;
#pragma unroll
                for (int bj = 0; bj < 2; ++bj) {
                    const int c = u.pn * BM + bj * HALF + cw;
                    const u32x4 b = *(const u32x4*)(Z + (size_t)r * ldz + off1 + c);
                    u32x4 w;
#pragma unroll
                    for (int q = 0; q < 4; ++q) w[q] = cvt_pk_bf16(acc[ai][bj][m][q >> 1][(q & 1) * 2] * fmaxf(bfl(b[q]), 1e-30f), acc[ai][bj][m][q >> 1][(q & 1) * 2 + 1] * fmaxf(bfh(b[q]), 1e-30f));
                    *(u32x4*)(O + (size_t)r * 1024 + c) = w;
                    asm volatile("" ::: "memory");
                }
            }
    }
};
template <class Epi, class Sched, bool ALIGN_EPI = false, bool SP2 = false>
__device__ __forceinline__ void gemm_phase(PG8_LAS unsigned char* lds, const Gemm g, const Sched& S, const Epi& E) {
    const int tid = threadIdx.x, wid = __builtin_amdgcn_readfirstlane(tid >> 6), lane = tid & 63, wr = wid >> 2, wc = wid & 3, fr = lane & 15, fq = lane >> 4;
    const int K = g.K, nt = K / BK;
    unsigned voffA[2], voffB[2];
#pragma unroll
    for (int i = 0; i < 2; ++i) { int R, C; stage_rc(tid * 16 + i * 8192, R, C); const int Rb = Epi::PERM ? ((R & ~31) + perm32(R & 31)) : R;
        voffA[i] = (unsigned)(R * g.lda + C) * 2u; voffB[i] = (unsigned)(Rb * g.ldb + C) * 2u; }
    const size_t kstep = (size_t)(BK * 2);
    const size_t hstepA = (size_t)HALF * g.lda * 2, hstepB = (size_t)HALF * g.ldb * 2;
    const size_t tstepA = 2 * hstepA, tstepB = 2 * hstepB;
    const unsigned ldsw = (unsigned)wid * 1024u;
    const int aoff = lds_byte(wr * 64 + fr, fq * 8), boff = lds_byte(wc * 32 + fr, fq * 8);
#define PG8_SA(b, h) (((b) * 2 + (h)) * HTB)
#define PG8_SB(b, h) ((4 + (b) * 2 + (h)) * HTB)
#define PG8_STAGE(bufoff, gbase, voff) do { _Pragma("unroll") for (int _i = 0; _i < 2; ++_i) \
        __builtin_amdgcn_global_load_lds((const unsigned*)((const char*)(gbase) + (voff)[_i]), (PG8_LAS unsigned*)(lds + (bufoff) + ldsw + _i * 8192), 16, 0, 0); } while (0)
#define PG8_LDA(dst, b, h) do { _Pragma("unroll") for (int m = 0; m < 4; ++m) _Pragma("unroll") for (int k = 0; k < 2; ++k) dst[m][k] = *(const PG8_LAS bf16x8*)(lds + PG8_SA(b, h) + aoff + m * 2048 + k * 1024); } while (0)
#define PG8_LDB(dst, b, h) do { _Pragma("unroll") for (int n = 0; n < 2; ++n) _Pragma("unroll") for (int k = 0; k < 2; ++k) dst[n][k] = *(const PG8_LAS bf16x8*)(lds + PG8_SB(b, h) + boff + n * 2048 + k * 1024); } while (0)
#define PG8_MMA(ai, bj, At, Bt) do { __builtin_amdgcn_s_setprio(1); _Pragma("unroll") for (int m = 0; m < 4; ++m) _Pragma("unroll") for (int n = 0; n < 2; ++n) _Pragma("unroll") for (int k = 0; k < 2; ++k) \
        acc[ai][bj][m][n] = __builtin_amdgcn_mfma_f32_16x16x32_bf16(Bt[n][k], At[m][k], acc[ai][bj][m][n], 0, 0, 0); __builtin_amdgcn_s_setprio(0); } while (0)
#define PG8_WAIT_V(n) asm volatile("s_waitcnt vmcnt(" #n ")" ::: "memory")
#define PG8_WAIT_L(n) asm volatile("s_waitcnt lgkmcnt(" #n ")" ::: "memory")
#define PG8_BAR __builtin_amdgcn_s_barrier()
#define PG8_SCHED __builtin_amdgcn_sched_barrier(0)
    Unit cur, nxt; int ui = 0;
    if (!S.next(0, cur)) return;
    f32x4 acc[2][2][4][2];
#pragma unroll
    for (int a = 0; a < 2; ++a)
#pragma unroll
        for (int b = 0; b < 2; ++b)
#pragma unroll
            for (int m = 0; m < 4; ++m)
#pragma unroll
                for (int n = 0; n < 2; ++n) acc[a][b][m][n] = (f32x4){0.f, 0.f, 0.f, 0.f};
    bf16x8 At[4][2], B0[2][2], B1[2][2];
    const char* cA = (const char*)g.A + (size_t)cur.pm * tstepA; const char* cA2 = (const char*)g.A2 + (size_t)cur.pm * tstepA; const char* cB = (const char*)g.Bt + (size_t)cur.pn * tstepB;
    S.a_ready(cur);
    if constexpr (SP2) {
        PG8_STAGE(PG8_SB(0, 0), cB, voffB); PG8_STAGE(PG8_SB(0, 1), cB + hstepB, voffB); PG8_STAGE(PG8_SA(0, 0), cA, voffA); PG8_STAGE(PG8_SA(0, 1), cA + hstepA, voffA);
        if (wr == 1) PG8_BAR;
        PG8_WAIT_V(2); PG8_BAR;
        PG8_STAGE(PG8_SB(1, 0), cB + kstep, voffB); PG8_STAGE(PG8_SA(1, 0), cA + kstep, voffA); PG8_STAGE(PG8_SB(1, 1), cB + hstepB + kstep, voffB);
        PG8_WAIT_V(6); PG8_BAR;
    } else {
        PG8_STAGE(PG8_SB(0, 0), cB, voffB); PG8_STAGE(PG8_SA(0, 0), cA, voffA); PG8_STAGE(PG8_SB(0, 1), cB + hstepB, voffB); PG8_STAGE(PG8_SA(0, 1), cA + hstepA, voffA);
        if (wr == 1) PG8_BAR;
        PG8_WAIT_V(4); PG8_BAR;
        PG8_STAGE(PG8_SB(1, 0), cB + kstep, voffB); PG8_STAGE(PG8_SA(1, 0), cA + kstep, voffA); PG8_STAGE(PG8_SB(1, 1), cB + hstepB + kstep, voffB);
        PG8_WAIT_V(6); PG8_BAR;
    }
    for (;;) {
        const bool has_next = S.next(ui + 1, nxt);
        const char* nA = has_next ? (const char*)g.A + (size_t)nxt.pm * tstepA : cA; const char* nA2 = has_next ? (const char*)g.A2 + (size_t)nxt.pm * tstepA : cA2; const char* nB = has_next ? (const char*)g.Bt + (size_t)nxt.pn * tstepB : cB;
        for (int t = 0; t < nt; t += 2) {
            const bool last = (t == nt - 2);
            if constexpr (Epi::HAS_MID) { if (t == g.ksplit) E.mid(acc, cur, wr, wc, fr, fq); }
            const char* a1 = ((t + 1) < g.ksplit ? cA : cA2) + (size_t)(t + 1) * kstep;
            const char* a2 = last ? nA : ((t + 2) < g.ksplit ? cA : cA2) + (size_t)(t + 2) * kstep; const char* b2 = last ? nB : cB + (size_t)(t + 2) * kstep;
            const char* a3 = a2 + kstep; const char* b3 = b2 + kstep;
            if (last && has_next) S.a_ready(nxt);
            if constexpr (SP2) {
            PG8_LDB(B0, 0, 0); PG8_LDB(B1, 0, 1); PG8_SCHED; PG8_LDA(At, 0, 0); PG8_STAGE(PG8_SA(1, 1), a1 + hstepA, voffA);
            PG8_WAIT_V(8); PG8_WAIT_L(0); PG8_BAR; PG8_MMA(0, 0, At, B0); PG8_MMA(0, 1, At, B1); PG8_BAR; PG8_SCHED;
            PG8_LDA(At, 0, 1); PG8_STAGE(PG8_SB(0, 0), b2, voffB); PG8_STAGE(PG8_SB(0, 1), b2 + hstepB, voffB); PG8_STAGE(PG8_SA(0, 0), a2, voffA);
            PG8_WAIT_V(8); PG8_WAIT_L(0); PG8_BAR; PG8_MMA(1, 0, At, B0); PG8_MMA(1, 1, At, B1); PG8_BAR; PG8_SCHED;
            PG8_LDB(B0, 1, 0); PG8_LDB(B1, 1, 1); PG8_SCHED; PG8_LDA(At, 1, 0); PG8_STAGE(PG8_SA(0, 1), a2 + hstepA, voffA);
            PG8_WAIT_V(8); PG8_WAIT_L(0); PG8_BAR; PG8_MMA(0, 0, At, B0); PG8_MMA(0, 1, At, B1); PG8_BAR; PG8_SCHED;
            PG8_LDA(At, 1, 1); PG8_STAGE(PG8_SB(1, 0), b3, voffB); PG8_STAGE(PG8_SB(1, 1), b3 + hstepB, voffB); PG8_STAGE(PG8_SA(1, 0), a3, voffA);
            PG8_WAIT_V(8); PG8_WAIT_L(0); PG8_BAR; PG8_MMA(1, 0, At, B0); PG8_MMA(1, 1, At, B1); PG8_BAR; PG8_SCHED;
            } else {
            PG8_LDB(B0, 0, 0); PG8_SCHED; PG8_LDA(At, 0, 0); PG8_STAGE(PG8_SA(1, 1), a1 + hstepA, voffA);
            PG8_WAIT_L(8); PG8_BAR; PG8_WAIT_L(0); PG8_MMA(0, 0, At, B0); PG8_BAR; PG8_SCHED;
            PG8_LDB(B1, 0, 1); PG8_STAGE(PG8_SB(0, 0), b2, voffB);
            PG8_BAR; PG8_WAIT_L(0); PG8_MMA(0, 1, At, B1); PG8_BAR;
            PG8_LDA(At, 0, 1); PG8_STAGE(PG8_SA(0, 0), a2, voffA);
            PG8_BAR; PG8_WAIT_L(0); PG8_MMA(1, 0, At, B0); PG8_BAR; PG8_SCHED;
            PG8_STAGE(PG8_SB(0, 1), b2 + hstepB, voffB);
            PG8_WAIT_V(6); PG8_BAR; PG8_MMA(1, 1, At, B1); PG8_BAR;
            PG8_LDB(B0, 1, 0); PG8_SCHED; PG8_LDA(At, 1, 0); PG8_STAGE(PG8_SA(0, 1), a2 + hstepA, voffA);
            PG8_WAIT_L(8); PG8_BAR; PG8_WAIT_L(0); PG8_MMA(0, 0, At, B0); PG8_BAR; PG8_SCHED;
            PG8_LDB(B1, 1, 1); PG8_STAGE(PG8_SB(1, 0), b3, voffB);
            PG8_BAR; PG8_WAIT_L(0); PG8_MMA(0, 1, At, B1); PG8_BAR;
            PG8_LDA(At, 1, 1); PG8_STAGE(PG8_SA(1, 0), a3, voffA);
            PG8_BAR; PG8_WAIT_L(0); PG8_MMA(1, 0, At, B0); PG8_BAR; PG8_SCHED;
            PG8_STAGE(PG8_SB(1, 1), b3 + hstepB, voffB);
            PG8_WAIT_V(6); PG8_BAR; PG8_MMA(1, 1, At, B1); PG8_BAR;
            }
        }
        if constexpr (ALIGN_EPI) { if (wr == 0) PG8_BAR; }
        E(acc, cur, wr, wc, fr, fq); S.done(cur);
        if (!has_next) break;
#pragma unroll
        for (int a = 0; a < 2; ++a)
#pragma unroll
            for (int b = 0; b < 2; ++b)
#pragma unroll
                for (int m = 0; m < 4; ++m)
#pragma unroll
                    for (int n = 0; n < 2; ++n) acc[a][b][m][n] = (f32x4){0.f, 0.f, 0.f, 0.f};
        cur = nxt; cA = nA; cA2 = nA2; cB = nB; ++ui;
        if constexpr (ALIGN_EPI) { if (wr == 1) PG8_BAR; }
    }
    PG8_WAIT_V(0);
    if constexpr (!ALIGN_EPI) { if (wr == 0) PG8_BAR; }
    PG8_BAR;

#undef PG8_SA
#undef PG8_SB
#undef PG8_STAGE
#undef PG8_LDA
#undef PG8_LDB
#undef PG8_MMA
#undef PG8_WAIT_V
#undef PG8_WAIT_L
#undef PG8_BAR
#undef PG8_SCHED
}
}

constexpr int NWAVES = 8;
constexpr int BATCH = 4, SEQ = 4096, DM = 1024, M = BATCH * SEQ, FF = 2816, INW = 6672;
constexpr int NGU = 2 * FF;
constexpr int ZP = 4608;
constexpr int NWIN = 4864;
constexpr int NZREAL = 4624;
constexpr size_t MiB = 1u << 20;
constexpr size_t WS_CTL = 0, CTL_ZERO_BYTES = 1 * MiB;
constexpr size_t WS_BIN = 1 * MiB, WS_BG = WS_BIN + 32768;
constexpr size_t WS_WG = 2 * MiB, WS_WPROJ = 6 * MiB, WS_WOUT = 10 * MiB, WS_WGU2 = 12 * MiB, WS_WD2 = 23 * MiB;
constexpr size_t WS_ST = 29 * MiB;
constexpr size_t WS_WGU1 = 29 * MiB, WS_WD1 = 40 * MiB, WS_WIN = WS_WD1 + 5767168;
constexpr size_t WS_XB = 61 * MiB;
constexpr size_t WS_BIG = 93 * MiB;
constexpr size_t WS_IF = 237 * MiB;
constexpr size_t WS_END = 240 * MiB;
static_assert(WS_WIN + (size_t)NWIN * 1024 * 2 <= WS_XB && WS_ST + 32 * MiB <= WS_XB && WS_WD2 + (size_t)1024 * FF * 2 <= WS_ST, "ws map");
constexpr int CW_BAR = 4096;
constexpr size_t CTL_SSQ = 512 * 1024;
constexpr int RING_OFF = 0, RING_BYTES = 131072;
constexpr int LDSCTL_OFF = 151552, MISC_OFF = LDSCTL_OFF + 320;
constexpr int LDS_BYTES = 155648;

#define GAS __attribute__((address_space(1)))
#define LAS __attribute__((address_space(3)))
typedef unsigned short bf16;
typedef unsigned v4u __attribute__((ext_vector_type(4)));
typedef unsigned v2u __attribute__((ext_vector_type(2)));
typedef float f32x4 __attribute__((ext_vector_type(4)));
typedef short bf16x8 __attribute__((ext_vector_type(8)));
typedef GAS unsigned gu32;
#define RLX_AGENT __ATOMIC_RELAXED, __HIP_MEMORY_SCOPE_AGENT
#define LDS_WAIT() asm volatile("s_waitcnt lgkmcnt(0)" ::: "memory")
#define VM_WAIT() asm volatile("s_waitcnt vmcnt(0)" ::: "memory")
__device__ __forceinline__ unsigned f2bf(float f) { unsigned u = __builtin_bit_cast(unsigned, f); return (u + 0x7fffu + ((u >> 16) & 1u)) >> 16; }
__device__ __forceinline__ unsigned pk2(float lo, float hi) { return f2bf(lo) | (f2bf(hi) << 16); }
__device__ __forceinline__ float bf2f(unsigned short b) { return __builtin_bit_cast(float, (unsigned)b << 16); }

#define XB_TMO      128
#define XB_XCNT(j)  (256  + 64 * (j))
#define XB_XSUB(j)  (1280 + 64 * (j))
#define XB_XGEN(j)  (2304 + 64 * (j))
#define XB_TOP      3328
#define XB_TOPGEN   3392
#define XCD_BAR_WORDS 3456
#define XB_SPIN_CAP (1u << 23)
__device__ __forceinline__ unsigned xb_ld(unsigned* p)              { return __hip_atomic_load(p, __ATOMIC_RELAXED, __HIP_MEMORY_SCOPE_AGENT); }
__device__ __forceinline__ unsigned xb_add(unsigned* p, unsigned v) { return __hip_atomic_fetch_add(p, v, __ATOMIC_RELAXED, __HIP_MEMORY_SCOPE_AGENT); }
__device__ __forceinline__ unsigned xb_xcc_id() { return (unsigned)__builtin_amdgcn_s_getreg((3 << 11) | 20) & 0xFu; }
#define XB_SPIN(cond, bar) do { unsigned _sp = 0; while (cond) { __builtin_amdgcn_s_sleep(1); \
    if ((++_sp & 255u) == 0u) { if (xb_ld(&(bar)[XB_TMO])) break; if (_sp > XB_SPIN_CAP) { atomicAdd(&(bar)[XB_TMO], 1u); break; } } } } while (0)
struct XcdBarrier { unsigned* bar; unsigned x; volatile LAS unsigned* st; };
__device__ __forceinline__ XcdBarrier xcd_barrier_post(unsigned* bar, volatile LAS unsigned* st) {
    XcdBarrier b; b.bar = bar; b.x = xb_xcc_id(); b.st = st;
    if (threadIdx.x == 0) (void)xb_add(&bar[XB_XCNT(b.x)], 1u);
    return b;
}
__device__ __forceinline__ void xcd_barrier_complete(unsigned* bar, unsigned x, unsigned& nloc, unsigned& nx) {
    const unsigned G = gridDim.x * gridDim.y * gridDim.z;
    unsigned sum, cnt, mine, sp = 0u;
    for (;;) {
        sum = 0u; cnt = 0u; mine = 0u;
#pragma unroll
        for (unsigned j = 0; j < 16; ++j) { const unsigned c = xb_ld(&bar[XB_XCNT(j)]); sum += c; cnt += (c > 0u) ? 1u : 0u; mine = (j == x) ? c : mine; }
        if (sum == G) break;
        __builtin_amdgcn_s_sleep(1);
        if ((++sp & 255u) == 0u) { if (xb_ld(&bar[XB_TMO])) break; if (sp > XB_SPIN_CAP) { atomicAdd(&bar[XB_TMO], 1u); break; } }
    }
    nloc = mine > 0u ? mine : 1u; nx = cnt > 0u ? cnt : 1u;
}
__device__ __forceinline__ void xcd_barrier(const XcdBarrier& b) {
    asm volatile("s_waitcnt vmcnt(0)" ::: "memory");
    __syncthreads();
    if (threadIdx.x == 0) {
        unsigned* bar = b.bar;
        __builtin_amdgcn_s_waitcnt(0);
        unsigned nloc = b.st[0], nx = b.st[1];
        if (nloc == 0u) { xcd_barrier_complete(bar, b.x, nloc, nx); b.st[0] = nloc; b.st[1] = nx; }
        const unsigned old = xb_add(&bar[XB_XSUB(b.x)], 1u);
        const unsigned gen = old / nloc;
        if (old + 1u == (gen + 1u) * nloc) {
            __builtin_amdgcn_fence(__ATOMIC_RELEASE, "agent");
            asm volatile("s_waitcnt vmcnt(0)" ::: "memory");
            const unsigned og = xb_add(&bar[XB_TOP], 1u);
            const unsigned tg = og / nx;
            if (og + 1u == (tg + 1u) * nx) xb_add(&bar[XB_TOPGEN], 1u);
            else XB_SPIN(xb_ld(&bar[XB_TOPGEN]) == tg, bar);
            __builtin_amdgcn_fence(__ATOMIC_ACQUIRE, "agent");
            xb_add(&bar[XB_XGEN(b.x)], 1u);
            asm volatile("s_waitcnt vmcnt(0)" ::: "memory");
        } else {
            XB_SPIN(xb_ld(&bar[XB_XGEN(b.x)]) == gen, bar);
            __builtin_amdgcn_fence(__ATOMIC_ACQUIRE, "agent");
            asm volatile("s_waitcnt vmcnt(0)" ::: "memory");
        }
    }
    __syncthreads();
}

__device__ __forceinline__ float wave_sum(float v) {
#pragma unroll
    for (int o = 1; o < 64; o <<= 1) v += __shfl_xor(v, o);
    return v;
}
template <class RowMap>
__device__ __forceinline__ void transpose_item(const float* W, int N, const float* g, LAS float* scr, int item, int lane, const RowMap& rm) {
    const int nblk = (N + 31) / 32, kb = item / nblk, nb = item % nblk, k0 = 64 * kb, n0 = 32 * nb;
    const int nl = lane & 31, nsrc = n0 + nl;
    float wv[32];
    const int nclamp = nsrc < N ? nsrc : N - 1;
#pragma unroll
    for (int i = 0; i < 32; ++i) wv[i] = W[(size_t)(k0 + 2 * i + (lane >> 5)) * N + nclamp];
#pragma unroll
    for (int i = 0; i < 32; ++i) { const int kk = 2 * i + (lane >> 5); float v = nsrc < N ? wv[i] : 0.f; if (g) v *= g[k0 + kk]; scr[kk * 33 + nl] = v; }
    LDS_WAIT(); asm volatile("" ::: "memory");
    const int c = lane & 7;
#pragma unroll
    for (int j = 0; j < 4; ++j) { const int n = (lane >> 3) + 8 * j; const LAS float* s = scr + (8 * c) * 33 + n;
        v4u o; o.x = pk2(s[0 * 33], s[1 * 33]); o.y = pk2(s[2 * 33], s[3 * 33]); o.z = pk2(s[4 * 33], s[5 * 33]); o.w = pk2(s[6 * 33], s[7 * 33]);
        if (n0 + n < N) *(GAS v4u*)(rm(n0 + n) + k0 + 8 * c) = o; }
    LDS_WAIT(); asm volatile("" ::: "memory");
}
struct RmGate { bf16* W; __device__ __forceinline__ bf16* operator()(int n) const { return W + (size_t)(256 * (n >> 7) + (n & 127)) * 1024; } };
struct RmUp   { bf16* W; __device__ __forceinline__ bf16* operator()(int n) const { return W + (size_t)(256 * (n >> 7) + 128 + (n & 127)) * 1024; } };
struct RmLin  { bf16* W; int ld, koff; __device__ __forceinline__ bf16* operator()(int n) const { return W + (size_t)n * ld + koff; } };
struct RmWin  { bf16* Win; bf16* Wg; __device__ __forceinline__ bf16* operator()(int n) const { return n < NZREAL ? Win + (size_t)n * 1024 : Wg + (size_t)(n - NZREAL) * 1024; } };


namespace att {
typedef float f32x16 __attribute__((ext_vector_type(16)));
typedef short s16x4 __attribute__((ext_vector_type(4)));
constexpr int KSTR = 144, VSTR = 192, STG_STR = 144;
constexpr int LDS_K = 0, LDS_V = 256 * KSTR, LDS_STG = LDS_V + 256 * VSTR, LDS_END = LDS_STG + 8 * 32 * STG_STR;
__device__ __forceinline__ s16x4 tr_read(LAS const unsigned char* p) { return __builtin_bit_cast(s16x4, __builtin_amdgcn_ds_read_tr16_b64_v4i16((LAS s16x4*)p)); }
__device__ __forceinline__ unsigned pk_bf16(float lo, float hi) { return pg8::cvt_pk_bf16(lo, hi); }

__device__ __forceinline__ void attn_unit(bf16* Z, const float* sinks, int b, int hkv, int qb, LAS unsigned char* lds) {
    int tid_ = threadIdx.x; asm volatile("" : "+v"(tid_));
    const int tid = tid_, lane = tid & 63, wave = __builtin_amdgcn_readfirstlane(tid >> 6), c = lane & 31, hi = lane >> 5;
    const int q0 = qb * 128; const size_t rowbase = (size_t)b * SEQ;
#pragma unroll
    for (int i = 0; i < 4; ++i) {
        const int idx = tid + 512 * i, kk = idx >> 3, ch = idx & 7, pos = q0 - 128 + kk;
        v4u kv = (v4u){0u, 0u, 0u, 0u}, vv = (v4u){0u, 0u, 0u, 0u};
        if (pos >= 0) { const bf16* zr = Z + (rowbase + pos) * ZP + hkv * 64 + ch * 8; kv = *(const v4u*)(zr + 1024); vv = *(const v4u*)(zr + 1280); }
        *(LAS v4u*)(lds + LDS_K + kk * KSTR + ch * 16) = kv;
        *(LAS v4u*)(lds + LDS_V + kk * VSTR + ch * 16) = vv;
    }
    __syncthreads();
    const int hq = hkv * 4 + (wave >> 1);
    const float sink8 = sinks[hq] * 8.0f;
    const float cs = 0.125f * 1.4426950408889634f;
#pragma unroll 1
    for (int blk = 0; blk < 2; ++blk) {
        const int i32 = 2 * (wave & 1) + blk, qs = q0 + 32 * i32;
        bf16* qrow = Z + (rowbase + qs + c) * ZP + hq * 64;
        bf16x8 qf[4];
#pragma unroll
        for (int s = 0; s < 4; ++s) qf[s] = *(const bf16x8*)(qrow + 16 * s + 8 * hi);
        f32x16 st[5];
#pragma unroll
        for (int j = 0; j < 5; ++j) {
            LAS const unsigned char* kb = lds + LDS_K + (32 * i32 + 32 * j + c) * KSTR + hi * 16;
            f32x16 acc = {};
#pragma unroll
            for (int s = 0; s < 4; ++s) { const bf16x8 kf = *(LAS const bf16x8*)(kb + s * 32); acc = __builtin_amdgcn_mfma_f32_32x32x16_bf16(kf, qf[s], acc, 0, 0, 0); }
            st[j] = acc;
        }
#pragma unroll
        for (int r = 0; r < 16; ++r) {
            const int rr = (r & 3) + 8 * (r >> 2) + 4 * hi;
            if (!(rr > c)) st[0][r] = -INFINITY;
            if (!(rr <= c)) st[4][r] = -INFINITY;
        }
        if (qb == 0) {
#pragma unroll
            for (int j = 0; j < 5; ++j)
#pragma unroll
                for (int r = 0; r < 16; ++r) { const int rr = (r & 3) + 8 * (r >> 2) + 4 * hi; if (32 * i32 + 32 * j + rr < 128) st[j][r] = -INFINITY; }
        }
        float m = sink8;
#pragma unroll
        for (int j = 0; j < 5; ++j)
#pragma unroll
            for (int r = 0; r < 16; ++r) m = fmaxf(m, st[j][r]);
        m = fmaxf(m, __shfl_xor(m, 32));
        const float mb = m * cs; float sum = 0.f;
        bf16x8 pf[5][2];
#pragma unroll
        for (int j = 0; j < 5; ++j) {
            float p[16];
#pragma unroll
            for (int r = 0; r < 16; ++r) { p[r] = __builtin_amdgcn_exp2f(st[j][r] * cs - mb); sum += p[r]; }
#pragma unroll
            for (int s = 0; s < 2; ++s) { v4u w; w.x = pk_bf16(p[8 * s], p[8 * s + 1]); w.y = pk_bf16(p[8 * s + 2], p[8 * s + 3]); w.z = pk_bf16(p[8 * s + 4], p[8 * s + 5]); w.w = pk_bf16(p[8 * s + 6], p[8 * s + 7]);
                pf[j][s] = __builtin_bit_cast(bf16x8, w); }
        }
        sum += __shfl_xor(sum, 32);
        sum += __builtin_amdgcn_exp2f(sink8 * cs - mb);
        f32x16 ot[2] = {};
        const int g16 = (lane >> 4) & 1, q4 = (lane & 15) >> 2, p4 = lane & 3;
        LAS const unsigned char* vb = lds + LDS_V + (32 * i32 + 4 * hi + q4) * VSTR + (16 * g16 + 4 * p4) * 2;
#pragma unroll
        for (int j = 0; j < 5; ++j)
#pragma unroll
            for (int s = 0; s < 2; ++s)
#pragma unroll
                for (int db = 0; db < 2; ++db) {
                    const s16x4 lo = tr_read(vb + (32 * j + 16 * s) * VSTR + db * 64), hh = tr_read(vb + (32 * j + 16 * s + 8) * VSTR + db * 64);
                    const bf16x8 vf = (bf16x8){lo[0], lo[1], lo[2], lo[3], hh[0], hh[1], hh[2], hh[3]};
                    ot[db] = __builtin_amdgcn_mfma_f32_32x32x16_bf16(vf, pf[j][s], ot[db], 0, 0, 0);
                }
        const float inv = __builtin_amdgcn_rcpf(sum);
        LAS unsigned char* stg = lds + LDS_STG + wave * (32 * STG_STR);
#pragma unroll
        for (int db = 0; db < 2; ++db)
#pragma unroll
            for (int g = 0; g < 4; ++g) {
                v2u w; w.x = pk_bf16(ot[db][4 * g] * inv, ot[db][4 * g + 1] * inv); w.y = pk_bf16(ot[db][4 * g + 2] * inv, ot[db][4 * g + 3] * inv);
                *(LAS v2u*)(stg + c * STG_STR + (32 * db + 8 * g + 4 * hi) * 2) = w;
            }
        LDS_WAIT(); asm volatile("" ::: "memory");
#pragma unroll
        for (int it = 0; it < 4; ++it) {
            const int row = it * 8 + (lane >> 3), chn = lane & 7;
            const v4u v = *(LAS const v4u*)(stg + row * STG_STR + chn * 16);
            *(v4u*)(Z + (rowbase + qs + row) * ZP + hq * 64 + chn * 8) = v;
        }
        LDS_WAIT(); asm volatile("" ::: "memory");
    }
    __syncthreads();
}
}

namespace ml {
using att::f32x16; using att::s16x4; using att::tr_read; using att::pk_bf16;
constexpr int QSTR = 144, KWSTR = 192, VSTR = 320, CSTR = 144, HSTR = 528;
constexpr float LOG2E = 1.4426950408889634f;
__device__ __forceinline__ float fexp(float x) { return __builtin_amdgcn_exp2f(x * LOG2E); }
__device__ __forceinline__ float bflo(unsigned w) { return __builtin_bit_cast(float, w << 16); }
__device__ __forceinline__ float bfhi(unsigned w) { return __builtin_bit_cast(float, w & 0xffff0000u); }
__device__ __forceinline__ void gates(float zi, float zf, int lane, float& cum, float& g, float& pm) {
    const float ig = 15.0f - 30.0f * __builtin_amdgcn_rcpf(1.0f + __builtin_amdgcn_exp2f(zi * (2.0f / 15.0f * LOG2E)));
    const float fc = 15.0f - 30.0f * __builtin_amdgcn_rcpf(1.0f + __builtin_amdgcn_exp2f(zf * (2.0f / 15.0f * LOG2E)));
    const float lf = fminf(fc, 0.f) - 0.6931471805599453f * __builtin_amdgcn_logf(1.0f + __builtin_amdgcn_exp2f(-fabsf(fc) * LOG2E));
    float cs = lf;
#pragma unroll
    for (int o = 1; o < 64; o <<= 1) { const float t = __shfl_up(cs, o); if (lane >= o) cs += t; }
    cum = cs; g = ig - cs; float p = g;
#pragma unroll
    for (int o = 1; o < 64; o <<= 1) { const float t = __shfl_up(p, o); if (lane >= o) p = fmaxf(p, t); }
    pm = p;
}
__device__ __forceinline__ void load_cwt(LAS float* cwt, const float* cw, int h, int tid) {
    const int j = tid >> 6, d = tid & 63;
    cwt[j * 64 + d] = cw[(j & 3) * 1024 + (j >> 2) * 512 + h * 64 + d];
}
__device__ __forceinline__ void conv8(const v4u (&x)[4], float m0, float m1, float m2, LAS const float* w, int ch8, float (&o)[8]) {
    float a[8];
#pragma unroll
    for (int e = 0; e < 8; ++e) a[e] = 0.f;
#pragma unroll
    for (int j = 0; j < 4; ++j) {
        const float mk = j == 0 ? m0 : (j == 1 ? m1 : (j == 2 ? m2 : 1.0f));
        const f32x4 w0 = *(LAS const f32x4*)(w + j * 64 + ch8 * 8) * mk, w1 = *(LAS const f32x4*)(w + j * 64 + ch8 * 8 + 4) * mk;
        a[0] += bflo(x[j].x) * w0[0]; a[1] += bfhi(x[j].x) * w0[1]; a[2] += bflo(x[j].y) * w0[2]; a[3] += bfhi(x[j].y) * w0[3];
        a[4] += bflo(x[j].z) * w1[0]; a[5] += bfhi(x[j].z) * w1[1]; a[6] += bflo(x[j].w) * w1[2]; a[7] += bfhi(x[j].w) * w1[3];
    }
#pragma unroll
    for (int e = 0; e < 8; ++e) o[e] = a[e] * pg8::fast_sigmoid(a[e]);
}
__device__ __forceinline__ v4u pack8(const float (&o)[8]) { v4u w; w.x = pk_bf16(o[0], o[1]); w.y = pk_bf16(o[2], o[3]); w.z = pk_bf16(o[4], o[5]); w.w = pk_bf16(o[6], o[7]); return w; }
__device__ __forceinline__ int unit_of(int bx, int i) { return (bx >> 3) * 64 + (bx & 7) + 8 * i; }

constexpr int A_KW = 0, A_V = 64 * KWSTR, A_CWT = A_V + 64 * VSTR, A_END = A_CWT + 2048;
struct ALoad { v4u k[4]; v4u v[2]; float gi, gf; };
__device__ __forceinline__ void phaseA_issue(ALoad& L, const bf16* Z, const float* IF, int u, int tid, int lane) {
    const int h = (u >> 6) & 7, b = u >> 9, cc = u & 63; const size_t r0 = (size_t)b * SEQ + cc * 64;
    const int t = tid >> 3, ch8 = tid & 7;
#pragma unroll
    for (int j = 0; j < 4; ++j) { const int dt = (cc * 64 + t - 3 + j) < 0 ? 0 : (t - 3 + j); L.k[j] = *(const v4u*)(Z + (r0 + dt) * ZP + 2048 + h * 64 + ch8 * 8); }
#pragma unroll
    for (int i = 0; i < 2; ++i) { const int idx = tid + 512 * i, tt = idx >> 4, chv = idx & 15; L.v[i] = *(const v4u*)(Z + (r0 + tt) * ZP + 2560 + h * 128 + chv * 8); }
    L.gi = IF[(r0 + lane) * 16 + h]; L.gf = IF[(r0 + lane) * 16 + 8 + h];
}
__device__ __forceinline__ void phaseA_all(const bf16* Z, const float* IF, const float* cw, bf16* CT, float* NL, float* SCAL, int bx, LAS unsigned char* lds) {
    int tid_ = threadIdx.x; asm volatile("" : "+v"(tid_));
    const int tid = tid_, lane = tid & 63, wave = __builtin_amdgcn_readfirstlane(tid >> 6), c = lane & 31, hi = lane >> 5;
    const int h = (bx >> 3) & 7;
    load_cwt((LAS float*)(lds + A_CWT), cw, h, tid);
    ALoad L; phaseA_issue(L, Z, IF, unit_of(bx, 0), tid, lane);
    __syncthreads();
#pragma unroll 1
    for (int i = 0; i < 8; ++i) {
        const int u = unit_of(bx, i), cc = u & 63;
        float cum, g, pm; gates(L.gi, L.gf, lane, cum, g, pm);
        const float P = __shfl(pm, 63), total = __shfl(cum, 63);
        const float wkv = fexp(g - P);
        if (tid == 0) { SCAL[u * 4] = total; SCAL[u * 4 + 1] = P; }
        {   const int t = tid >> 3, ch8 = tid & 7; const float wk_t = __shfl(wkv, wave * 8 + (lane >> 3)) * 0.125f;
            const int tp = cc * 64 + t; float kf[8];
            conv8(L.k, tp - 3 >= 0 ? 1.f : 0.f, tp - 2 >= 0 ? 1.f : 0.f, tp - 1 >= 0 ? 1.f : 0.f, (LAS const float*)(lds + A_CWT) + 256, ch8, kf);
#pragma unroll
            for (int e = 0; e < 8; ++e) kf[e] *= wk_t;
            *(LAS v4u*)(lds + A_KW + t * KWSTR + ch8 * 16) = pack8(kf);
        }
#pragma unroll
        for (int q = 0; q < 2; ++q) { const int idx = tid + 512 * q, tt = idx >> 4, chv = idx & 15; *(LAS v4u*)(lds + A_V + tt * VSTR + chv * 16) = L.v[q]; }
        __syncthreads();
        if (i + 1 < 8) phaseA_issue(L, Z, IF, unit_of(bx, i + 1), tid, lane);
        const int db = wave >> 2, vb = wave & 3, g16 = (lane >> 4) & 1, q4 = (lane & 15) >> 2, p4 = lane & 3;
        f32x16 acc = {};
        LAS const unsigned char* ka = lds + A_KW + (8 * hi + q4) * KWSTR + (32 * db + 16 * g16 + 4 * p4) * 2;
        LAS const unsigned char* va = lds + A_V + (8 * hi + q4) * VSTR + (32 * vb + 16 * g16 + 4 * p4) * 2;
#pragma unroll
        for (int ks = 0; ks < 4; ++ks) {
            const s16x4 a0 = tr_read(ka + (16 * ks) * KWSTR), a1 = tr_read(ka + (16 * ks + 4) * KWSTR);
            const s16x4 b0 = tr_read(va + (16 * ks) * VSTR), b1 = tr_read(va + (16 * ks + 4) * VSTR);
            acc = __builtin_amdgcn_mfma_f32_32x32x16_bf16((bf16x8){a0[0], a0[1], a0[2], a0[3], a1[0], a1[1], a1[2], a1[3]}, (bf16x8){b0[0], b0[1], b0[2], b0[3], b1[0], b1[1], b1[2], b1[3]}, acc, 0, 0, 0);
        }
        bf16* crow = CT + ((size_t)u * 128 + 32 * vb + c) * 64 + 32 * db + 4 * hi;
#pragma unroll
        for (int gq = 0; gq < 4; ++gq) { v2u w; w.x = pk_bf16(acc[4 * gq], acc[4 * gq + 1]); w.y = pk_bf16(acc[4 * gq + 2], acc[4 * gq + 3]); *(v2u*)(crow + 8 * gq) = w; }
        if (tid < 64) { float s = 0.f;
#pragma unroll 8
            for (int sidx = 0; sidx < 64; ++sidx) s += bf2f(*(LAS const unsigned short*)(lds + A_KW + sidx * KWSTR + tid * 2));
            NL[u * 64 + tid] = s; }
        __syncthreads();
    }
}

__device__ __forceinline__ void scan_phase(bf16* CT, float* NL, float* SCAL, int bx, int tid_in) {
    int tid = tid_in; asm volatile("" : "+v"(tid));
    const int bh = bx >> 3, sub = bx & 7, u0 = bh * 64;
    if (tid < 128) {
        v4u* p = (v4u*)CT + (size_t)u0 * 1024 + sub * 128 + tid;
        float s[8]; float m = 0.f;
#pragma unroll
        for (int e = 0; e < 8; ++e) s[e] = 0.f;
#pragma unroll 8
        for (int cidx = 0; cidx < 64; ++cidx) {
            const v4u w = p[(size_t)cidx * 1024];
            const float tot = SCAL[(u0 + cidx) * 4], P = SCAL[(u0 + cidx) * 4 + 1];
            const float Mx = fmaxf(m, P), dec = fexp(m - Mx), ee = fexp(P - Mx);
            v4u o; o.x = pk_bf16(s[0], s[1]); o.y = pk_bf16(s[2], s[3]); o.z = pk_bf16(s[4], s[5]); o.w = pk_bf16(s[6], s[7]);
            p[(size_t)cidx * 1024] = o;
            s[0] = dec * s[0] + ee * bflo(w.x); s[1] = dec * s[1] + ee * bfhi(w.x); s[2] = dec * s[2] + ee * bflo(w.y); s[3] = dec * s[3] + ee * bfhi(w.y);
            s[4] = dec * s[4] + ee * bflo(w.z); s[5] = dec * s[5] + ee * bfhi(w.z); s[6] = dec * s[6] + ee * bflo(w.w); s[7] = dec * s[7] + ee * bfhi(w.w);
            m = tot + Mx;
        }
    } else if (sub == 0 && tid < 192) {
        const int d = tid - 128; float sn = 0.f, m = 0.f;
#pragma unroll 8
        for (int cidx = 0; cidx < 64; ++cidx) {
            const float tot = SCAL[(u0 + cidx) * 4], P = SCAL[(u0 + cidx) * 4 + 1];
            const float Mx = fmaxf(m, P), dec = fexp(m - Mx), ee = fexp(P - Mx);
            float* np = NL + (u0 + cidx) * 64 + d; const float nl = *np; *np = sn; sn = dec * sn + ee * nl;
            if (d == 0) SCAL[(u0 + cidx) * 4 + 2] = m;
            m = tot + Mx;
        }
    }
}

constexpr int C_Q = 0, C_K = C_Q + 64 * QSTR, C_V = C_K + 64 * QSTR, C_C = C_V + 64 * VSTR, C_H = C_C + 128 * CSTR, C_G = C_H + 64 * HSTR, C_N = C_G + 256, C_RED = C_N + 256, C_CWT = C_RED + 1024, C_GN = C_CWT + 2048, C_END = C_GN + 512;
struct CLoad { v4u q[4], k[4], v[2], ct[2]; float gi, gf, np, mprev; };
__device__ __forceinline__ void phaseC_issue(CLoad& L, const bf16* Z, const float* IF, const bf16* CT, const float* NL, const float* SCAL, int u, int tid, int lane) {
    const int h = (u >> 6) & 7, b = u >> 9, cc = u & 63; const size_t r0 = (size_t)b * SEQ + cc * 64;
    const int t = tid >> 3, ch8 = tid & 7;
#pragma unroll
    for (int j = 0; j < 4; ++j) { const int dt = (cc * 64 + t - 3 + j) < 0 ? 0 : (t - 3 + j); const bf16* zr = Z + (r0 + dt) * ZP + h * 64 + ch8 * 8; L.q[j] = *(const v4u*)(zr + 1536); L.k[j] = *(const v4u*)(zr + 2048); }
#pragma unroll
    for (int i = 0; i < 2; ++i) { const int idx = tid + 512 * i, tt = idx >> 4, chv = idx & 15; L.v[i] = *(const v4u*)(Z + (r0 + tt) * ZP + 2560 + h * 128 + chv * 8); }
#pragma unroll
    for (int i = 0; i < 2; ++i) { const int idx = tid + 512 * i, vv = idx >> 3, ch = idx & 7; L.ct[i] = *(const v4u*)(CT + ((size_t)u * 128 + vv) * 64 + ch * 8); }
    L.gi = IF[(r0 + lane) * 16 + h]; L.gf = IF[(r0 + lane) * 16 + 8 + h];
    L.np = NL[u * 64 + lane]; L.mprev = SCAL[u * 4 + 2];
}
__device__ __forceinline__ void phaseC_all(bf16* Z, const float* IF, const float* cw, const bf16* CT, const float* NL, const float* SCAL, const float* gn, int bx, LAS unsigned char* lds) {
    int tid_ = threadIdx.x; asm volatile("" : "+v"(tid_));
    const int tid = tid_, lane = tid & 63, wave = __builtin_amdgcn_readfirstlane(tid >> 6), c = lane & 31, hi = lane >> 5;
    const int h = (bx >> 3) & 7;
    load_cwt((LAS float*)(lds + C_CWT), cw, h, tid);
    if (tid < 128) *(LAS float*)(lds + C_GN + tid * 4) = gn[h * 128 + tid];
    CLoad L; phaseC_issue(L, Z, IF, CT, NL, SCAL, unit_of(bx, 0), tid, lane);
    __syncthreads();
#pragma unroll 1
    for (int i = 0; i < 8; ++i) {
        const int u = unit_of(bx, i), b = u >> 9, cc = u & 63; const size_t r0 = (size_t)b * SEQ + cc * 64;
        float cum, g, pm; gates(L.gi, L.gf, lane, cum, g, pm);
        const float m_prev = L.mprev;
        const float Mt = fmaxf(m_prev, pm), wint = fexp(m_prev - Mt), flo = fexp(-(cum + Mt));
        if (wave == 0) { *(LAS float*)(lds + C_G + lane * 4) = g; *(LAS float*)(lds + C_N + lane * 4) = L.np; }
        {   const int t = tid >> 3, ch8 = tid & 7, tp = cc * 64 + t; float f[8];
            const float m0 = tp - 3 >= 0 ? 1.f : 0.f, m1 = tp - 2 >= 0 ? 1.f : 0.f, m2 = tp - 1 >= 0 ? 1.f : 0.f;
            conv8(L.q, m0, m1, m2, (LAS const float*)(lds + C_CWT), ch8, f);
            *(LAS v4u*)(lds + C_Q + t * QSTR + ch8 * 16) = pack8(f);
            conv8(L.k, m0, m1, m2, (LAS const float*)(lds + C_CWT) + 256, ch8, f);
#pragma unroll
            for (int e = 0; e < 8; ++e) f[e] *= 0.125f;
            *(LAS v4u*)(lds + C_K + t * QSTR + ch8 * 16) = pack8(f);
        }
#pragma unroll
        for (int q = 0; q < 2; ++q) { const int idx = tid + 512 * q, tt = idx >> 4, chv = idx & 15; *(LAS v4u*)(lds + C_V + tt * VSTR + chv * 16) = L.v[q]; }
#pragma unroll
        for (int q = 0; q < 2; ++q) { const int idx = tid + 512 * q, vv = idx >> 3, ch = idx & 7; *(LAS v4u*)(lds + C_C + vv * CSTR + ch * 16) = L.ct[q]; }
        __syncthreads();
        v4u og[2];
#pragma unroll
        for (int q = 0; q < 2; ++q) { const int idx = tid + 512 * q; og[q] = *(const v4u*)(Z + (r0 + (idx >> 4)) * ZP + 3584 + h * 128 + (idx & 15) * 8); }
        if (i + 1 < 8) phaseC_issue(L, Z, IF, CT, NL, SCAL, unit_of(bx, i + 1), tid, lane);
        const int tb = wave >> 2, vb = wave & 3, g16 = (lane >> 4) & 1, q4 = (lane & 15) >> 2, p4 = lane & 3;
        const float Mt_c = __shfl(Mt, 32 * tb + c), wint_c = __shfl(wint, 32 * tb + c), flo_c = __shfl(flo, 32 * tb + c);
        bf16x8 qf[4];
#pragma unroll
        for (int ks = 0; ks < 4; ++ks) qf[ks] = *(LAS const bf16x8*)(lds + C_Q + (32 * tb + c) * QSTR + (16 * ks + 8 * hi) * 2);
        f32x16 X[2]; float dsum = 0.f;
#pragma unroll
        for (int j = 0; j < 2; ++j) {
            X[j] = (f32x16){};
            if (j <= tb) {
                LAS const unsigned char* kb = lds + C_K + (32 * j + c) * QSTR + hi * 16;
#pragma unroll
                for (int ks = 0; ks < 4; ++ks) X[j] = __builtin_amdgcn_mfma_f32_32x32x16_bf16(*(LAS const bf16x8*)(kb + ks * 32), qf[ks], X[j], 0, 0, 0);
#pragma unroll
                for (int r = 0; r < 16; ++r) {
                    const int s = 32 * j + (r & 3) + 8 * (r >> 2) + 4 * hi;
                    const float gs = *(LAS const float*)(lds + C_G + s * 4);
                    const float w = (s <= 32 * tb + c) ? fexp(gs - Mt_c) : 0.f;
                    X[j][r] *= w; dsum += X[j][r];
                }
            }
        }
        dsum += __shfl_xor(dsum, 32);
        float qn = 0.f;
        {   LAS const unsigned char* qr = lds + C_Q + (32 * tb + c) * QSTR + hi * 64; LAS const float* nr = (LAS const float*)(lds + C_N) + 32 * hi;
#pragma unroll
            for (int k4 = 0; k4 < 4; ++k4) { const v4u x = *(LAS const v4u*)(qr + k4 * 16);
                qn += bflo(x.x) * nr[8 * k4] + bfhi(x.x) * nr[8 * k4 + 1] + bflo(x.y) * nr[8 * k4 + 2] + bfhi(x.y) * nr[8 * k4 + 3] + bflo(x.z) * nr[8 * k4 + 4] + bfhi(x.z) * nr[8 * k4 + 5] + bflo(x.w) * nr[8 * k4 + 6] + bfhi(x.w) * nr[8 * k4 + 7]; }
        }
        qn += __shfl_xor(qn, 32);
        const float den = dsum + wint_c * qn, inv = __builtin_amdgcn_rcpf(fmaxf(fabsf(den), flo_c));
        f32x16 acc = {};
#pragma unroll
        for (int ks = 0; ks < 4; ++ks) acc = __builtin_amdgcn_mfma_f32_32x32x16_bf16(*(LAS const bf16x8*)(lds + C_C + (32 * vb + c) * CSTR + (16 * ks + 8 * hi) * 2), qf[ks], acc, 0, 0, 0);
#pragma unroll
        for (int r = 0; r < 16; ++r) acc[r] *= wint_c;
        LAS const unsigned char* va = lds + C_V + (4 * hi + q4) * VSTR + (32 * vb + 16 * g16 + 4 * p4) * 2;
#pragma unroll
        for (int j = 0; j < 2; ++j) {
            if (j <= tb) {
#pragma unroll
                for (int s2 = 0; s2 < 2; ++s2) {
                    const s16x4 a0 = tr_read(va + (32 * j + 16 * s2) * VSTR), a1 = tr_read(va + (32 * j + 16 * s2 + 8) * VSTR);
                    v4u w; w.x = pk_bf16(X[j][8 * s2], X[j][8 * s2 + 1]); w.y = pk_bf16(X[j][8 * s2 + 2], X[j][8 * s2 + 3]); w.z = pk_bf16(X[j][8 * s2 + 4], X[j][8 * s2 + 5]); w.w = pk_bf16(X[j][8 * s2 + 6], X[j][8 * s2 + 7]);
                    acc = __builtin_amdgcn_mfma_f32_32x32x16_bf16((bf16x8){a0[0], a0[1], a0[2], a0[3], a1[0], a1[1], a1[2], a1[3]}, __builtin_bit_cast(bf16x8, w), acc, 0, 0, 0);
                }
            }
        }
        float ss = 0.f;
#pragma unroll
        for (int r = 0; r < 16; ++r) { acc[r] *= inv; ss += acc[r] * acc[r]; }
        ss += __shfl_xor(ss, 32);
        if (hi == 0) *(LAS float*)(lds + C_RED + (vb * 64 + 32 * tb + c) * 4) = ss;
#pragma unroll
        for (int gq = 0; gq < 4; ++gq) *(LAS f32x4*)(lds + C_H + (32 * tb + c) * HSTR + (32 * vb + 8 * gq + 4 * hi) * 4) = (f32x4){acc[4 * gq], acc[4 * gq + 1], acc[4 * gq + 2], acc[4 * gq + 3]};
        __syncthreads();
#pragma unroll
        for (int q = 0; q < 2; ++q) {
            const int idx = tid + 512 * q, t = idx >> 4, ch = idx & 15; const v4u o = og[q];
            const f32x4 gn0 = *(LAS const f32x4*)(lds + C_GN + ch * 32), gn1 = *(LAS const f32x4*)(lds + C_GN + ch * 32 + 16);
            LAS const float* red = (LAS const float*)(lds + C_RED);
            const float tot = (red[t] + red[64 + t]) + (red[128 + t] + red[192 + t]);
            const float rs = __builtin_amdgcn_rsqf(tot * (1.0f / 128.0f) + 1e-6f);
            const f32x4 h0 = *(LAS const f32x4*)(lds + C_H + t * HSTR + ch * 32), h1 = *(LAS const f32x4*)(lds + C_H + t * HSTR + ch * 32 + 16);
            float f[8];
            f[0] = pg8::fast_sigmoid(bflo(o.x)) * h0[0] * rs * gn0[0]; f[1] = pg8::fast_sigmoid(bfhi(o.x)) * h0[1] * rs * gn0[1];
            f[2] = pg8::fast_sigmoid(bflo(o.y)) * h0[2] * rs * gn0[2]; f[3] = pg8::fast_sigmoid(bfhi(o.y)) * h0[3] * rs * gn0[3];
            f[4] = pg8::fast_sigmoid(bflo(o.z)) * h1[0] * rs * gn1[0]; f[5] = pg8::fast_sigmoid(bfhi(o.z)) * h1[1] * rs * gn1[1];
            f[6] = pg8::fast_sigmoid(bflo(o.w)) * h1[2] * rs * gn1[2]; f[7] = pg8::fast_sigmoid(bfhi(o.w)) * h1[3] * rs * gn1[3];
            *(v4u*)(Z + (r0 + t) * ZP + 2560 + h * 128 + ch * 8) = pack8(f);
        }
        __syncthreads();
    }
}
}

struct Args { const float* in[19]; float* out; unsigned char* ws; int ph_lo, ph_hi, use_bar, pad; };

__global__ void __launch_bounds__(NWAVES * 64, 2) mk_fwd(Args args) {
    extern __shared__ __attribute__((aligned(16))) unsigned char lds_raw[];
    LAS unsigned char* lds = (LAS unsigned char*)lds_raw;
    volatile LAS unsigned* MISC = (volatile LAS unsigned*)(lds + MISC_OFF);
    const int tid = threadIdx.x, lane = tid & 63, wave = __builtin_amdgcn_readfirstlane(tid >> 6);
    const int G = gridDim.x, bx = blockIdx.x, vcu = (G % 8 == 0) ? (bx % 8) * (G / 8) + bx / 8 : bx;
    unsigned char* ws = args.ws;
    gu32* ctl = (gu32*)(ws + WS_CTL);
    float* SSQ = (float*)(ws + WS_CTL + CTL_SSQ);
    const float* x = args.in[0];
    bf16 *WGU1 = (bf16*)(ws + WS_WGU1), *WD1 = (bf16*)(ws + WS_WD1), *WIN = (bf16*)(ws + WS_WIN), *WG = (bf16*)(ws + WS_WG), *WPROJ = (bf16*)(ws + WS_WPROJ),
         *WOUT = (bf16*)(ws + WS_WOUT), *WGU2 = (bf16*)(ws + WS_WGU2), *WD2 = (bf16*)(ws + WS_WD2);
    bf16 *XB = (bf16*)(ws + WS_XB), *BIG = (bf16*)(ws + WS_BIG);
    float *BIN = (float*)(ws + WS_BIN), *BG = (float*)(ws + WS_BG), *IFB = (float*)(ws + WS_IF);
    bf16* MG = (bf16*)(ws + WS_ST);
    float *NLB = (float*)(ws + WS_IF + 1 * MiB), *SCB = (float*)(ws + WS_IF + 1 * MiB + 524288);
    for (int u = tid; u < (LDS_BYTES - LDSCTL_OFF) / 4; u += NWAVES * 64) ((LAS unsigned*)(lds + LDSCTL_OFF))[u] = 0u;
    __syncthreads();
    XcdBarrier bar; bar.bar = (unsigned*)(ctl + CW_BAR); bar.x = 0; bar.st = nullptr;
    if (args.use_bar) bar = xcd_barrier_post((unsigned*)(ctl + CW_BAR), MISC + 8);
    const int lo = args.ph_lo, hi = args.ph_hi;
#define IN(k) (lo <= (k) && (k) < hi)
#define SEAM(k) do { if (IN(k) && IN((k) + 1)) xcd_barrier(bar); } while (0)

    if (IN(0)) {
        LAS float* scr = (LAS float*)(lds + RING_OFF + wave * 16384);
        const int gw = vcu * NWAVES + wave, NGW = G * NWAVES;
        constexpr int I_GU = 16 * (FF / 32), I_D = (FF / 64) * 32, I_WIN = 16 * ((INW + 31) / 32), I_SQ = 16 * 32;
        constexpr int NITEMS = 4 * I_GU + 2 * I_D + I_WIN + 3 * I_SQ;
        for (int it = gw; it < NITEMS; it += NGW) {
            int r = it;
            if (r < I_GU) { transpose_item(args.in[2], FF, args.in[1], scr, r, lane, RmGate{WGU1}); continue; } r -= I_GU;
            if (r < I_GU) { transpose_item(args.in[3], FF, args.in[1], scr, r, lane, RmUp{WGU1}); continue; } r -= I_GU;
            if (r < I_D) { transpose_item(args.in[4], DM, nullptr, scr, r, lane, RmLin{WD1, FF, 0}); continue; } r -= I_D;
            if (r < I_WIN) { transpose_item(args.in[6], INW, args.in[5], scr, r, lane, RmWin{WIN, WG}); continue; } r -= I_WIN;
            if (r < I_SQ) { transpose_item(args.in[11], DM, nullptr, scr, r, lane, RmLin{WPROJ, 2048, 0}); continue; } r -= I_SQ;
            if (r < I_SQ) { transpose_item(args.in[12], DM, nullptr, scr, r, lane, RmLin{WPROJ, 2048, 1024}); continue; } r -= I_SQ;
            if (r < I_SQ) { transpose_item(args.in[13], DM, nullptr, scr, r, lane, RmLin{WOUT, 1024, 0}); continue; } r -= I_SQ;
            if (r < I_GU) { transpose_item(args.in[15], FF, args.in[14], scr, r, lane, RmGate{WGU2}); continue; } r -= I_GU;
            if (r < I_GU) { transpose_item(args.in[16], FF, args.in[14], scr, r, lane, RmUp{WGU2}); continue; } r -= I_GU;
            transpose_item(args.in[17], DM, nullptr, scr, r, lane, RmLin{WD2, FF, 0});
        }
        { const int gt = vcu * (NWAVES * 64) + tid, NGT = G * NWAVES * 64;
          GAS v4u* z = (GAS v4u*)(WIN + (size_t)NZREAL * 1024);
          for (int i = gt; i < (NWIN - NZREAL) * 1024 * 2 / 16; i += NGT) z[i] = (v4u){0u, 0u, 0u, 0u};
          for (int i = gt; i < NWIN; i += NGT) BIN[i] = i < NZREAL ? args.in[7][i] : 0.f;
          for (int i = gt; i < 2048; i += NGT) BG[i] = args.in[7][NZREAL + i]; }
        for (int m = gw * 2; m < M; m += NGW * 2) {
            f32x4 v[2][4]; float s[2];
#pragma unroll
            for (int q = 0; q < 2; ++q) { const GAS f32x4* xr = (const GAS f32x4*)(x + (size_t)(m + q) * DM) + lane;
#pragma unroll
                for (int j = 0; j < 4; ++j) v[q][j] = xr[64 * j]; }
#pragma unroll
            for (int q = 0; q < 2; ++q) { float a = 0.f;
#pragma unroll
                for (int j = 0; j < 4; ++j) a += (v[q][j].x * v[q][j].x + v[q][j].y * v[q][j].y) + (v[q][j].z * v[q][j].z + v[q][j].w * v[q][j].w);
                s[q] = wave_sum(a);
                GAS v2u* o8 = (GAS v2u*)(XB + (size_t)(m + q) * DM) + lane;
#pragma unroll
                for (int j = 0; j < 4; ++j) o8[64 * j] = (v2u){pk2(v[q][j].x, v[q][j].y), pk2(v[q][j].z, v[q][j].w)};
                if (lane == 0) SSQ[m + q] = s[q]; }
        }
        SEAM(0);
    }
    if (IN(1)) {
        pg8::Gemm g{XB, XB, WGU1, 1024, 1024, 1024, 1 << 30}; pg8::StaticOrder S; S.init(M, NGU, G, bx);
        pg8::EpiSwiglu E{BIG, FF, SSQ};
        pg8::gemm_phase<pg8::EpiSwiglu, pg8::StaticOrder, true, true>(lds + RING_OFF, g, S, E);
        SEAM(1);
    }
    if (IN(2)) {
        pg8::Gemm g{BIG, BIG, WD1, FF, FF, FF, 1 << 30}; pg8::StaticOrder S; S.init(M, DM, G, bx);
        pg8::EpiRes E{x, args.out, XB, SSQ + M, 0.5f};
        pg8::gemm_phase<pg8::EpiRes, pg8::StaticOrder, true, true>(lds + RING_OFF, g, S, E);
        SEAM(2);
    }

    if (IN(3)) {
        pg8::Gemm g{XB, XB, WIN, 1024, 1024, 1024, 1 << 30}; pg8::StaticOrder S; S.init(M, NWIN, G, bx);
        pg8::EpiWin E{BIG, ZP, IFB, BIN, SSQ + M};
        pg8::gemm_phase<pg8::EpiWin, pg8::StaticOrder, true, true>(lds + RING_OFF, g, S, E);
        SEAM(3);
    }

    if (IN(4)) {
        for (int u = bx; u < BATCH * 4 * 32; u += G) att::attn_unit(BIG, args.in[8], u >> 7, (u >> 5) & 3, u & 31, lds + RING_OFF);
        for (int v = bx; v < 256; v += G) ml::phaseA_all(BIG, IFB, args.in[9], MG, NLB, SCB, v, lds + RING_OFF);
        SEAM(4);
    }
    if (IN(5)) {
        for (int v = bx; v < 256; v += G) ml::scan_phase(MG, NLB, SCB, v, tid);
        SEAM(5);
    }
    if (IN(6)) {
        for (int v = bx; v < 256; v += G) ml::phaseC_all(BIG, IFB, args.in[9], MG, NLB, SCB, args.in[10], v, lds + RING_OFF);
        SEAM(6);
    }
    if (IN(7)) {
        pg8::Gemm g{XB, XB, WG, 1024, 1024, 1024, 1 << 30}; pg8::StaticOrder S; S.init(M, 2048, G, bx);
        pg8::EpiGate E{BIG, ZP, 1536, 3584, BG, SSQ + M};
        pg8::gemm_phase<pg8::EpiGate, pg8::StaticOrder, true, true>(lds + RING_OFF, g, S, E);
        SEAM(7);
    }
    if (IN(8)) {
        pg8::Gemm g{BIG, BIG + 2560 - 1024, WPROJ, ZP, 2048, 2048, 16}; pg8::StaticOrder S; S.init(M, DM, G, bx);
        pg8::EpiProj E{BIG, ZP, 1536, 3584, MG};
        pg8::gemm_phase<pg8::EpiProj, pg8::StaticOrder, true, true>(lds + RING_OFF, g, S, E);
        SEAM(8);
    }
    if (IN(9)) {
        pg8::Gemm g{MG, MG, WOUT, 1024, 1024, 1024, 1 << 30}; pg8::StaticOrder S; S.init(M, DM, G, bx);
        pg8::EpiRes E{args.out, args.out, XB, SSQ + 2 * M, 1.0f};
        pg8::gemm_phase<pg8::EpiRes, pg8::StaticOrder, true, true>(lds + RING_OFF, g, S, E);
        SEAM(9);
    }
    if (IN(10)) {
        pg8::Gemm g{XB, XB, WGU2, 1024, 1024, 1024, 1 << 30}; pg8::StaticOrder S; S.init(M, NGU, G, bx);
        pg8::EpiSwiglu E{BIG, FF, SSQ + 2 * M};
        pg8::gemm_phase<pg8::EpiSwiglu, pg8::StaticOrder, true, true>(lds + RING_OFF, g, S, E);
        SEAM(10);
    }
    if (IN(11)) {
        pg8::Gemm g{BIG, BIG, WD2, FF, FF, FF, 1 << 30}; pg8::StaticOrder S; S.init(M, DM, G, bx);
        pg8::EpiRes E{args.out, args.out, nullptr, SSQ + 3 * M, 0.5f};
        pg8::gemm_phase<pg8::EpiRes, pg8::StaticOrder, true, true>(lds + RING_OFF, g, S, E);
        SEAM(11);
    }
    if (IN(12)) {
        const int gw = vcu * NWAVES + wave, NGW = G * NWAVES; const float* gf = args.in[18];
        for (int m = gw; m < M; m += NGW) {
            GAS f32x4* xr = (GAS f32x4*)(args.out + (size_t)m * DM) + lane;
            const float rs = pg8::rstd_of(SSQ[3 * M + m]);
#pragma unroll
            for (int j = 0; j < 4; ++j) { const f32x4 gv = *((const f32x4*)gf + lane + 64 * j); f32x4 v = xr[64 * j]; xr[64 * j] = v * rs * gv; }
        }
    }
#undef IN
#undef SEAM
}

extern "C" void kernel_launch(void* const* d_in, const int* in_sizes, int n_in, void* d_out, int out_size, void* d_ws, size_t ws_size, hipStream_t stream) {
    static int grid = 0;
    if (grid == 0) {
        int dev = 0, cus = 0, per_cu = 0;
        if (n_in != 19 || out_size != M * DM || ws_size < WS_END) { fprintf(stderr, "kernel_launch: unexpected problem shape (n_in %d out %d ws %zu)\n", n_in, out_size, ws_size); grid = -1; return; }
        if (hipGetDevice(&dev) != hipSuccess || hipDeviceGetAttribute(&cus, hipDeviceAttributeMultiprocessorCount, dev) != hipSuccess) { grid = -1; return; }
        if (hipFuncSetAttribute((const void*)mk_fwd, hipFuncAttributeMaxDynamicSharedMemorySize, LDS_BYTES) != hipSuccess) { fprintf(stderr, "kernel_launch: hipFuncSetAttribute failed\n"); grid = -1; return; }
        if (hipOccupancyMaxActiveBlocksPerMultiprocessor(&per_cu, (const void*)mk_fwd, NWAVES * 64, LDS_BYTES) != hipSuccess || per_cu < 1) { fprintf(stderr, "kernel_launch: occupancy query says %d blocks per CU\n", per_cu); grid = -1; return; }
        (void)hipGetLastError();
        grid = cus;
    }
    if (grid < 0) return;
    (void)hipMemsetAsync((char*)d_ws + WS_CTL, 0, CTL_ZERO_BYTES, stream);
    Args a{};
    for (int i = 0; i < 19; ++i) a.in[i] = (const float*)d_in[i];
    a.out = (float*)d_out; a.ws = (unsigned char*)d_ws; a.use_bar = 1; a.ph_lo = 0; a.ph_hi = 13;
    hipLaunchKernelGGL(mk_fwd, dim3(grid), dim3(NWAVES * 64), LDS_BYTES, stream, a);
}
```
